# Optimizing an MI355X kernel written in HIP

```python
import jax, jax.numpy as jnp
from jax import lax
import numpy as np

D_MODEL = 1024
BATCH = 2
SEQ = 8192
DEPTH = 1

D_MIX = D_MODEL
GLA_HEADS = 4
GLA_VDIM = D_MIX // 2
GLA_DV = GLA_VDIM // GLA_HEADS
GLA_DK = GLA_DV // 2
GLA_KDIM = GLA_HEADS * GLA_DK
GLA_GATE_RANK = 16
GLA_GATE_NORM = 16.0
GLA_CHUNK = 64
POOL_WIDTH = D_MIX - GLA_VDIM
POOL_WINDOWS = (2, 4, 8, 16)
POOL_GROUPS = 4
POOL_GW = POOL_WIDTH // POOL_GROUPS
IN_SIZES = (GLA_KDIM, GLA_KDIM, GLA_VDIM, GLA_VDIM, POOL_WIDTH, GLA_GATE_RANK)
IN_COLS = int(sum(IN_SIZES))
IN_SPLITS = [int(v) for v in np.cumsum(IN_SIZES)[:-1]]
PEER_HEADS = 8
PEER_NKEYS = 128
PEER_NEXPERTS = PEER_NKEYS * PEER_NKEYS
PEER_HALF = 128
PEER_QDIM = 2 * PEER_HALF
PEER_TOPK = 16
PEER_TOK_BLOCK = 128
EPS = 1e-6

kernel_name = 'hymba_gla_pool_peer_adaln_block'


def rmsnorm(x, gain):
    xf = x.astype(jnp.float32)
    y = xf * lax.rsqrt(jnp.mean(xf * xf, axis=-1, keepdims=True) + EPS) * gain.astype(jnp.float32)
    return y.astype(x.dtype)


def modulate(h, shift, scale):
    return h * (1.0 + scale[:, None, :]) + shift[:, None, :]


def gla_chunked(q, k, v, log_a):
    B, S, H, DK = q.shape
    DV = v.shape[-1]
    C = GLA_CHUNK
    N = S // C
    def to_chunks(t):
        return t.astype(jnp.float32).reshape(B, N, C, H, t.shape[-1]).transpose(0, 3, 1, 2, 4)
    q, k, v, log_a = to_chunks(q), to_chunks(k), to_chunks(v), to_chunks(log_a)
    q = q * (DK ** -0.5)
    b = jnp.cumsum(log_a, axis=3)
    b_last = b[:, :, :, -1:, :]
    q_in = q * jnp.exp(b)
    k_in = k * jnp.exp(-b)
    k_st = k * jnp.exp(b_last - b)
    causal = jnp.tril(jnp.ones((C, C), dtype=bool))
    attn = jnp.where(causal, jnp.einsum('bhnid,bhnjd->bhnij', q_in, k_in), 0.0)
    o_intra = jnp.einsum('bhnij,bhnjv->bhniv', attn, v)
    kv = jnp.einsum('bhncd,bhncv->nbhdv', k_st, v)
    decay = jnp.exp(b_last[:, :, :, 0, :]).transpose(2, 0, 1, 3)
    def step(state, inp):
        kv_n, dec_n = inp
        return state * dec_n[..., None] + kv_n, state
    s0 = jnp.zeros((B, H, DK, DV), jnp.float32)
    _, states = lax.scan(step, s0, (kv, decay))
    o_inter = jnp.einsum('bhncd,nbhdv->bhncv', q_in, states)
    o = o_intra + o_inter
    return o.transpose(0, 2, 3, 1, 4).reshape(B, S, H, DV)


def causal_multiscale_pool(p, pool_w, pool_scale):
    B, S, _ = p.shape
    pg = p.astype(jnp.float32).reshape(B, S, POOL_GROUPS, POOL_GW)
    pos = jnp.arange(S)
    outs = []
    for gi, w in enumerate(POOL_WINDOWS):
        xg = pg[:, :, gi]
        cs = jnp.cumsum(xg, axis=1)
        lag = jnp.pad(cs, ((0, 0), (w, 0), (0, 0)))[:, :S]
        count = jnp.minimum(pos + 1, w).astype(jnp.float32)
        outs.append((cs - lag) / count[None, :, None] - xg)
    pooled = jnp.stack(outs, axis=2)
    y = jnp.einsum('bsgc,gcd->bsgd', pooled, pool_w.astype(jnp.float32)).reshape(B, S, POOL_WIDTH)
    return (y * pool_scale.astype(jnp.float32)).astype(p.dtype)


def token_mixer(h, w_in, gla_gate_w, gla_gate_b, gla_norm_g, pool_w, pool_scale, w_out):
    B, S, _ = h.shape
    proj = h @ w_in
    q, k, v, g, p, a_lr = jnp.split(proj, IN_SPLITS, axis=-1)
    log_a = jax.nn.log_sigmoid((a_lr @ gla_gate_w + gla_gate_b).astype(jnp.float32)) / GLA_GATE_NORM
    o = gla_chunked(q.reshape(B, S, GLA_HEADS, GLA_DK), k.reshape(B, S, GLA_HEADS, GLA_DK),
                    v.reshape(B, S, GLA_HEADS, GLA_DV), log_a.reshape(B, S, GLA_HEADS, GLA_DK))
    o = rmsnorm(o, gla_norm_g).astype(h.dtype) * jax.nn.silu(g.reshape(B, S, GLA_HEADS, GLA_DV))
    y_gla = o.reshape(B, S, GLA_VDIM)
    y_pool = causal_multiscale_pool(p, pool_w, pool_scale).astype(h.dtype)
    return jnp.concatenate([y_gla, y_pool], axis=-1) @ w_out


def peer_ffn(h, w_q, sub_k1, sub_k2, expert_u, expert_v):
    B, S, D = h.shape
    T = B * S
    ht = h.reshape(T, D)
    qp = (ht @ w_q).reshape(T, PEER_HEADS, 2, PEER_HALF)
    s1 = jnp.einsum('thk,nk->thn', qp[:, :, 0], sub_k1).astype(jnp.float32)
    s2 = jnp.einsum('thk,nk->thn', qp[:, :, 1], sub_k2).astype(jnp.float32)
    v1, i1 = lax.top_k(s1, PEER_TOPK)
    v2, i2 = lax.top_k(s2, PEER_TOPK)
    cand_s = (v1[..., :, None] + v2[..., None, :]).reshape(T, PEER_HEADS, PEER_TOPK * PEER_TOPK)
    cand_i = (i1[..., :, None] * PEER_NKEYS + i2[..., None, :]).reshape(T, PEER_HEADS, PEER_TOPK * PEER_TOPK)
    top_s, pos = lax.top_k(cand_s, PEER_TOPK)
    idx = jnp.take_along_axis(cand_i, pos, axis=-1)
    gates = jax.nn.softmax(top_s, axis=-1).astype(h.dtype)
    NBLK = T // PEER_TOK_BLOCK
    E = PEER_HEADS * PEER_TOPK
    hb = ht.reshape(NBLK, PEER_TOK_BLOCK, D)
    ib = idx.reshape(NBLK, PEER_TOK_BLOCK, E)
    gb = gates.reshape(NBLK, PEER_TOK_BLOCK, E)
    def expert_block(args):
        xb, eb, wb = args
        act = jax.nn.gelu(jnp.einsum('td,ted->te', xb, expert_u[eb]), approximate=False) * wb
        return jnp.einsum('te,ted->td', act, expert_v[eb])
    out = lax.map(expert_block, (hb, ib, gb))
    return out.reshape(B, S, D)


def setup_inputs(seed: int = 0) -> dict:
    key = jax.random.key(seed)
    ks = jax.random.split(key, 20)
    f32 = jnp.float32
    nrm = lambda k, shape, s: jax.random.normal(k, shape, f32) * s
    L, D = DEPTH, D_MODEL
    return {
        'x': nrm(ks[0], (BATCH, SEQ, D), 1.0),
        'c': nrm(ks[1], (BATCH, D), 1.0),
        'ada_w': nrm(ks[2], (L, D, 6 * D), 0.5 * D ** -0.5),
        'ada_b': nrm(ks[3], (L, 6 * D), 0.02),
        'norm1_g': 1.0 + nrm(ks[4], (L, D), 0.02),
        'w_in': nrm(ks[5], (L, D, IN_COLS), D ** -0.5),
        'gla_gate_w': nrm(ks[6], (L, GLA_GATE_RANK, GLA_KDIM), GLA_GATE_RANK ** -0.5),
        'gla_gate_b': nrm(ks[7], (L, GLA_KDIM), 0.02),
        'gla_norm_g': 1.0 + nrm(ks[8], (L, GLA_DV), 0.02),
        'pool_w': nrm(ks[9], (L, POOL_GROUPS, POOL_GW, POOL_GW), POOL_GW ** -0.5),
        'pool_scale': 1.0 + nrm(ks[10], (L, POOL_WIDTH), 0.02),
        'w_out': nrm(ks[11], (L, D_MIX, D), D_MIX ** -0.5),
        'norm2_g': 1.0 + nrm(ks[12], (L, D), 0.02),
        'peer_wq': nrm(ks[13], (L, D, PEER_HEADS * PEER_QDIM), D ** -0.5),
        'peer_k1': nrm(ks[14], (L, PEER_NKEYS, PEER_HALF), PEER_HALF ** -0.5),
        'peer_k2': nrm(ks[15], (L, PEER_NKEYS, PEER_HALF), PEER_HALF ** -0.5),
        'peer_u': nrm(ks[16], (L, PEER_NEXPERTS, D), D ** -0.5),
        'peer_v': nrm(ks[17], (L, PEER_NEXPERTS, D), PEER_HEADS ** -0.5),
        'final_g': 1.0 + nrm(ks[18], (D,), 0.02),
    }


def reference(x, c, ada_w, ada_b, norm1_g, w_in, gla_gate_w, gla_gate_b, gla_norm_g, pool_w, pool_scale,
              w_out, norm2_g, peer_wq, peer_k1, peer_k2, peer_u, peer_v, final_g):
    for l in range(DEPTH):
        mod = jax.nn.silu(c) @ ada_w[l] + ada_b[l]
        shift1, scale1, gate1, shift2, scale2, gate2 = jnp.split(mod, 6, axis=-1)
        h = modulate(rmsnorm(x, norm1_g[l]), shift1, scale1)
        mix = token_mixer(h, w_in[l], gla_gate_w[l], gla_gate_b[l], gla_norm_g[l], pool_w[l], pool_scale[l], w_out[l])
        x = x + gate1[:, None, :] * mix
        h = modulate(rmsnorm(x, norm2_g[l]), shift2, scale2)
        ffn = peer_ffn(h, peer_wq[l], peer_k1[l], peer_k2[l], peer_u[l], peer_v[l])
        x = x + gate2[:, None, :] * ffn
    return rmsnorm(x, final_g)
```

```cpp
#include <hip/hip_runtime.h>
#include <cstdio>
#include <cstdint>

#define LAS __attribute__((address_space(3)))
#define GAS __attribute__((address_space(1)))
typedef unsigned short bf16_t;
typedef short bf16x8 __attribute__((ext_vector_type(8)));
typedef float f32x4 __attribute__((ext_vector_type(4)));
typedef float f32x2 __attribute__((ext_vector_type(2)));
typedef unsigned u32x4 __attribute__((ext_vector_type(4)));
typedef unsigned u32x2 __attribute__((ext_vector_type(2)));
typedef __bf16 bf16x2_t __attribute__((ext_vector_type(2)));

namespace pg8 {
#define PG8_LAS __attribute__((address_space(3)))
constexpr int BM = 256, BK = 64, HALF = 128, HTB = HALF * BK * 2, STAGE_BYTES = 8 * HTB, NXCD = 8, WGM = 8;
__host__ __device__ __forceinline__ int lds_byte(int r, int c) { const int st = (r >> 4) * 2 + (c >> 5), rr = r & 15, cc = c & 31, ob = rr * 64 + cc * 2; return st * 1024 + (ob ^ (((ob >> 9) & 1) << 5)); }
__host__ __device__ __forceinline__ void stage_rc(int b, int& R, int& C) { const int st = b / 1024, sb = b % 1024, swz = sb ^ (((sb >> 9) & 1) << 5); R = (st >> 1) * 16 + swz / 64; C = (st & 1) * 32 + (swz % 64) / 2; }
__host__ __device__ __forceinline__ int perm32(int rho) { const int n = rho >> 4, i = rho & 15; return 8 * (i >> 2) + 4 * n + (i & 3); }
struct Unit { int pm, pn; };
struct Gemm { const bf16_t* A; const bf16_t* Bt; int M, N, K; };
struct StaticOrder {
    int nM, nN, nwg, G, c;
    __host__ __device__ void init(int M, int N, int G_, int c_) { nM = M / BM; nN = N / BM; nwg = nM * nN; G = G_; c = c_; }
    __host__ __device__ bool next(int i, Unit& u) const {
        const long L = (long)i * G + c; if (L >= nwg) return false;
        int wgid = (int)L; { const int q = nwg / NXCD, r = nwg % NXCD, xcd = wgid % NXCD, off = wgid / NXCD; wgid = (xcd < r ? xcd * (q + 1) : r * (q + 1) + (xcd - r) * q) + off; }
        const int nig = WGM * nN, gid = wgid / nig, fm = gid * WGM, gsz = (nM - fm) < WGM ? (nM - fm) : WGM;
        u.pm = fm + ((wgid % nig) % gsz); u.pn = (wgid % nig) / gsz; return true;
    }
    __device__ __forceinline__ void a_ready(const Unit&) const {}
    __device__ __forceinline__ void done(const Unit&) const {}
};
__device__ __forceinline__ unsigned cvt_pk_bf16(float lo, float hi) { unsigned r; asm volatile("v_cvt_pk_bf16_f32 %0, %1, %2" : "=v"(r) : "v"(lo), "v"(hi)); return r; }

template <class Epi, class Sched, bool ALIGN_EPI = false, bool SP2 = false>
__device__ __forceinline__ void gemm_phase(PG8_LAS unsigned char* lds, const Gemm g, const Sched& S, const Epi& E) {
    const int tid = threadIdx.x, wid = __builtin_amdgcn_readfirstlane(tid >> 6), lane = tid & 63, wr = wid >> 2, wc = wid & 3, fr = lane & 15, fq = lane >> 4;
    const int K = g.K, nt = K / BK;
    unsigned voffA[2], voffB[2];
#pragma unroll
    for (int i = 0; i < 2; ++i) { int R, C; stage_rc(tid * 16 + i * 8192, R, C); const int Rb = Epi::PERM ? ((R & ~31) + perm32(R & 31)) : R;
        voffA[i] = (unsigned)(R * K + C) * 2u; voffB[i] = (unsigned)(Rb * K + C) * 2u; }
    const size_t kstep = (size_t)(BK * 2);
    const size_t hstep = (size_t)HALF * K * 2;
    const size_t tstep = 2 * hstep;
    const unsigned ldsw = (unsigned)wid * 1024u;
    const int aoff = lds_byte(wr * 64 + fr, fq * 8), boff = lds_byte(wc * 32 + fr, fq * 8);
#define PG8_SA(b, h) (((b) * 2 + (h)) * HTB)
#define PG8_SB(b, h) ((4 + (b) * 2 + (h)) * HTB)
#define PG8_STAGE(bufoff, gbase, voff) do { _Pragma("unroll") for (int _i = 0; _i < 2; ++_i) \
        __builtin_amdgcn_global_load_lds((const unsigned*)((const char*)(gbase) + (voff)[_i]), (PG8_LAS unsigned*)(lds + (bufoff) + ldsw + _i * 8192), 16, 0, 0); } while (0)
#define PG8_LDA(dst, b, h) do { _Pragma("unroll") for (int m = 0; m < 4; ++m) _Pragma("unroll") for (int k = 0; k < 2; ++k) dst[m][k] = *(const PG8_LAS bf16x8*)(lds + PG8_SA(b, h) + aoff + m * 2048 + k * 1024); } while (0)
#define PG8_LDB(dst, b, h) do { _Pragma("unroll") for (int n = 0; n < 2; ++n) _Pragma("unroll") for (int k = 0; k < 2; ++k) dst[n][k] = *(const PG8_LAS bf16x8*)(lds + PG8_SB(b, h) + boff + n * 2048 + k * 1024); } while (0)
#define PG8_MMA(ai, bj, At, Bt) do { __builtin_amdgcn_s_setprio(1); _Pragma("unroll") for (int m = 0; m < 4; ++m) _Pragma("unroll") for (int n = 0; n < 2; ++n) _Pragma("unroll") for (int k = 0; k < 2; ++k) \
        acc[ai][bj][m][n] = __builtin_amdgcn_mfma_f32_16x16x32_bf16(Bt[n][k], At[m][k], acc[ai][bj][m][n], 0, 0, 0); __builtin_amdgcn_s_setprio(0); } while (0)
#define PG8_WAIT_V(n) asm volatile("s_waitcnt vmcnt(" #n ")" ::: "memory")
#define PG8_WAIT_L(n) asm volatile("s_waitcnt lgkmcnt(" #n ")" ::: "memory")
#define PG8_BAR __builtin_amdgcn_s_barrier()
#define PG8_SCHED __builtin_amdgcn_sched_barrier(0)
    Unit cur, nxt; int ui = 0;
    if (!S.next(0, cur)) return;
    f32x4 acc[2][2][4][2];
#pragma unroll
    for (int a = 0; a < 2; ++a)
#pragma unroll
        for (int b = 0; b < 2; ++b)
#pragma unroll
            for (int m = 0; m < 4; ++m)
#pragma unroll
                for (int n = 0; n < 2; ++n) acc[a][b][m][n] = (f32x4){0.f, 0.f, 0.f, 0.f};
    bf16x8 At[4][2], B0[2][2], B1[2][2];
    const char* cA = (const char*)g.A + (size_t)cur.pm * tstep; const char* cB = (const char*)g.Bt + (size_t)cur.pn * tstep;
    S.a_ready(cur);
    if constexpr (SP2) {
        PG8_STAGE(PG8_SB(0, 0), cB, voffB); PG8_STAGE(PG8_SB(0, 1), cB + hstep, voffB); PG8_STAGE(PG8_SA(0, 0), cA, voffA); PG8_STAGE(PG8_SA(0, 1), cA + hstep, voffA);
        if (wr == 1) PG8_BAR;
        PG8_WAIT_V(2); PG8_BAR;
        PG8_STAGE(PG8_SB(1, 0), cB + kstep, voffB); PG8_STAGE(PG8_SA(1, 0), cA + kstep, voffA); PG8_STAGE(PG8_SB(1, 1), cB + hstep + kstep, voffB);
        PG8_WAIT_V(6); PG8_BAR;
    } else {
        PG8_STAGE(PG8_SB(0, 0), cB, voffB); PG8_STAGE(PG8_SA(0, 0), cA, voffA); PG8_STAGE(PG8_SB(0, 1), cB + hstep, voffB); PG8_STAGE(PG8_SA(0, 1), cA + hstep, voffA);
        if (wr == 1) PG8_BAR;
        PG8_WAIT_V(4); PG8_BAR;
        PG8_STAGE(PG8_SB(1, 0), cB + kstep, voffB); PG8_STAGE(PG8_SA(1, 0), cA + kstep, voffA); PG8_STAGE(PG8_SB(1, 1), cB + hstep + kstep, voffB);
        PG8_WAIT_V(6); PG8_BAR;
    }
    for (;;) {
        const bool has_next = S.next(ui + 1, nxt);
        const char* nA = has_next ? (const char*)g.A + (size_t)nxt.pm * tstep : cA; const char* nB = has_next ? (const char*)g.Bt + (size_t)nxt.pn * tstep : cB;
        for (int t = 0; t < nt; t += 2) {
            const bool last = (t == nt - 2);
            const char* a1 = cA + (size_t)(t + 1) * kstep;
            const char* a2 = last ? nA : cA + (size_t)(t + 2) * kstep; const char* b2 = last ? nB : cB + (size_t)(t + 2) * kstep;
            const char* a3 = a2 + kstep; const char* b3 = b2 + kstep;
            if (last && has_next) S.a_ready(nxt);
            if constexpr (SP2) {
            PG8_LDB(B0, 0, 0); PG8_LDB(B1, 0, 1); PG8_SCHED; PG8_LDA(At, 0, 0); PG8_STAGE(PG8_SA(1, 1), a1 + hstep, voffA);
            PG8_WAIT_V(8); PG8_WAIT_L(0); PG8_BAR; PG8_MMA(0, 0, At, B0); PG8_MMA(0, 1, At, B1); PG8_BAR; PG8_SCHED;
            PG8_LDA(At, 0, 1); PG8_STAGE(PG8_SB(0, 0), b2, voffB); PG8_STAGE(PG8_SB(0, 1), b2 + hstep, voffB); PG8_STAGE(PG8_SA(0, 0), a2, voffA);
            PG8_WAIT_V(8); PG8_WAIT_L(0); PG8_BAR; PG8_MMA(1, 0, At, B0); PG8_MMA(1, 1, At, B1); PG8_BAR; PG8_SCHED;
            PG8_LDB(B0, 1, 0); PG8_LDB(B1, 1, 1); PG8_SCHED; PG8_LDA(At, 1, 0); PG8_STAGE(PG8_SA(0, 1), a2 + hstep, voffA);
            PG8_WAIT_V(8); PG8_WAIT_L(0); PG8_BAR; PG8_MMA(0, 0, At, B0); PG8_MMA(0, 1, At, B1); PG8_BAR; PG8_SCHED;
            PG8_LDA(At, 1, 1); PG8_STAGE(PG8_SB(1, 0), b3, voffB); PG8_STAGE(PG8_SB(1, 1), b3 + hstep, voffB); PG8_STAGE(PG8_SA(1, 0), a3, voffA);
            PG8_WAIT_V(8); PG8_WAIT_L(0); PG8_BAR; PG8_MMA(1, 0, At, B0); PG8_MMA(1, 1, At, B1); PG8_BAR; PG8_SCHED;
            } else {
            PG8_LDB(B0, 0, 0); PG8_SCHED; PG8_LDA(At, 0, 0); PG8_STAGE(PG8_SA(1, 1), a1 + hstep, voffA);
            PG8_WAIT_L(8); PG8_BAR; PG8_WAIT_L(0); PG8_MMA(0, 0, At, B0); PG8_BAR; PG8_SCHED;
            PG8_LDB(B1, 0, 1); PG8_STAGE(PG8_SB(0, 0), b2, voffB);
            PG8_BAR; PG8_WAIT_L(0); PG8_MMA(0, 1, At, B1); PG8_BAR;
            PG8_LDA(At, 0, 1); PG8_STAGE(PG8_SA(0, 0), a2, voffA);
            PG8_BAR; PG8_WAIT_L(0); PG8_MMA(1, 0, At, B0); PG8_BAR; PG8_SCHED;
            PG8_STAGE(PG8_SB(0, 1), b2 + hstep, voffB);
            PG8_WAIT_V(6); PG8_BAR; PG8_MMA(1, 1, At, B1); PG8_BAR;
            PG8_LDB(B0, 1, 0); PG8_SCHED; PG8_LDA(At, 1, 0); PG8_STAGE(PG8_SA(0, 1), a2 + hstep, voffA);
            PG8_WAIT_L(8); PG8_BAR; PG8_WAIT_L(0); PG8_MMA(0, 0, At, B0); PG8_BAR; PG8_SCHED;
            PG8_LDB(B1, 1, 1); PG8_STAGE(PG8_SB(1, 0), b3, voffB);
            PG8_BAR; PG8_WAIT_L(0); PG8_MMA(0, 1, At, B1); PG8_BAR;
            PG8_LDA(At, 1, 1); PG8_STAGE(PG8_SA(1, 0), a3, voffA);
            PG8_BAR; PG8_WAIT_L(0); PG8_MMA(1, 0, At, B0); PG8_BAR; PG8_SCHED;
            PG8_STAGE(PG8_SB(1, 1), b3 + hstep, voffB);
            PG8_WAIT_V(6); PG8_BAR; PG8_MMA(1, 1, At, B1); PG8_BAR;
            }
        }
        if constexpr (ALIGN_EPI) { if (wr == 0) PG8_BAR; }
        E(acc, cur, wr, wc, fr, fq); S.done(cur);
        if (!has_next) break;
#pragma unroll
        for (int a = 0; a < 2; ++a)
#pragma unroll
            for (int b = 0; b < 2; ++b)
#pragma unroll
                for (int m = 0; m < 4; ++m)
#pragma unroll
                    for (int n = 0; n < 2; ++n) acc[a][b][m][n] = (f32x4){0.f, 0.f, 0.f, 0.f};
        cur = nxt; cA = nA; cB = nB; ++ui;
        if constexpr (ALIGN_EPI) { if (wr == 1) PG8_BAR; }
    }
    PG8_WAIT_V(0);
    if constexpr (!ALIGN_EPI) { if (wr == 0) PG8_BAR; }
    PG8_BAR;
#undef PG8_SA
#undef PG8_SB
#undef PG8_STAGE
#undef PG8_LDA
#undef PG8_LDB
#undef PG8_MMA
#undef PG8_WAIT_V
#undef PG8_WAIT_L
#undef PG8_BAR
#undef PG8_SCHED
}
}

constexpr int NB = 2, SEQ = 8192, D = 1024, M = NB * SEQ;
constexpr int NPROJ = 2048, NIN = 2304, INLD = 2064;
constexpr int NUNIT = 1024;
constexpr int NEXP = 16384;
constexpr size_t MiB = 1u << 20;
constexpr size_t WS_CTL = 0, CTL_ZERO_BYTES = 64 * 1024;
constexpr size_t WS_MOD = 1 * MiB;
constexpr size_t WS_DEC = 1 * MiB + 512 * 1024;
constexpr size_t WS_WIN = 2 * MiB;
constexpr size_t WS_WOUT = 7 * MiB;
constexpr size_t WS_WQ = 9 * MiB;
constexpr size_t WS_KK = 13 * MiB;
constexpr size_t WS_IDX = 14 * MiB;
constexpr size_t WS_GATE = 22 * MiB;
constexpr size_t WS_LOGA = 30 * MiB;
constexpr size_t WS_KV = 46 * MiB;
constexpr size_t WS_H = 78 * MiB;
constexpr size_t WS_U16 = 110 * MiB;
constexpr size_t WS_V16 = 142 * MiB;
constexpr size_t WS_PROJ = 174 * MiB;
constexpr size_t WS_END = 238 * MiB;
constexpr int CW_BAR = 1024;
constexpr int NWAVES = 8, NTHR = 512;
constexpr int LDS_BYTES = 147456, MISC_OFF = 147456 - 256;

#define XB_TMO      128
#define XB_XCNT(j)  (256  + 64 * (j))
#define XB_XSUB(j)  (1280 + 64 * (j))
#define XB_XGEN(j)  (2304 + 64 * (j))
#define XB_TOP      3328
#define XB_TOPGEN   3392
#define XCD_BAR_WORDS 3456
#define XB_SPIN_CAP (1u << 20)
__device__ __forceinline__ unsigned xb_ld(unsigned* p)              { return __hip_atomic_load(p, __ATOMIC_RELAXED, __HIP_MEMORY_SCOPE_AGENT); }
__device__ __forceinline__ unsigned xb_add(unsigned* p, unsigned v) { return __hip_atomic_fetch_add(p, v, __ATOMIC_RELAXED, __HIP_MEMORY_SCOPE_AGENT); }
__device__ __forceinline__ unsigned xb_xcc_id() { return (unsigned)__builtin_amdgcn_s_getreg((3 << 11) | 20) & 0xFu; }
#define XB_SPIN(cond, bar) do { unsigned _sp = 0; while (cond) { __builtin_amdgcn_s_sleep(1); \
    if ((++_sp & 255u) == 0u) { if (xb_ld(&(bar)[XB_TMO])) break; if (_sp > XB_SPIN_CAP) { atomicAdd(&(bar)[XB_TMO], 1u); break; } } } } while (0)
struct XcdBarrier { unsigned* bar; unsigned x; volatile LAS unsigned* st; };
__device__ __forceinline__ XcdBarrier xcd_barrier_post(unsigned* bar, volatile LAS unsigned* st) {
    XcdBarrier b; b.bar = bar; b.x = xb_xcc_id(); b.st = st;
    if (threadIdx.x == 0) (void)xb_add(&bar[XB_XCNT(b.x)], 1u);
    return b;
}
__device__ __forceinline__ void xcd_barrier_complete(unsigned* bar, unsigned x, unsigned& nloc, unsigned& nx) {
    const unsigned G = gridDim.x * gridDim.y * gridDim.z;
    unsigned sum, cnt, mine, sp = 0u;
    for (;;) {
        sum = 0u; cnt = 0u; mine = 0u;
#pragma unroll
        for (unsigned j = 0; j < 16; ++j) { const unsigned c = xb_ld(&bar[XB_XCNT(j)]); sum += c; cnt += (c > 0u) ? 1u : 0u; mine = (j == x) ? c : mine; }
        if (sum == G) break;
        __builtin_amdgcn_s_sleep(1);
        if ((++sp & 255u) == 0u) { if (xb_ld(&bar[XB_TMO])) break; if (sp > XB_SPIN_CAP) { atomicAdd(&bar[XB_TMO], 1u); break; } }
    }
    nloc = mine > 0u ? mine : 1u; nx = cnt > 0u ? cnt : 1u;
}
__device__ __forceinline__ void xcd_barrier(const XcdBarrier& b) {
    asm volatile("s_waitcnt vmcnt(0)" ::: "memory");
    __syncthreads();
    if (threadIdx.x == 0) {
        unsigned* bar = b.bar;
        __builtin_amdgcn_s_waitcnt(0);
        unsigned nloc = b.st[0], nx = b.st[1];
        if (nloc == 0u) { xcd_barrier_complete(bar, b.x, nloc, nx); b.st[0] = nloc; b.st[1] = nx; }
        const unsigned old = xb_add(&bar[XB_XSUB(b.x)], 1u);
        const unsigned gen = old / nloc;
        if (old + 1u == (gen + 1u) * nloc) {
            __builtin_amdgcn_fence(__ATOMIC_RELEASE, "agent");
            asm volatile("s_waitcnt vmcnt(0)" ::: "memory");
            const unsigned og = xb_add(&bar[XB_TOP], 1u);
            const unsigned tg = og / nx;
            if (og + 1u == (tg + 1u) * nx) xb_add(&bar[XB_TOPGEN], 1u);
            else XB_SPIN(xb_ld(&bar[XB_TOPGEN]) == tg, bar);
            __builtin_amdgcn_fence(__ATOMIC_ACQUIRE, "agent");
            xb_add(&bar[XB_XGEN(b.x)], 1u);
            asm volatile("s_waitcnt vmcnt(0)" ::: "memory");
        } else {
            XB_SPIN(xb_ld(&bar[XB_XGEN(b.x)]) == gen, bar);
            __builtin_amdgcn_fence(__ATOMIC_ACQUIRE, "agent");
            asm volatile("s_waitcnt vmcnt(0)" ::: "memory");
        }
    }
    __syncthreads();
}

__device__ __forceinline__ unsigned f2bf(float f) { unsigned u = __builtin_bit_cast(unsigned, f); return (u + 0x7fffu + ((u >> 16) & 1u)) >> 16; }
__device__ __forceinline__ unsigned pk2(float lo, float hi) { return f2bf(lo) | (f2bf(hi) << 16); }
__device__ __forceinline__ float bflo(unsigned w) { return __builtin_bit_cast(float, w << 16); }
__device__ __forceinline__ float bfhi(unsigned w) { return __builtin_bit_cast(float, w & 0xffff0000u); }
__device__ __forceinline__ float wave_sum(float v) {
#pragma unroll
    for (int o = 1; o < 64; o <<= 1) v += __shfl_xor(v, o);
    return v;
}
__device__ __forceinline__ float silu_f(float x) { return x / (1.f + __expf(-x)); }
__device__ __forceinline__ float logsig_f(float x) { return fminf(x, 0.f) - log1pf(__expf(-fabsf(x))); }
__device__ __forceinline__ float gelu_f(float x) { return 0.5f * x * (1.f + erff(x * 0.70710678118654752f)); }

struct Params { const float* in[19]; float* out; unsigned char* ws; int ph_lo, ph_hi; };

struct EpiProj {
    static constexpr bool PERM = true;
    bf16_t* P; float* LA; const float* gb;
    __device__ __forceinline__ void operator()(const f32x4 (&acc)[2][2][4][2], const pg8::Unit& u, int wr, int wc, int fr, int fq) const {
        const int row0 = u.pm * 256 + wr * 64 + fr;
        if (u.pn < 8) {
            const int col0 = u.pn * 256 + wc * 32 + 8 * fq;
#pragma unroll
            for (int ai = 0; ai < 2; ++ai)
#pragma unroll
                for (int m = 0; m < 4; ++m) { bf16_t* rowp = P + (size_t)(row0 + ai * 128 + m * 16) * NPROJ + col0;
#pragma unroll
                    for (int bj = 0; bj < 2; ++bj) { const f32x4 v0 = acc[ai][bj][m][0], v1 = acc[ai][bj][m][1];
                        u32x4 w; w.x = pg8::cvt_pk_bf16(v0[0], v0[1]); w.y = pg8::cvt_pk_bf16(v0[2], v0[3]); w.z = pg8::cvt_pk_bf16(v1[0], v1[1]); w.w = pg8::cvt_pk_bf16(v1[2], v1[3]);
                        *(u32x4*)(rowp + bj * 128) = w; } }
        } else {
            const int col0 = wc * 32 + 8 * fq;
            f32x4 bv[2][2];
#pragma unroll
            for (int bj = 0; bj < 2; ++bj)
#pragma unroll
                for (int n = 0; n < 2; ++n) bv[bj][n] = *(const f32x4*)(gb + col0 + bj * 128 + 4 * n);
#pragma unroll
            for (int ai = 0; ai < 2; ++ai)
#pragma unroll
                for (int m = 0; m < 4; ++m) { float* rowp = LA + (size_t)(row0 + ai * 128 + m * 16) * 256 + col0;
#pragma unroll
                    for (int bj = 0; bj < 2; ++bj)
#pragma unroll
                        for (int n = 0; n < 2; ++n) { const f32x4 v = acc[ai][bj][m][n] + bv[bj][n]; f32x4 o;
#pragma unroll
                            for (int j = 0; j < 4; ++j) o[j] = logsig_f(v[j]) * (1.0f / 16.0f);
                            *(f32x4*)(rowp + bj * 128 + 4 * n) = o; } }
        }
    }
};
struct EpiX1 {
    static constexpr bool PERM = false;
    const float* x; float* X1; const float* gate;
    __device__ __forceinline__ void operator()(const f32x4 (&acc)[2][2][4][2], const pg8::Unit& u, int wr, int wc, int fr, int fq) const {
        const int row0 = u.pm * 256 + wr * 64 + fr, col0 = u.pn * 256 + wc * 32 + 4 * fq;
        const float* gp = gate + (u.pm >= 32 ? 6144 : 0);
        f32x4 gv[2][2];
#pragma unroll
        for (int bj = 0; bj < 2; ++bj)
#pragma unroll
            for (int n = 0; n < 2; ++n) gv[bj][n] = *(const f32x4*)(gp + col0 + bj * 128 + n * 16);
#pragma unroll
        for (int ai = 0; ai < 2; ++ai)
#pragma unroll
            for (int m = 0; m < 4; ++m) { const size_t ro = (size_t)(row0 + ai * 128 + m * 16) * D + col0;
#pragma unroll
                for (int bj = 0; bj < 2; ++bj)
#pragma unroll
                    for (int n = 0; n < 2; ++n) { const f32x4 xv = *(const f32x4*)(x + ro + bj * 128 + n * 16);
                        *(f32x4*)(X1 + ro + bj * 128 + n * 16) = xv + gv[bj][n] * acc[ai][bj][m][n]; } }
    }
};
struct EpiQ {
    static constexpr bool PERM = true;
    bf16_t* Q;
    __device__ __forceinline__ void operator()(const f32x4 (&acc)[2][2][4][2], const pg8::Unit& u, int wr, int wc, int fr, int fq) const {
        const int row0 = u.pm * 256 + wr * 64 + fr, col0 = u.pn * 256 + wc * 32 + 8 * fq;
#pragma unroll
        for (int ai = 0; ai < 2; ++ai)
#pragma unroll
            for (int m = 0; m < 4; ++m) { bf16_t* rowp = Q + (size_t)(row0 + ai * 128 + m * 16) * 2048 + col0;
#pragma unroll
                for (int bj = 0; bj < 2; ++bj) { const f32x4 v0 = acc[ai][bj][m][0], v1 = acc[ai][bj][m][1];
                    u32x4 w; w.x = pg8::cvt_pk_bf16(v0[0], v0[1]); w.y = pg8::cvt_pk_bf16(v0[2], v0[3]); w.z = pg8::cvt_pk_bf16(v1[0], v1[1]); w.w = pg8::cvt_pk_bf16(v1[2], v1[3]);
                    *(u32x4*)(rowp + bj * 128) = w; } }
    }
};

__device__ __forceinline__ void transpose_item(const float* W, int ldw, int k0, int n0, bf16_t* WT, int ldt, int row0, LAS float* scr, int lane) {
#pragma unroll 8
    for (int i = 0; i < 32; ++i) { const int kk = 2 * i + (lane >> 5); scr[kk * 33 + (lane & 31)] = W[(size_t)(k0 + kk) * ldw + n0 + (lane & 31)]; }
    asm volatile("s_waitcnt lgkmcnt(0)" ::: "memory");
    const int c = lane & 7;
#pragma unroll
    for (int j = 0; j < 4; ++j) { const int n = (lane >> 3) + 8 * j; const LAS float* s = scr + (8 * c) * 33 + n;
        u32x4 o; o.x = pk2(s[0 * 33], s[1 * 33]); o.y = pk2(s[2 * 33], s[3 * 33]); o.z = pk2(s[4 * 33], s[5 * 33]); o.w = pk2(s[6 * 33], s[7 * 33]);
        *(u32x4*)(WT + (size_t)(row0 + n0 + n) * ldt + k0 + 8 * c) = o; }
    asm volatile("s_waitcnt lgkmcnt(0)" ::: "memory");
}

__device__ __forceinline__ void norm_mod_row(const float* xrow, const float* g, const float* shift, const float* scale, bf16_t* orow, int lane) {
    f32x4 v[4]; float s = 0.f;
#pragma unroll
    for (int j = 0; j < 4; ++j) { v[j] = *(const f32x4*)(xrow + 4 * lane + 256 * j); s += (v[j].x * v[j].x + v[j].y * v[j].y) + (v[j].z * v[j].z + v[j].w * v[j].w); }
    const float rstd = 1.f / sqrtf(wave_sum(s) * (1.f / D) + 1e-6f);
#pragma unroll
    for (int j = 0; j < 4; ++j) { const int c = 4 * lane + 256 * j;
        const f32x4 gg = *(const f32x4*)(g + c), sh = *(const f32x4*)(shift + c), sc = *(const f32x4*)(scale + c);
        const f32x4 y = v[j] * rstd * gg * (sc + 1.0f) + sh;
        u32x2 o; o.x = pk2(y.x, y.y); o.y = pk2(y.z, y.w);
        *(u32x2*)(orow + c) = o; }
}

__constant__ unsigned char CAND_IJ[64] = {
    0x00,0x01,0x02,0x03,0x04,0x05,0x06,0x07,0x08,0x09,0x0a,0x0b,0x0c,0x0d,0x0e,0x0f,
    0x10,0x11,0x12,0x13,0x14,0x15,0x16,0x17,
    0x20,0x21,0x22,0x23,0x24,
    0x30,0x31,0x32,0x33,
    0x40,0x41,0x42,
    0x50,0x51, 0x60,0x61, 0x70,0x71,
    0x80,0x90,0xa0,0xb0,0xc0,0xd0,0xe0,0xf0,
    0,0,0,0,0,0,0,0,0,0,0,0,0,0};

__device__ __forceinline__ unsigned fkey(float f, unsigned idbits, unsigned idmask) {
    unsigned u = __builtin_bit_cast(unsigned, f); u = (u & 0x80000000u) ? ~u : (u | 0x80000000u);
    return (u & ~idmask) | idbits;
}
__device__ __forceinline__ float fkey_val(unsigned key, unsigned idmask) {
    unsigned u = key & ~idmask; u = (u & 0x80000000u) ? (u ^ 0x80000000u) : ~u;
    return __builtin_bit_cast(float, u);
}
template <int CTRL, int ROWMASK> __device__ __forceinline__ unsigned dpp_u(unsigned v) { return (unsigned)__builtin_amdgcn_update_dpp(0, (int)v, CTRL, ROWMASK, 0xF, true); }
template <int CTRL, int ROWMASK> __device__ __forceinline__ float dpp_f(float v) { return __builtin_bit_cast(float, __builtin_amdgcn_update_dpp(0, __builtin_bit_cast(int, v), CTRL, ROWMASK, 0xF, true)); }
__device__ __forceinline__ unsigned umax_(unsigned a, unsigned b) { return a > b ? a : b; }

__global__ void __launch_bounds__(NTHR, 2) fwd_kernel(Params p) {
    extern __shared__ __attribute__((aligned(16))) unsigned char lds_raw[];
    LAS unsigned char* lds = (LAS unsigned char*)lds_raw;
    const int tid = threadIdx.x, lane = tid & 63, wave = __builtin_amdgcn_readfirstlane(tid >> 6);
    const int G = gridDim.x, bx = blockIdx.x;
    const int gw = bx * NWAVES + wave, NGW = G * NWAVES;
    unsigned char* ws = p.ws;
    unsigned* ctl = (unsigned*)(ws + WS_CTL);
    float* MOD = (float*)(ws + WS_MOD);
    float* DEC = (float*)(ws + WS_DEC);
    bf16_t* WIN = (bf16_t*)(ws + WS_WIN);
    bf16_t* WOUT = (bf16_t*)(ws + WS_WOUT);
    bf16_t* WQ = (bf16_t*)(ws + WS_WQ);
    bf16_t* KK = (bf16_t*)(ws + WS_KK);
    int* IDX = (int*)(ws + WS_IDX);
    float* GATE = (float*)(ws + WS_GATE);
    float* LOGA = (float*)(ws + WS_LOGA);
    float* KV = (float*)(ws + WS_KV);
    bf16_t* H = (bf16_t*)(ws + WS_H);
    bf16_t* U16 = (bf16_t*)(ws + WS_U16);
    bf16_t* V16 = (bf16_t*)(ws + WS_V16);
    bf16_t* PROJ = (bf16_t*)(ws + WS_PROJ);
    const float* x = p.in[0]; const float* cvec = p.in[1]; const float* ada_w = p.in[2]; const float* ada_b = p.in[3]; const float* norm1_g = p.in[4];
    const float* w_in = p.in[5]; const float* gate_w = p.in[6]; const float* gate_b = p.in[7]; const float* gla_norm_g = p.in[8];
    const float* pool_w = p.in[9]; const float* pool_scale = p.in[10]; const float* w_out = p.in[11]; const float* norm2_g = p.in[12];
    const float* peer_wq = p.in[13]; const float* peer_k1 = p.in[14]; const float* peer_k2 = p.in[15]; const float* peer_u = p.in[16]; const float* peer_v = p.in[17];
    const float* final_g = p.in[18];
    float* X1 = p.out;

    volatile LAS unsigned* MISC = (volatile LAS unsigned*)(lds + MISC_OFF);
    if (tid < 64) MISC[tid] = 0u;
    __syncthreads();
    XcdBarrier bar = xcd_barrier_post(ctl + CW_BAR, MISC + 8);
    const int lo = p.ph_lo, hi = p.ph_hi;
#define IN(k) (lo <= (k) && (k) < hi)
#define SEAM(k) do { if (IN(k) && IN((k) + 1)) xcd_barrier(bar); } while (0)

    if (IN(0)) {
        {
            LAS float* sc = (LAS float*)lds;
            LAS f32x4* red = (LAS f32x4*)(lds + 8192);
            for (int i = tid; i < 2048; i += NTHR) sc[i] = silu_f(cvec[i]);
            __syncthreads();
            for (int cb = bx; cb < 256; cb += G) {
                if (tid < 384) {
                    const int f4 = tid % 6, rg = tid / 6;
                    f32x4 a0 = {0.f, 0.f, 0.f, 0.f}, a1 = {0.f, 0.f, 0.f, 0.f};
#pragma unroll 4
                    for (int i = 0; i < 16; ++i) { const int r = rg + 64 * i; const f32x4 w = *(const f32x4*)(ada_w + (size_t)r * 6144 + 24 * cb + 4 * f4);
                        a0 += w * sc[r]; a1 += w * sc[1024 + r]; }
                    red[(rg * 6 + f4) * 2 + 0] = a0; red[(rg * 6 + f4) * 2 + 1] = a1;
                }
                __syncthreads();
                if (tid < 48) { const int b = tid / 24, col = tid % 24; float s = 0.f;
                    for (int rg = 0; rg < 64; ++rg) s += red[(rg * 6 + (col >> 2)) * 2 + b][col & 3];
                    MOD[b * 6144 + 24 * cb + col] = s + ada_b[24 * cb + col]; }
                __syncthreads();
            }
        }
        for (int it = bx; it < 128; it += G) {
            const int g = it >> 5, nb = (it >> 1) & 15, cb = it & 1;
            LAS float* PW = (LAS float*)lds;
            LAS float* WO = (LAS float*)(lds + 32768);
            for (int i = tid; i < 64 * 128; i += NTHR) { const int c = i >> 7, j = i & 127; PW[i] = pool_w[(size_t)(g * 128 + cb * 64 + c) * 128 + j] * pool_scale[g * 128 + j]; }
            for (int i = tid; i < 128 * 64; i += NTHR) { const int j = i >> 6, n = i & 63; WO[i] = w_out[(size_t)(512 + g * 128 + j) * 1024 + nb * 64 + n]; }
            __syncthreads();
            const int n = tid & 63, cg = tid >> 6;
            float a[8];
#pragma unroll
            for (int q = 0; q < 8; ++q) a[q] = 0.f;
            for (int j = 0; j < 128; ++j) { const float wo = WO[j * 64 + n];
#pragma unroll
                for (int q = 0; q < 8; ++q) a[q] += PW[(cg * 8 + q) * 128 + j] * wo; }
            u32x4 o; o.x = pk2(a[0], a[1]); o.y = pk2(a[2], a[3]); o.z = pk2(a[4], a[5]); o.w = pk2(a[6], a[7]);
            *(u32x4*)(WOUT + (size_t)(nb * 64 + n) * 1024 + 512 + g * 128 + cb * 64 + cg * 8) = o;
            __syncthreads();
        }
        {
            LAS float* scr = (LAS float*)(lds + wave * 16384);
            constexpr int I_IN = 16 * 64, I_Q = 16 * 64, I_O = 8 * 32;
            for (int it = gw; it < I_IN + I_Q + I_O; it += NGW) {
                int r = it;
                if (r < I_IN) { transpose_item(w_in, INLD, (r >> 6) * 64, (r & 63) * 32, WIN, 1024, 0, scr, lane); continue; } r -= I_IN;
                if (r < I_Q) { transpose_item(peer_wq, 2048, (r >> 6) * 64, (r & 63) * 32, WQ, 1024, 0, scr, lane); continue; } r -= I_Q;
                transpose_item(w_out, 1024, (r >> 5) * 64, (r & 31) * 32, WOUT, 1024, 0, scr, lane);
            }
        }
        for (int o = bx * NTHR + tid; o < 256 * 1024; o += G * NTHR) { const int j = o >> 10, k = o & 1023; float s = 0.f;
#pragma unroll
            for (int r = 0; r < 16; ++r) s += w_in[(size_t)k * INLD + 2048 + r] * gate_w[r * 256 + j];
            WIN[(size_t)(2048 + j) * 1024 + k] = (bf16_t)f2bf(s); }
        for (size_t i = (size_t)bx * NTHR + tid; i < (size_t)NEXP * 1024 / 8; i += (size_t)G * NTHR) {
            { const f32x4 a = *(const f32x4*)(peer_u + i * 8), b = *(const f32x4*)(peer_u + i * 8 + 4); u32x4 o; o.x = pk2(a.x, a.y); o.y = pk2(a.z, a.w); o.z = pk2(b.x, b.y); o.w = pk2(b.z, b.w); *(u32x4*)(U16 + i * 8) = o; }
            { const f32x4 a = *(const f32x4*)(peer_v + i * 8), b = *(const f32x4*)(peer_v + i * 8 + 4); u32x4 o; o.x = pk2(a.x, a.y); o.y = pk2(a.z, a.w); o.z = pk2(b.x, b.y); o.w = pk2(b.z, b.w); *(u32x4*)(V16 + i * 8) = o; }
        }
        for (int i = bx * NTHR + tid; i < 2 * 128 * 128; i += G * NTHR) KK[i] = (bf16_t)f2bf(i < 16384 ? peer_k1[i] : peer_k2[i - 16384]);
    }
    SEAM(0);

    if (IN(1)) {
        for (int m = gw; m < M; m += NGW) { const float* md = MOD + (m >= SEQ ? 6144 : 0); norm_mod_row(x + (size_t)m * D, norm1_g, md, md + 1024, H + (size_t)m * D, lane); }
    }
    SEAM(1);

    if (IN(2)) {
        pg8::Gemm g{H, WIN, M, NIN, D}; pg8::StaticOrder S; S.init(M, NIN, G, bx);
        EpiProj E{PROJ, LOGA, gate_b};
        pg8::gemm_phase<EpiProj, pg8::StaticOrder, true, true>(lds, g, S, E);
    }
    SEAM(2);

    if (IN(3)) {
        const int hb = tid >> 8, ht = tid & 255;
        LAS float* LAT = (LAS float*)(lds + hb * 69632);
        LAS float* KST = (LAS float*)(lds + hb * 69632 + 16640);
        LAS float* VV = (LAS float*)(lds + hb * 69632 + 16640 + 17408);
        for (int it = 0; it < (NUNIT + 2 * G - 1) / (2 * G); ++it) {
            const int u = (it * G + bx) * 2 + hb;
            const bool act = u < NUNIT;
            const int h = u & 3, t0 = (u >> 2) * 64;
            const int c = ht & 63, dc = ht >> 6;
            if (act) {
                const float* la = LOGA + (size_t)(t0 + c) * 256 + h * 64 + dc * 16;
#pragma unroll
                for (int q = 0; q < 4; ++q) { const f32x4 v = *(const f32x4*)(la + 4 * q);
#pragma unroll
                    for (int j = 0; j < 4; ++j) LAT[(dc * 16 + q * 4 + j) * 65 + c] = v[j]; }
            }
            __syncthreads();
            if (act && ht < 64) { float b = 0.f; for (int i = 0; i < 64; ++i) { b += LAT[ht * 65 + i]; LAT[ht * 65 + i] = b; } DEC[u * 64 + ht] = __expf(b); }
            __syncthreads();
            if (act) {
                const bf16_t* kp = PROJ + (size_t)(t0 + c) * NPROJ + 256 + h * 64 + dc * 16;
                const u32x4 k0 = *(const u32x4*)kp, k1 = *(const u32x4*)(kp + 8);
                const unsigned kw[8] = {k0.x, k0.y, k0.z, k0.w, k1.x, k1.y, k1.z, k1.w};
#pragma unroll
                for (int q = 0; q < 8; ++q) { const int d = dc * 16 + 2 * q;
                    KST[c * 68 + d] = bflo(kw[q]) * __expf(LAT[d * 65 + 63] - LAT[d * 65 + c]);
                    KST[c * 68 + d + 1] = bfhi(kw[q]) * __expf(LAT[(d + 1) * 65 + 63] - LAT[(d + 1) * 65 + c]); }
                const bf16_t* vp = PROJ + (size_t)(t0 + c) * NPROJ + 512 + h * 128 + dc * 32;
#pragma unroll
                for (int q = 0; q < 4; ++q) { const u32x4 w = *(const u32x4*)(vp + 8 * q);
                    f32x4 a = {bflo(w.x), bfhi(w.x), bflo(w.y), bfhi(w.y)}, b = {bflo(w.z), bfhi(w.z), bflo(w.w), bfhi(w.w)};
                    *(LAS f32x4*)(VV + c * 132 + dc * 32 + 8 * q) = a; *(LAS f32x4*)(VV + c * 132 + dc * 32 + 8 * q + 4) = b; }
            }
            __syncthreads();
            if (act) {
                const int tv = ht & 31, td = ht >> 5;
                f32x4 a[8];
#pragma unroll
                for (int q = 0; q < 8; ++q) a[q] = (f32x4){0.f, 0.f, 0.f, 0.f};
                for (int cc = 0; cc < 64; ++cc) {
                    const f32x4 vv = *(const LAS f32x4*)(VV + cc * 132 + 4 * tv);
                    const f32x4 ka = *(const LAS f32x4*)(KST + cc * 68 + 8 * td), kb = *(const LAS f32x4*)(KST + cc * 68 + 8 * td + 4);
                    a[0] += vv * ka.x; a[1] += vv * ka.y; a[2] += vv * ka.z; a[3] += vv * ka.w;
                    a[4] += vv * kb.x; a[5] += vv * kb.y; a[6] += vv * kb.z; a[7] += vv * kb.w;
                }
                float* kvp = KV + (size_t)u * 8192 + (8 * td) * 128 + 4 * tv;
#pragma unroll
                for (int q = 0; q < 8; ++q) *(f32x4*)(kvp + q * 128) = a[q];
            }
            __syncthreads();
        }
        for (int it = bx * NTHR + tid; it < (M / 8) * 64; it += G * NTHR) {
            const int cv = it & 63, run = it >> 6, ch = cv * 8, gq = ch >> 7, w = 2 << gq;
            const int t0 = run * 8, pos0 = t0 & (SEQ - 1);
            const bf16_t* pp = PROJ + 1536 + ch;
            float s[8];
#pragma unroll
            for (int j = 0; j < 8; ++j) s[j] = 0.f;
            for (int q = 1; q <= w; ++q) if (pos0 - q >= 0) { const u32x4 v = *(const u32x4*)(pp + (size_t)(t0 - q) * NPROJ);
                s[0] += bflo(v.x); s[1] += bfhi(v.x); s[2] += bflo(v.y); s[3] += bfhi(v.y); s[4] += bflo(v.z); s[5] += bfhi(v.z); s[6] += bflo(v.w); s[7] += bfhi(v.w); }
            for (int r = 0; r < 8; ++r) {
                const int t = t0 + r, pos = pos0 + r;
                const u32x4 v = *(const u32x4*)(pp + (size_t)t * NPROJ);
                const float cur[8] = {bflo(v.x), bfhi(v.x), bflo(v.y), bfhi(v.y), bflo(v.z), bfhi(v.z), bflo(v.w), bfhi(v.w)};
#pragma unroll
                for (int j = 0; j < 8; ++j) s[j] += cur[j];
                if (pos >= w) { const u32x4 o = *(const u32x4*)(pp + (size_t)(t - w) * NPROJ);
                    s[0] -= bflo(o.x); s[1] -= bfhi(o.x); s[2] -= bflo(o.y); s[3] -= bfhi(o.y); s[4] -= bflo(o.z); s[5] -= bfhi(o.z); s[6] -= bflo(o.w); s[7] -= bfhi(o.w); }
                const float inv = 1.f / (float)((pos + 1) < w ? (pos + 1) : w);
                u32x4 ov; ov.x = pk2(s[0] * inv - cur[0], s[1] * inv - cur[1]); ov.y = pk2(s[2] * inv - cur[2], s[3] * inv - cur[3]);
                ov.z = pk2(s[4] * inv - cur[4], s[5] * inv - cur[5]); ov.w = pk2(s[6] * inv - cur[6], s[7] * inv - cur[7]);
                *(u32x4*)(H + (size_t)t * D + 512 + ch) = ov;
            }
        }
    }
    SEAM(3);

    if (IN(4)) {
        for (int sq = bx * NTHR + tid; sq < 8 * 8192; sq += G * NTHR) {
            const int bh = sq >> 13, e = sq & 8191, b = bh >> 2, h = bh & 3, d = e >> 7;
            float st = 0.f;
            for (int n0 = 0; n0 < 128; n0 += 8) {
                float kv[8], dc[8];
#pragma unroll
                for (int q = 0; q < 8; ++q) { const int u = ((b * 128 + n0 + q) * 4 + h); kv[q] = KV[(size_t)u * 8192 + e]; dc[q] = DEC[u * 64 + d]; }
#pragma unroll
                for (int q = 0; q < 8; ++q) { const int u = ((b * 128 + n0 + q) * 4 + h); KV[(size_t)u * 8192 + e] = st; st = st * dc[q] + kv[q]; }
            }
        }
    }
    SEAM(4);

    if (IN(5)) {
        LAS float* LAT = (LAS float*)lds;
        LAS float* QIT = (LAS float*)(lds + 16640);
        LAS float* KIT = (LAS float*)(lds + 16640 + 16384);
        LAS float* VV = (LAS float*)(lds + 16640 + 32768);
        LAS float* ST = (LAS float*)(lds + 16640 + 32768 + 32768);
        for (int u = bx; u < NUNIT; u += G) {
            const int h = u & 3, t0 = (u >> 2) * 64;
            const int i = tid & 63, dc = tid >> 6;
            {
                const float* la = LOGA + (size_t)(t0 + i) * 256 + h * 64 + dc * 8;
                const f32x4 a = *(const f32x4*)la, b = *(const f32x4*)(la + 4);
#pragma unroll
                for (int j = 0; j < 4; ++j) { LAT[(dc * 8 + j) * 65 + i] = a[j]; LAT[(dc * 8 + 4 + j) * 65 + i] = b[j]; }
            }
            __syncthreads();
            if (tid < 64) { float b = 0.f; for (int r = 0; r < 64; ++r) { b += LAT[tid * 65 + r]; LAT[tid * 65 + r] = b; } }
            __syncthreads();
            {
                const bf16_t* qp = PROJ + (size_t)(t0 + i) * NPROJ + h * 64 + dc * 8;
                const u32x4 qv = *(const u32x4*)qp, kv = *(const u32x4*)(qp + 256);
                const unsigned qw[4] = {qv.x, qv.y, qv.z, qv.w}, kw[4] = {kv.x, kv.y, kv.z, kv.w};
#pragma unroll
                for (int q = 0; q < 4; ++q) { const int d = dc * 8 + 2 * q; const float b0 = LAT[d * 65 + i], b1 = LAT[(d + 1) * 65 + i];
                    QIT[d * 64 + i] = bflo(qw[q]) * __expf(b0) * 0.125f; QIT[(d + 1) * 64 + i] = bfhi(qw[q]) * __expf(b1) * 0.125f;
                    KIT[d * 64 + i] = bflo(kw[q]) * __expf(-b0); KIT[(d + 1) * 64 + i] = bfhi(kw[q]) * __expf(-b1); }
                const bf16_t* vp = PROJ + (size_t)(t0 + i) * NPROJ + 512 + h * 128 + dc * 16;
#pragma unroll
                for (int q = 0; q < 2; ++q) { const u32x4 w = *(const u32x4*)(vp + 8 * q);
                    f32x4 a = {bflo(w.x), bfhi(w.x), bflo(w.y), bfhi(w.y)}, b = {bflo(w.z), bfhi(w.z), bflo(w.w), bfhi(w.w)};
                    *(LAS f32x4*)(VV + i * 128 + dc * 16 + 8 * q) = a; *(LAS f32x4*)(VV + i * 128 + dc * 16 + 8 * q + 4) = b; }
                const float* sp = KV + (size_t)u * 8192;
#pragma unroll
                for (int q = 0; q < 4; ++q) *(LAS f32x4*)(ST + (q * NTHR + tid) * 4) = *(const f32x4*)(sp + (q * NTHR + tid) * 4);
            }
            __syncthreads();
            float att[2][4];
            {
                const int tj = tid & 15, ti = tid >> 4;
#pragma unroll
                for (int a = 0; a < 2; ++a)
#pragma unroll
                    for (int b = 0; b < 4; ++b) att[a][b] = 0.f;
                for (int d = 0; d < 64; ++d) { const f32x2 q = *(const LAS f32x2*)(QIT + d * 64 + 2 * ti); const f32x4 k = *(const LAS f32x4*)(KIT + d * 64 + 4 * tj);
#pragma unroll
                    for (int b = 0; b < 4; ++b) { att[0][b] += q.x * k[b]; att[1][b] += q.y * k[b]; } }
#pragma unroll
                for (int a = 0; a < 2; ++a)
#pragma unroll
                    for (int b = 0; b < 4; ++b) if (4 * tj + b > 2 * ti + a) att[a][b] = 0.f;
            }
            __syncthreads();
            {
                const int tj = tid & 15, ti = tid >> 4;
                LAS float* ATTT = KIT;
#pragma unroll
                for (int b = 0; b < 4; ++b) *(LAS f32x2*)(ATTT + (4 * tj + b) * 64 + 2 * ti) = (f32x2){att[0][b], att[1][b]};
            }
            __syncthreads();
            {
                const int tv = tid & 31, ti = tid >> 5;
                LAS float* ATTT = KIT;
                f32x4 o[4];
#pragma unroll
                for (int a = 0; a < 4; ++a) o[a] = (f32x4){0.f, 0.f, 0.f, 0.f};
                for (int j = 0; j < 64; ++j) { const f32x4 vv = *(const LAS f32x4*)(VV + j * 128 + 4 * tv); const f32x4 at = *(const LAS f32x4*)(ATTT + j * 64 + 4 * ti);
                    o[0] += vv * at.x; o[1] += vv * at.y; o[2] += vv * at.z; o[3] += vv * at.w; }
                for (int d = 0; d < 64; ++d) { const f32x4 sv = *(const LAS f32x4*)(ST + d * 128 + 4 * tv); const f32x4 q = *(const LAS f32x4*)(QIT + d * 64 + 4 * ti);
                    o[0] += sv * q.x; o[1] += sv * q.y; o[2] += sv * q.z; o[3] += sv * q.w; }
                const f32x4 gn = *(const f32x4*)(gla_norm_g + 4 * tv);
#pragma unroll
                for (int a = 0; a < 4; ++a) {
                    float ss = o[a].x * o[a].x + o[a].y * o[a].y + o[a].z * o[a].z + o[a].w * o[a].w;
#pragma unroll
                    for (int off = 1; off < 32; off <<= 1) ss += __shfl_xor(ss, off);
                    const float rstd = 1.f / sqrtf(ss * (1.f / 128.f) + 1e-6f);
                    const int t = t0 + 4 * ti + a;
                    const u32x2 gw2 = *(const u32x2*)(PROJ + (size_t)t * NPROJ + 1024 + h * 128 + 4 * tv);
                    const f32x4 gg = {bflo(gw2.x), bfhi(gw2.x), bflo(gw2.y), bfhi(gw2.y)};
                    f32x4 y;
#pragma unroll
                    for (int j = 0; j < 4; ++j) y[j] = o[a][j] * rstd * gn[j] * silu_f(gg[j]);
                    u32x2 ov; ov.x = pk2(y.x, y.y); ov.y = pk2(y.z, y.w);
                    *(u32x2*)(H + (size_t)t * D + h * 128 + 4 * tv) = ov;
                }
            }
            __syncthreads();
        }
    }
    SEAM(5);

    if (IN(6)) {
        pg8::Gemm g{H, WOUT, M, D, D}; pg8::StaticOrder S; S.init(M, D, G, bx);
        EpiX1 E{x, X1, MOD + 2048};
        pg8::gemm_phase<EpiX1, pg8::StaticOrder, true, true>(lds, g, S, E);
    }
    SEAM(6);

    if (IN(7)) {
        for (int m = gw; m < M; m += NGW) { const float* md = MOD + (m >= SEQ ? 6144 : 0) + 3072; norm_mod_row(X1 + (size_t)m * D, norm2_g, md, md + 1024, H + (size_t)m * D, lane); }
    }
    SEAM(7);

    if (IN(8)) {
        pg8::Gemm g{H, WQ, M, 2048, D}; pg8::StaticOrder S; S.init(M, 2048, G, bx);
        EpiQ E{PROJ};
        pg8::gemm_phase<EpiQ, pg8::StaticOrder, true, true>(lds, g, S, E);
    }
    SEAM(8);

    if (IN(9)) {
        LAS bf16_t* KL = (LAS bf16_t*)lds;
        LAS float* SC = (LAS float*)(lds + 69632);
        for (int i = tid; i < 2 * 128 * 16; i += NTHR) { const int row = i >> 4, ck = i & 15; *(LAS u32x4*)(KL + row * 136 + ck * 8) = *(const u32x4*)(KK + row * 128 + ck * 8); }
        __syncthreads();
        const unsigned ij = CAND_IJ[lane];
        const int ci = ij >> 4, cj = ij & 15;
        const bf16_t* Q = PROJ;
        for (int it = bx; it < (M / 64) * 8; it += G) {
            const int tt = it >> 3, h = it & 7, t0 = tt * 64;
            {
                const int half = wave >> 2, mt = wave & 3, fr = lane & 15, fq = lane >> 4;
                const bf16_t* qp = Q + (size_t)(t0 + mt * 16 + fr) * 2048 + h * 256 + half * 128 + fq * 8;
                bf16x8 af[4];
#pragma unroll
                for (int ks = 0; ks < 4; ++ks) af[ks] = *(const bf16x8*)(qp + ks * 32);
                const LAS bf16_t* kb = KL + half * 128 * 136 + fr * 136 + fq * 8;
#pragma unroll
                for (int nt = 0; nt < 8; ++nt) {
                    f32x4 c = {0.f, 0.f, 0.f, 0.f};
#pragma unroll
                    for (int ks = 0; ks < 4; ++ks) { const bf16x8 bf = *(const LAS bf16x8*)(kb + nt * 16 * 136 + ks * 32); c = __builtin_amdgcn_mfma_f32_16x16x32_bf16(af[ks], bf, c, 0, 0, 0); }
#pragma unroll
                    for (int r = 0; r < 4; ++r) SC[(half * 64 + mt * 16 + fq * 4 + r) * 132 + nt * 16 + fr] = c[r];
                }
            }
            __syncthreads();
            for (int tk = 0; tk < 8; ++tk) {
                const int tl = wave * 8 + tk, hl = lane & 31, half = lane >> 5;
                const f32x4 s = *(const LAS f32x4*)(SC + (half * 64 + tl) * 132 + 4 * hl);
                unsigned k0 = fkey(s.x, 127u - (4 * hl + 0), 127u), k1 = fkey(s.y, 127u - (4 * hl + 1), 127u), k2 = fkey(s.z, 127u - (4 * hl + 2), 127u), k3 = fkey(s.w, 127u - (4 * hl + 3), 127u);
                unsigned res = 0u;
#pragma unroll
                for (int r = 0; r < 16; ++r) {
                    unsigned m = umax_(umax_(k0, k1), umax_(k2, k3));
                    m = umax_(m, dpp_u<0x111, 0xF>(m)); m = umax_(m, dpp_u<0x112, 0xF>(m)); m = umax_(m, dpp_u<0x114, 0xF>(m)); m = umax_(m, dpp_u<0x118, 0xF>(m));
                    m = umax_(m, dpp_u<0x142, 0xA>(m));
                    const unsigned m1 = __builtin_amdgcn_readlane(m, 31), m2 = __builtin_amdgcn_readlane(m, 63);
                    const unsigned mm = half ? m2 : m1;
                    k0 = (k0 == mm) ? 0u : k0; k1 = (k1 == mm) ? 0u : k1; k2 = (k2 == mm) ? 0u : k2; k3 = (k3 == mm) ? 0u : k3;
                    res = (hl == r) ? mm : res;
                }
                const unsigned ka = __builtin_amdgcn_ds_bpermute(4 * ci, res), kb2 = __builtin_amdgcn_ds_bpermute(4 * (32 + cj), res);
                const float csum = fkey_val(ka, 127u) + fkey_val(kb2, 127u);
                unsigned ck = (lane < 50) ? fkey(csum, 63u - lane, 63u) : 0u;
                unsigned res2 = 0u;
#pragma unroll
                for (int r = 0; r < 16; ++r) {
                    unsigned m = ck;
                    m = umax_(m, dpp_u<0x111, 0xF>(m)); m = umax_(m, dpp_u<0x112, 0xF>(m)); m = umax_(m, dpp_u<0x114, 0xF>(m)); m = umax_(m, dpp_u<0x118, 0xF>(m));
                    m = umax_(m, dpp_u<0x142, 0xA>(m)); m = umax_(m, dpp_u<0x143, 0xC>(m));
                    const unsigned mm = __builtin_amdgcn_readlane(m, 63);
                    ck = (ck == mm) ? 0u : ck;
                    res2 = (lane == r) ? mm : res2;
                }
                const unsigned L = 63u - (res2 & 63u);
                const unsigned ij2 = __builtin_amdgcn_ds_bpermute(4 * L, ij);
                const unsigned wa = __builtin_amdgcn_ds_bpermute(4 * (ij2 >> 4), res), wb = __builtin_amdgcn_ds_bpermute(4 * (32 + (ij2 & 15)), res);
                const int eid = (int)((127u - (wa & 127u)) * 128u + (127u - (wb & 127u)));
                const float sv = fkey_val(res2, 63u);
                const float mx = __builtin_bit_cast(float, __builtin_amdgcn_readlane(__builtin_bit_cast(int, sv), 0));
                const float ex = (lane < 16) ? __expf(sv - mx) : 0.f;
                float sm = ex;
                sm += dpp_f<0x111, 0xF>(sm); sm += dpp_f<0x112, 0xF>(sm); sm += dpp_f<0x114, 0xF>(sm); sm += dpp_f<0x118, 0xF>(sm);
                const float tot = __builtin_bit_cast(float, __builtin_amdgcn_readlane(__builtin_bit_cast(int, sm), 15));
                if (lane < 16) { const size_t o = (size_t)(t0 + tl) * 128 + h * 16 + lane; IDX[o] = eid; GATE[o] = ex / tot; }
            }
            __syncthreads();
        }
    }
    SEAM(9);

    if (IN(10)) {
        for (int t = gw; t < M; t += NGW) {
            const bf16_t* hp = H + (size_t)t * D;
            const u32x4 h0 = *(const u32x4*)(hp + 8 * lane), h1 = *(const u32x4*)(hp + 512 + 8 * lane);
            const unsigned hw[8] = {h0.x, h0.y, h0.z, h0.w, h1.x, h1.y, h1.z, h1.w};
            const int id0 = IDX[(size_t)t * 128 + lane], id1 = IDX[(size_t)t * 128 + 64 + lane];
            const float g0 = GATE[(size_t)t * 128 + lane], g1 = GATE[(size_t)t * 128 + 64 + lane];
            float o[16];
#pragma unroll
            for (int j = 0; j < 16; ++j) o[j] = 0.f;
#pragma unroll 1
            for (int e0 = 0; e0 < 128; e0 += 4) {
                u32x4 uu[4][2], vv[4][2]; float gt[4];
#pragma unroll
                for (int q = 0; q < 4; ++q) {
                    const int e = e0 + q;
                    const int eid = (e0 < 64) ? __builtin_amdgcn_readlane(id0, e & 63) : __builtin_amdgcn_readlane(id1, e & 63);
                    gt[q] = __builtin_bit_cast(float, (e0 < 64) ? __builtin_amdgcn_readlane(__builtin_bit_cast(int, g0), e & 63) : __builtin_amdgcn_readlane(__builtin_bit_cast(int, g1), e & 63));
                    const bf16_t* up = U16 + (size_t)eid * 1024 + 8 * lane; const bf16_t* vp = V16 + (size_t)eid * 1024 + 8 * lane;
                    uu[q][0] = *(const u32x4*)up; uu[q][1] = *(const u32x4*)(up + 512); vv[q][0] = *(const u32x4*)vp; vv[q][1] = *(const u32x4*)(vp + 512);
                }
#pragma unroll
                for (int q = 0; q < 4; ++q) {
                    const unsigned uw[8] = {uu[q][0].x, uu[q][0].y, uu[q][0].z, uu[q][0].w, uu[q][1].x, uu[q][1].y, uu[q][1].z, uu[q][1].w};
                    float z = 0.f;
#pragma unroll
                    for (int j = 0; j < 8; ++j) z = __builtin_amdgcn_fdot2_f32_bf16(__builtin_bit_cast(bf16x2_t, uw[j]), __builtin_bit_cast(bf16x2_t, hw[j]), z, false);
                    z = wave_sum(z);
                    const float a = gelu_f(z) * gt[q];
                    const unsigned vw[8] = {vv[q][0].x, vv[q][0].y, vv[q][0].z, vv[q][0].w, vv[q][1].x, vv[q][1].y, vv[q][1].z, vv[q][1].w};
#pragma unroll
                    for (int j = 0; j < 8; ++j) { o[2 * j] += a * bflo(vw[j]); o[2 * j + 1] += a * bfhi(vw[j]); }
                }
            }
            const float* g2p = MOD + (t >= SEQ ? 6144 : 0) + 5120;
            float* xr = X1 + (size_t)t * D;
            f32x4 xv[4]; float ss = 0.f;
#pragma unroll
            for (int q = 0; q < 4; ++q) { const int c = (q >> 1) * 512 + 8 * lane + (q & 1) * 4;
                const f32x4 xx = *(const f32x4*)(xr + c), gg = *(const f32x4*)(g2p + c);
                const f32x4 ov = {o[q * 4 + 0], o[q * 4 + 1], o[q * 4 + 2], o[q * 4 + 3]};
                xv[q] = xx + gg * ov; ss += (xv[q].x * xv[q].x + xv[q].y * xv[q].y) + (xv[q].z * xv[q].z + xv[q].w * xv[q].w); }
            const float rstd = 1.f / sqrtf(wave_sum(ss) * (1.f / D) + 1e-6f);
#pragma unroll
            for (int q = 0; q < 4; ++q) { const int c = (q >> 1) * 512 + 8 * lane + (q & 1) * 4;
                const f32x4 fg = *(const f32x4*)(final_g + c);
                *(f32x4*)(xr + c) = xv[q] * rstd * fg; }
        }
    }
#undef IN
#undef SEAM
}

extern "C" void kernel_launch(void* const* d_in, const int* in_sizes, int n_in, void* d_out, int out_size, void* d_ws, size_t ws_size, hipStream_t stream) {
    static int grid = 0;
    if (grid == 0) {
        if (n_in != 19 || out_size != M * D || ws_size < WS_END) { fprintf(stderr, "kernel_launch: unexpected shapes (n_in %d out %d ws %zu)\n", n_in, out_size, ws_size); grid = -1; return; }
        int dev = 0, cus = 0, per_cu = 0;
        (void)hipGetDevice(&dev); (void)hipDeviceGetAttribute(&cus, hipDeviceAttributeMultiprocessorCount, dev);
        (void)hipFuncSetAttribute((const void*)fwd_kernel, hipFuncAttributeMaxDynamicSharedMemorySize, LDS_BYTES);
        (void)hipOccupancyMaxActiveBlocksPerMultiprocessor(&per_cu, (const void*)fwd_kernel, NTHR, LDS_BYTES);
        (void)hipGetLastError();
        if (per_cu < 1) { fprintf(stderr, "kernel_launch: occupancy query says %d blocks/CU\n", per_cu); per_cu = 1; }
        grid = cus;
    }
    if (grid < 0) return;
    (void)hipMemsetAsync((char*)d_ws + WS_CTL, 0, CTL_ZERO_BYTES, stream);
    Params p{};
    for (int i = 0; i < 19; ++i) p.in[i] = (const float*)d_in[i];
    p.out = (float*)d_out; p.ws = (unsigned char*)d_ws; p.ph_lo = 0; p.ph_hi = 11;
    void* args[] = {&p};
    hipError_t e = hipLaunchCooperativeKernel((const void*)fwd_kernel, dim3(grid), dim3(NTHR), args, LDS_BYTES, stream);
    if (e != hipSuccess) fprintf(stderr, "kernel_launch: cooperative launch failed: %s (grid %d)\n", hipGetErrorString(e), grid);
}
```

```cpp
#include <hip/hip_runtime.h>
#include <cstdio>
#include <cstdint>

#define LAS __attribute__((address_space(3)))
#define GAS __attribute__((address_space(1)))
typedef unsigned short bf16_t;
typedef short bf16x8 __attribute__((ext_vector_type(8)));
typedef float f32x4 __attribute__((ext_vector_type(4)));
typedef float f32x2 __attribute__((ext_vector_type(2)));
typedef unsigned u32x4 __attribute__((ext_vector_type(4)));
typedef unsigned u32x2 __attribute__((ext_vector_type(2)));
typedef __bf16 bf16x2_t __attribute__((ext_vector_type(2)));

namespace pg8 {
#define PG8_LAS __attribute__((address_space(3)))
constexpr int BM = 256, BK = 64, HALF = 128, HTB = HALF * BK * 2, STAGE_BYTES = 8 * HTB, NXCD = 8, WGM = 8;
__host__ __device__ __forceinline__ int lds_byte(int r, int c) { const int st = (r >> 4) * 2 + (c >> 5), rr = r & 15, cc = c & 31, ob = rr * 64 + cc * 2; return st * 1024 + (ob ^ (((ob >> 9) & 1) << 5)); }
__host__ __device__ __forceinline__ void stage_rc(int b, int& R, int& C) { const int st = b / 1024, sb = b % 1024, swz = sb ^ (((sb >> 9) & 1) << 5); R = (st >> 1) * 16 + swz / 64; C = (st & 1) * 32 + (swz % 64) / 2; }
__host__ __device__ __forceinline__ int perm32(int rho) { const int n = rho >> 4, i = rho & 15; return 8 * (i >> 2) + 4 * n + (i & 3); }
struct Unit { int pm, pn; };
struct Gemm { const bf16_t* A; const bf16_t* Bt; int M, N, K; };
struct StaticOrder {
    int nM, nN, nwg, G, c;
    __host__ __device__ void init(int M, int N, int G_, int c_) { nM = M / BM; nN = N / BM; nwg = nM * nN; G = G_; c = c_; }
    __host__ __device__ bool next(int i, Unit& u) const {
        const long L = (long)i * G + c; if (L >= nwg) return false;
        int wgid = (int)L; { const int q = nwg / NXCD, r = nwg % NXCD, xcd = wgid % NXCD, off = wgid / NXCD; wgid = (xcd < r ? xcd * (q + 1) : r * (q + 1) + (xcd - r) * q) + off; }
        const int nig = WGM * nN, gid = wgid / nig, fm = gid * WGM, gsz = (nM - fm) < WGM ? (nM - fm) : WGM;
        u.pm = fm + ((wgid % nig) % gsz); u.pn = (wgid % nig) / gsz; return true;
    }
    __device__ __forceinline__ void a_ready(const Unit&) const {}
    __device__ __forceinline__ void done(const Unit&) const {}
};
__device__ __forceinline__ unsigned cvt_pk_bf16(float lo, float hi) { unsigned r; asm volatile("v_cvt_pk_bf16_f32 %0, %1, %2" : "=v"(r) : "v"(lo), "v"(hi)); return r; }

template <class Epi, class Sched, bool ALIGN_EPI = false, bool SP2 = false>
__device__ __forceinline__ void gemm_phase(PG8_LAS unsigned char* lds, const Gemm g, const Sched& S, const Epi& E) {
    const int tid = threadIdx.x, wid = __builtin_amdgcn_readfirstlane(tid >> 6), lane = tid & 63, wr = wid >> 2, wc = wid & 3, fr = lane & 15, fq = lane >> 4;
    const int K = g.K, nt = K / BK;
    unsigned voffA[2], voffB[2];
#pragma unroll
    for (int i = 0; i < 2; ++i) { int R, C; stage_rc(tid * 16 + i * 8192, R, C); const int Rb = Epi::PERM ? ((R & ~31) + perm32(R & 31)) : R;
        voffA[i] = (unsigned)(R * K + C) * 2u; voffB[i] = (unsigned)(Rb * K + C) * 2u; }
    const size_t kstep = (size_t)(BK * 2);
    const size_t hstep = (size_t)HALF * K * 2;
    const size_t tstep = 2 * hstep;
    const unsigned ldsw = (unsigned)wid * 1024u;
    const int aoff = lds_byte(wr * 64 + fr, fq * 8), boff = lds_byte(wc * 32 + fr, fq * 8);
#define PG8_SA(b, h) (((b) * 2 + (h)) * HTB)
#define PG8_SB(b, h) ((4 + (b) * 2 + (h)) * HTB)
#define PG8_STAGE(bufoff, gbase, voff) do { _Pragma("unroll") for (int _i = 0; _i < 2; ++_i) \
        __builtin_amdgcn_global_load_lds((const unsigned*)((const char*)(gbase) + (voff)[_i]), (PG8_LAS unsigned*)(lds + (bufoff) + ldsw + _i * 8192), 16, 0, 0); } while (0)
#define PG8_LDA(dst, b, h) do { _Pragma("unroll") for (int m = 0; m < 4; ++m) _Pragma("unroll") for (int k = 0; k < 2; ++k) dst[m][k] = *(const PG8_LAS bf16x8*)(lds + PG8_SA(b, h) + aoff + m * 2048 + k * 1024); } while (0)
#define PG8_LDB(dst, b, h) do { _Pragma("unroll") for (int n = 0; n < 2; ++n) _Pragma("unroll") for (int k = 0; k < 2; ++k) dst[n][k] = *(const PG8_LAS bf16x8*)(lds + PG8_SB(b, h) + boff + n * 2048 + k * 1024); } while (0)
#define PG8_MMA(ai, bj, At, Bt) do { __builtin_amdgcn_s_setprio(1); _Pragma("unroll") for (int m = 0; m < 4; ++m) _Pragma("unroll") for (int n = 0; n < 2; ++n) _Pragma("unroll") for (int k = 0; k < 2; ++k) \
        acc[ai][bj][m][n] = __builtin_amdgcn_mfma_f32_16x16x32_bf16(Bt[n][k], At[m][k], acc[ai][bj][m][n], 0, 0, 0); __builtin_amdgcn_s_setprio(0); } while (0)
#define PG8_WAIT_V(n) asm volatile("s_waitcnt vmcnt(" #n ")" ::: "memory")
#define PG8_WAIT_L(n) asm volatile("s_waitcnt lgkmcnt(" #n ")" ::: "memory")
#define PG8_BAR __builtin_amdgcn_s_barrier()
#define PG8_SCHED __builtin_amdgcn_sched_barrier(0)
    Unit cur, nxt; int ui = 0;
    if (!S.next(0, cur)) return;
    f32x4 acc[2][2][4][2];
#pragma unroll
    for (int a = 0; a < 2; ++a)
#pragma unroll
        for (int b = 0; b < 2; ++b)
#pragma unroll
            for (int m = 0; m < 4; ++m)
#pragma unroll
                for (int n = 0; n < 2; ++n) acc[a][b][m][n] = (f32x4){0.f, 0.f, 0.f, 0.f};
    bf16x8 At[4][2], B0[2][2], B1[2][2];
    const char* cA = (const char*)g.A + (size_t)cur.pm * tstep; const char* cB = (const char*)g.Bt + (size_t)cur.pn * tstep;
    S.a_ready(cur);
    if constexpr (SP2) {
        PG8_STAGE(PG8_SB(0, 0), cB, voffB); PG8_STAGE(PG8_SB(0, 1), cB + hstep, voffB); PG8_STAGE(PG8_SA(0, 0), cA, voffA); PG8_STAGE(PG8_SA(0, 1), cA + hstep, voffA);
        if (wr == 1) PG8_BAR;
        PG8_WAIT_V(2); PG8_BAR;
        PG8_STAGE(PG8_SB(1, 0), cB + kstep, voffB); PG8_STAGE(PG8_SA(1, 0), cA + kstep, voffA); PG8_STAGE(PG8_SB(1, 1), cB + hstep + kstep, voffB);
        PG8_WAIT_V(6); PG8_BAR;
    } else {
        PG8_STAGE(PG8_SB(0, 0), cB, voffB); PG8_STAGE(PG8_SA(0, 0), cA, voffA); PG8_STAGE(PG8_SB(0, 1), cB + hstep, voffB); PG8_STAGE(PG8_SA(0, 1), cA + hstep, voffA);
        if (wr == 1) PG8_BAR;
        PG8_WAIT_V(4); PG8_BAR;
        PG8_STAGE(PG8_SB(1, 0), cB + kstep, voffB); PG8_STAGE(PG8_SA(1, 0), cA + kstep, voffA); PG8_STAGE(PG8_SB(1, 1), cB + hstep + kstep, voffB);
        PG8_WAIT_V(6); PG8_BAR;
    }
    for (;;) {
        const bool has_next = S.next(ui + 1, nxt);
        const char* nA = has_next ? (const char*)g.A + (size_t)nxt.pm * tstep : cA; const char* nB = has_next ? (const char*)g.Bt + (size_t)nxt.pn * tstep : cB;
        for (int t = 0; t < nt; t += 2) {
            const bool last = (t == nt - 2);
            const char* a1 = cA + (size_t)(t + 1) * kstep;
            const char* a2 = last ? nA : cA + (size_t)(t + 2) * kstep; const char* b2 = last ? nB : cB + (size_t)(t + 2) * kstep;
            const char* a3 = a2 + kstep; const char* b3 = b2 + kstep;
            if (last && has_next) S.a_ready(nxt);
            if constexpr (SP2) {
            PG8_LDB(B0, 0, 0); PG8_LDB(B1, 0, 1); PG8_SCHED; PG8_LDA(At, 0, 0); PG8_STAGE(PG8_SA(1, 1), a1 + hstep, voffA);
            PG8_WAIT_V(8); PG8_WAIT_L(0); PG8_BAR; PG8_MMA(0, 0, At, B0); PG8_MMA(0, 1, At, B1); PG8_BAR; PG8_SCHED;
            PG8_LDA(At, 0, 1); PG8_STAGE(PG8_SB(0, 0), b2, voffB); PG8_STAGE(PG8_SB(0, 1), b2 + hstep, voffB); PG8_STAGE(PG8_SA(0, 0), a2, voffA);
            PG8_WAIT_V(8); PG8_WAIT_L(0); PG8_BAR; PG8_MMA(1, 0, At, B0); PG8_MMA(1, 1, At, B1); PG8_BAR; PG8_SCHED;
            PG8_LDB(B0, 1, 0); PG8_LDB(B1, 1, 1); PG8_SCHED; PG8_LDA(At, 1, 0); PG8_STAGE(PG8_SA(0, 1), a2 + hstep, voffA);
            PG8_WAIT_V(8); PG8_WAIT_L(0); PG8_BAR; PG8_MMA(0, 0, At, B0); PG8_MMA(0, 1, At, B1); PG8_BAR; PG8_SCHED;
            PG8_LDA(At, 1, 1); PG8_STAGE(PG8_SB(1, 0), b3, voffB); PG8_STAGE(PG8_SB(1, 1), b3 + hstep, voffB); PG8_STAGE(PG8_SA(1, 0), a3, voffA);
            PG8_WAIT_V(8); PG8_WAIT_L(0); PG8_BAR; PG8_MMA(1, 0, At, B0); PG8_MMA(1, 1, At, B1); PG8_BAR; PG8_SCHED;
            } else {
            PG8_LDB(B0, 0, 0); PG8_SCHED; PG8_LDA(At, 0, 0); PG8_STAGE(PG8_SA(1, 1), a1 + hstep, voffA);
            PG8_WAIT_L(8); PG8_BAR; PG8_WAIT_L(0); PG8_MMA(0, 0, At, B0); PG8_BAR; PG8_SCHED;
            PG8_LDB(B1, 0, 1); PG8_STAGE(PG8_SB(0, 0), b2, voffB);
            PG8_BAR; PG8_WAIT_L(0); PG8_MMA(0, 1, At, B1); PG8_BAR;
            PG8_LDA(At, 0, 1); PG8_STAGE(PG8_SA(0, 0), a2, voffA);
            PG8_BAR; PG8_WAIT_L(0); PG8_MMA(1, 0, At, B0); PG8_BAR; PG8_SCHED;
            PG8_STAGE(PG8_SB(0, 1), b2 + hstep, voffB);
            PG8_WAIT_V(6); PG8_BAR; PG8_MMA(1, 1, At, B1); PG8_BAR;
            PG8_LDB(B0, 1, 0); PG8_SCHED; PG8_LDA(At, 1, 0); PG8_STAGE(PG8_SA(0, 1), a2 + hstep, voffA);
            PG8_WAIT_L(8); PG8_BAR; PG8_WAIT_L(0); PG8_MMA(0, 0, At, B0); PG8_BAR; PG8_SCHED;
            PG8_LDB(B1, 1, 1); PG8_STAGE(PG8_SB(1, 0), b3, voffB);
            PG8_BAR; PG8_WAIT_L(0); PG8_MMA(0, 1, At, B1); PG8_BAR;
            PG8_LDA(At, 1, 1); PG8_STAGE(PG8_SA(1, 0), a3, voffA);
            PG8_BAR; PG8_WAIT_L(0); PG8_MMA(1, 0, At, B0); PG8_BAR; PG8_SCHED;
            PG8_STAGE(PG8_SB(1, 1), b3 + hstep, voffB);
            PG8_WAIT_V(6); PG8_BAR; PG8_MMA(1, 1, At, B1); PG8_BAR;
            }
        }
        if constexpr (ALIGN_EPI) { if (wr == 0) PG8_BAR; }
        E(acc, cur, wr, wc, fr, fq); S.done(cur);
        if (!has_next) break;
#pragma unroll
        for (int a = 0; a < 2; ++a)
#pragma unroll
            for (int b = 0; b < 2; ++b)
#pragma unroll
                for (int m = 0; m < 4; ++m)
#pragma unroll
                    for (int n = 0; n < 2; ++n) acc[a][b][m][n] = (f32x4){0.f, 0.f, 0.f, 0.f};
        cur = nxt; cA = nA; cB = nB; ++ui;
        if constexpr (ALIGN_EPI) { if (wr == 1) PG8_BAR; }
    }
    PG8_WAIT_V(0);
    if constexpr (!ALIGN_EPI) { if (wr == 0) PG8_BAR; }
    PG8_BAR;
#undef PG8_SA
#undef PG8_SB
#undef PG8_STAGE
#undef PG8_LDA
#undef PG8_LDB
#undef PG8_MMA
#undef PG8_WAIT_V
#undef PG8_WAIT_L
#undef PG8_BAR
#undef PG8_SCHED
}
}

constexpr int NB = 2, SEQ = 8192, D = 1024, M = NB * SEQ;
constexpr int NPROJ = 2048, NIN = 2304, INLD = 2064;
constexpr int NUNIT = 1024;
constexpr int NEXP = 16384;
constexpr size_t MiB = 1u << 20;
constexpr size_t WS_CTL = 0, CTL_ZERO_BYTES = 64 * 1024;
constexpr size_t WS_MOD = 1 * MiB;
constexpr size_t WS_DEC = 1 * MiB + 512 * 1024;
constexpr size_t WS_WIN = 2 * MiB;
constexpr size_t WS_WOUT = 7 * MiB;
constexpr size_t WS_WQ = 9 * MiB;
constexpr size_t WS_KK = 13 * MiB;
constexpr size_t WS_IDX = 14 * MiB;
constexpr size_t WS_GATE = 22 * MiB;
constexpr size_t WS_LOGA = 30 * MiB;
constexpr size_t WS_KV = 46 * MiB;
constexpr size_t WS_H = 78 * MiB;
constexpr size_t WS_U8 = 110 * MiB;
constexpr size_t WS_V8 = 126 * MiB;
constexpr size_t WS_SU = 142 * MiB;
constexpr size_t WS_SV = 142 * MiB + 65536;
constexpr size_t WS_PROJ = 174 * MiB;
constexpr size_t WS_END = 238 * MiB;
constexpr int CW_BAR = 1024;
constexpr int NWAVES = 8, NTHR = 512;
constexpr int LDS_BYTES = 147456, MISC_OFF = 147456 - 256;

#define XB_TMO      128
#define XB_XCNT(j)  (256  + 64 * (j))
#define XB_XSUB(j)  (1280 + 64 * (j))
#define XB_XGEN(j)  (2304 + 64 * (j))
#define XB_TOP      3328
#define XB_TOPGEN   3392
#define XCD_BAR_WORDS 3456
#define XB_SPIN_CAP (1u << 20)
__device__ __forceinline__ unsigned xb_ld(unsigned* p)              { return __hip_atomic_load(p, __ATOMIC_RELAXED, __HIP_MEMORY_SCOPE_AGENT); }
__device__ __forceinline__ unsigned xb_add(unsigned* p, unsigned v) { return __hip_atomic_fetch_add(p, v, __ATOMIC_RELAXED, __HIP_MEMORY_SCOPE_AGENT); }
__device__ __forceinline__ unsigned xb_xcc_id() { return (unsigned)__builtin_amdgcn_s_getreg((3 << 11) | 20) & 0xFu; }
#define XB_SPIN(cond, bar) do { unsigned _sp = 0; while (cond) { __builtin_amdgcn_s_sleep(1); \
    if ((++_sp & 255u) == 0u) { if (xb_ld(&(bar)[XB_TMO])) break; if (_sp > XB_SPIN_CAP) { atomicAdd(&(bar)[XB_TMO], 1u); break; } } } } while (0)
struct XcdBarrier { unsigned* bar; unsigned x; volatile LAS unsigned* st; };
__device__ __forceinline__ XcdBarrier xcd_barrier_post(unsigned* bar, volatile LAS unsigned* st) {
    XcdBarrier b; b.bar = bar; b.x = xb_xcc_id(); b.st = st;
    if (threadIdx.x == 0) (void)xb_add(&bar[XB_XCNT(b.x)], 1u);
    return b;
}
__device__ __forceinline__ void xcd_barrier_complete(unsigned* bar, unsigned x, unsigned& nloc, unsigned& nx) {
    const unsigned G = gridDim.x * gridDim.y * gridDim.z;
    unsigned sum, cnt, mine, sp = 0u;
    for (;;) {
        sum = 0u; cnt = 0u; mine = 0u;
#pragma unroll
        for (unsigned j = 0; j < 16; ++j) { const unsigned c = xb_ld(&bar[XB_XCNT(j)]); sum += c; cnt += (c > 0u) ? 1u : 0u; mine = (j == x) ? c : mine; }
        if (sum == G) break;
        __builtin_amdgcn_s_sleep(1);
        if ((++sp & 255u) == 0u) { if (xb_ld(&bar[XB_TMO])) break; if (sp > XB_SPIN_CAP) { atomicAdd(&bar[XB_TMO], 1u); break; } }
    }
    nloc = mine > 0u ? mine : 1u; nx = cnt > 0u ? cnt : 1u;
}
__device__ __forceinline__ void xcd_barrier(const XcdBarrier& b) {
    asm volatile("s_waitcnt vmcnt(0)" ::: "memory");
    __syncthreads();
    if (threadIdx.x == 0) {
        unsigned* bar = b.bar;
        __builtin_amdgcn_s_waitcnt(0);
        unsigned nloc = b.st[0], nx = b.st[1];
        if (nloc == 0u) { xcd_barrier_complete(bar, b.x, nloc, nx); b.st[0] = nloc; b.st[1] = nx; }
        const unsigned old = xb_add(&bar[XB_XSUB(b.x)], 1u);
        const unsigned gen = old / nloc;
        if (old + 1u == (gen + 1u) * nloc) {
            __builtin_amdgcn_fence(__ATOMIC_RELEASE, "agent");
            asm volatile("s_waitcnt vmcnt(0)" ::: "memory");
            const unsigned og = xb_add(&bar[XB_TOP], 1u);
            const unsigned tg = og / nx;
            if (og + 1u == (tg + 1u) * nx) xb_add(&bar[XB_TOPGEN], 1u);
            else XB_SPIN(xb_ld(&bar[XB_TOPGEN]) == tg, bar);
            __builtin_amdgcn_fence(__ATOMIC_ACQUIRE, "agent");
            xb_add(&bar[XB_XGEN(b.x)], 1u);
            asm volatile("s_waitcnt vmcnt(0)" ::: "memory");
        } else {
            XB_SPIN(xb_ld(&bar[XB_XGEN(b.x)]) == gen, bar);
            __builtin_amdgcn_fence(__ATOMIC_ACQUIRE, "agent");
            asm volatile("s_waitcnt vmcnt(0)" ::: "memory");
        }
    }
    __syncthreads();
}

__device__ __forceinline__ unsigned f2bf(float f) { unsigned u = __builtin_bit_cast(unsigned, f); return (u + 0x7fffu + ((u >> 16) & 1u)) >> 16; }
__device__ __forceinline__ unsigned pk2(float lo, float hi) { return f2bf(lo) | (f2bf(hi) << 16); }
__device__ __forceinline__ float bflo(unsigned w) { return __builtin_bit_cast(float, w << 16); }
__device__ __forceinline__ float bfhi(unsigned w) { return __builtin_bit_cast(float, w & 0xffff0000u); }
__device__ __forceinline__ float wave_sum(float v) {
#pragma unroll
    for (int o = 1; o < 64; o <<= 1) v += __shfl_xor(v, o);
    return v;
}
__device__ __forceinline__ float silu_f(float x) { return x / (1.f + __expf(-x)); }
__device__ __forceinline__ float logsig_f(float x) { return fminf(x, 0.f) - log1pf(__expf(-fabsf(x))); }
__device__ __forceinline__ float gelu_f(float x) { return 0.5f * x * (1.f + erff(x * 0.70710678118654752f)); }

struct Params { const float* in[19]; float* out; unsigned char* ws; int ph_lo, ph_hi; };

struct EpiProj {
    static constexpr bool PERM = true;
    bf16_t* P; float* LA; const float* gb;
    __device__ __forceinline__ void operator()(const f32x4 (&acc)[2][2][4][2], const pg8::Unit& u, int wr, int wc, int fr, int fq) const {
        const int row0 = u.pm * 256 + wr * 64 + fr;
        if (u.pn < 8) {
            const int col0 = u.pn * 256 + wc * 32 + 8 * fq;
#pragma unroll
            for (int ai = 0; ai < 2; ++ai)
#pragma unroll
                for (int m = 0; m < 4; ++m) { bf16_t* rowp = P + (size_t)(row0 + ai * 128 + m * 16) * NPROJ + col0;
#pragma unroll
                    for (int bj = 0; bj < 2; ++bj) { const f32x4 v0 = acc[ai][bj][m][0], v1 = acc[ai][bj][m][1];
                        u32x4 w; w.x = pg8::cvt_pk_bf16(v0[0], v0[1]); w.y = pg8::cvt_pk_bf16(v0[2], v0[3]); w.z = pg8::cvt_pk_bf16(v1[0], v1[1]); w.w = pg8::cvt_pk_bf16(v1[2], v1[3]);
                        *(u32x4*)(rowp + bj * 128) = w; } }
        } else {
            const int col0 = wc * 32 + 8 * fq;
            f32x4 bv[2][2];
#pragma unroll
            for (int bj = 0; bj < 2; ++bj)
#pragma unroll
                for (int n = 0; n < 2; ++n) bv[bj][n] = *(const f32x4*)(gb + col0 + bj * 128 + 4 * n);
#pragma unroll
            for (int ai = 0; ai < 2; ++ai)
#pragma unroll
                for (int m = 0; m < 4; ++m) { float* rowp = LA + (size_t)(row0 + ai * 128 + m * 16) * 256 + col0;
#pragma unroll
                    for (int bj = 0; bj < 2; ++bj)
#pragma unroll
                        for (int n = 0; n < 2; ++n) { const f32x4 v = acc[ai][bj][m][n] + bv[bj][n]; f32x4 o;
#pragma unroll
                            for (int j = 0; j < 4; ++j) o[j] = logsig_f(v[j]) * (1.0f / 16.0f);
                            *(f32x4*)(rowp + bj * 128 + 4 * n) = o; } }
        }
    }
};
struct EpiX1 {
    static constexpr bool PERM = false;
    const float* x; float* X1; const float* gate;
    __device__ __forceinline__ void operator()(const f32x4 (&acc)[2][2][4][2], const pg8::Unit& u, int wr, int wc, int fr, int fq) const {
        const int row0 = u.pm * 256 + wr * 64 + fr, col0 = u.pn * 256 + wc * 32 + 4 * fq;
        const float* gp = gate + (u.pm >= 32 ? 6144 : 0);
        f32x4 gv[2][2];
#pragma unroll
        for (int bj = 0; bj < 2; ++bj)
#pragma unroll
            for (int n = 0; n < 2; ++n) gv[bj][n] = *(const f32x4*)(gp + col0 + bj * 128 + n * 16);
#pragma unroll
        for (int ai = 0; ai < 2; ++ai)
#pragma unroll
            for (int m = 0; m < 4; ++m) { const size_t ro = (size_t)(row0 + ai * 128 + m * 16) * D + col0;
#pragma unroll
                for (int bj = 0; bj < 2; ++bj)
#pragma unroll
                    for (int n = 0; n < 2; ++n) { const f32x4 xv = *(const f32x4*)(x + ro + bj * 128 + n * 16);
                        *(f32x4*)(X1 + ro + bj * 128 + n * 16) = xv + gv[bj][n] * acc[ai][bj][m][n]; } }
    }
};
struct EpiQ {
    static constexpr bool PERM = true;
    bf16_t* Q;
    __device__ __forceinline__ void operator()(const f32x4 (&acc)[2][2][4][2], const pg8::Unit& u, int wr, int wc, int fr, int fq) const {
        const int row0 = u.pm * 256 + wr * 64 + fr, col0 = u.pn * 256 + wc * 32 + 8 * fq;
#pragma unroll
        for (int ai = 0; ai < 2; ++ai)
#pragma unroll
            for (int m = 0; m < 4; ++m) { bf16_t* rowp = Q + (size_t)(row0 + ai * 128 + m * 16) * 2048 + col0;
#pragma unroll
                for (int bj = 0; bj < 2; ++bj) { const f32x4 v0 = acc[ai][bj][m][0], v1 = acc[ai][bj][m][1];
                    u32x4 w; w.x = pg8::cvt_pk_bf16(v0[0], v0[1]); w.y = pg8::cvt_pk_bf16(v0[2], v0[3]); w.z = pg8::cvt_pk_bf16(v1[0], v1[1]); w.w = pg8::cvt_pk_bf16(v1[2], v1[3]);
                    *(u32x4*)(rowp + bj * 128) = w; } }
    }
};

__device__ __forceinline__ void transpose_item(const float* W, int ldw, int k0, int n0, bf16_t* WT, int ldt, int row0, LAS float* scr, int lane) {
#pragma unroll 8
    for (int i = 0; i < 32; ++i) { const int kk = 2 * i + (lane >> 5); scr[kk * 33 + (lane & 31)] = W[(size_t)(k0 + kk) * ldw + n0 + (lane & 31)]; }
    asm volatile("s_waitcnt lgkmcnt(0)" ::: "memory");
    const int c = lane & 7;
#pragma unroll
    for (int j = 0; j < 4; ++j) { const int n = (lane >> 3) + 8 * j; const LAS float* s = scr + (8 * c) * 33 + n;
        u32x4 o; o.x = pk2(s[0 * 33], s[1 * 33]); o.y = pk2(s[2 * 33], s[3 * 33]); o.z = pk2(s[4 * 33], s[5 * 33]); o.w = pk2(s[6 * 33], s[7 * 33]);
        *(u32x4*)(WT + (size_t)(row0 + n0 + n) * ldt + k0 + 8 * c) = o; }
    asm volatile("s_waitcnt lgkmcnt(0)" ::: "memory");
}

__device__ __forceinline__ void norm_mod_row(const float* xrow, const float* g, const float* shift, const float* scale, bf16_t* orow, int lane) {
    f32x4 v[4]; float s = 0.f;
#pragma unroll
    for (int j = 0; j < 4; ++j) { v[j] = *(const f32x4*)(xrow + 4 * lane + 256 * j); s += (v[j].x * v[j].x + v[j].y * v[j].y) + (v[j].z * v[j].z + v[j].w * v[j].w); }
    const float rstd = 1.f / sqrtf(wave_sum(s) * (1.f / D) + 1e-6f);
#pragma unroll
    for (int j = 0; j < 4; ++j) { const int c = 4 * lane + 256 * j;
        const f32x4 gg = *(const f32x4*)(g + c), sh = *(const f32x4*)(shift + c), sc = *(const f32x4*)(scale + c);
        const f32x4 y = v[j] * rstd * gg * (sc + 1.0f) + sh;
        u32x2 o; o.x = pk2(y.x, y.y); o.y = pk2(y.z, y.w);
        *(u32x2*)(orow + c) = o; }
}

__constant__ unsigned char CAND_IJ[64] = {
    0x00,0x01,0x02,0x03,0x04,0x05,0x06,0x07,0x08,0x09,0x0a,0x0b,0x0c,0x0d,0x0e,0x0f,
    0x10,0x11,0x12,0x13,0x14,0x15,0x16,0x17,
    0x20,0x21,0x22,0x23,0x24,
    0x30,0x31,0x32,0x33,
    0x40,0x41,0x42,
    0x50,0x51, 0x60,0x61, 0x70,0x71,
    0x80,0x90,0xa0,0xb0,0xc0,0xd0,0xe0,0xf0,
    0,0,0,0,0,0,0,0,0,0,0,0,0,0};

__device__ __forceinline__ unsigned fkey(float f, unsigned idbits, unsigned idmask) {
    unsigned u = __builtin_bit_cast(unsigned, f); u = (u & 0x80000000u) ? ~u : (u | 0x80000000u);
    return (u & ~idmask) | idbits;
}
__device__ __forceinline__ float fkey_val(unsigned key, unsigned idmask) {
    unsigned u = key & ~idmask; u = (u & 0x80000000u) ? (u ^ 0x80000000u) : ~u;
    return __builtin_bit_cast(float, u);
}
template <int CTRL, int ROWMASK> __device__ __forceinline__ unsigned dpp_u(unsigned v) { return (unsigned)__builtin_amdgcn_update_dpp(0, (int)v, CTRL, ROWMASK, 0xF, true); }
template <int CTRL, int ROWMASK> __device__ __forceinline__ float dpp_f(float v) { return __builtin_bit_cast(float, __builtin_amdgcn_update_dpp(0, __builtin_bit_cast(int, v), CTRL, ROWMASK, 0xF, true)); }
__device__ __forceinline__ unsigned umax_(unsigned a, unsigned b) { return a > b ? a : b; }

__global__ void __launch_bounds__(NTHR, 2) fwd_kernel(Params p) {
    extern __shared__ __attribute__((aligned(16))) unsigned char lds_raw[];
    LAS unsigned char* lds = (LAS unsigned char*)lds_raw;
    const int tid = threadIdx.x, lane = tid & 63, wave = __builtin_amdgcn_readfirstlane(tid >> 6);
    const int G = gridDim.x, bx = blockIdx.x;
    const int gw = bx * NWAVES + wave, NGW = G * NWAVES;
    unsigned char* ws = p.ws;
    unsigned* ctl = (unsigned*)(ws + WS_CTL);
    float* MOD = (float*)(ws + WS_MOD);
    float* DEC = (float*)(ws + WS_DEC);
    bf16_t* WIN = (bf16_t*)(ws + WS_WIN);
    bf16_t* WOUT = (bf16_t*)(ws + WS_WOUT);
    bf16_t* WQ = (bf16_t*)(ws + WS_WQ);
    bf16_t* KK = (bf16_t*)(ws + WS_KK);
    int* IDX = (int*)(ws + WS_IDX);
    float* GATE = (float*)(ws + WS_GATE);
    float* LOGA = (float*)(ws + WS_LOGA);
    float* KV = (float*)(ws + WS_KV);
    bf16_t* H = (bf16_t*)(ws + WS_H);
    unsigned char* U8 = ws + WS_U8;
    unsigned char* V8 = ws + WS_V8;
    float* SU = (float*)(ws + WS_SU);
    float* SV = (float*)(ws + WS_SV);
    bf16_t* PROJ = (bf16_t*)(ws + WS_PROJ);
    const float* x = p.in[0]; const float* cvec = p.in[1]; const float* ada_w = p.in[2]; const float* ada_b = p.in[3]; const float* norm1_g = p.in[4];
    const float* w_in = p.in[5]; const float* gate_w = p.in[6]; const float* gate_b = p.in[7]; const float* gla_norm_g = p.in[8];
    const float* pool_w = p.in[9]; const float* pool_scale = p.in[10]; const float* w_out = p.in[11]; const float* norm2_g = p.in[12];
    const float* peer_wq = p.in[13]; const float* peer_k1 = p.in[14]; const float* peer_k2 = p.in[15]; const float* peer_u = p.in[16]; const float* peer_v = p.in[17];
    const float* final_g = p.in[18];
    float* X1 = p.out;

    volatile LAS unsigned* MISC = (volatile LAS unsigned*)(lds + MISC_OFF);
    if (tid < 64) MISC[tid] = 0u;
    __syncthreads();
    XcdBarrier bar = xcd_barrier_post(ctl + CW_BAR, MISC + 8);
    const int lo = p.ph_lo, hi = p.ph_hi;
#define IN(k) (lo <= (k) && (k) < hi)
#define SEAM(k) do { if (IN(k) && IN((k) + 1)) xcd_barrier(bar); } while (0)

    if (IN(0)) {
        {
            LAS float* sc = (LAS float*)lds;
            LAS f32x4* red = (LAS f32x4*)(lds + 8192);
            for (int i = tid; i < 2048; i += NTHR) sc[i] = silu_f(cvec[i]);
            __syncthreads();
            for (int cb = bx; cb < 256; cb += G) {
                if (tid < 384) {
                    const int f4 = tid % 6, rg = tid / 6;
                    f32x4 a0 = {0.f, 0.f, 0.f, 0.f}, a1 = {0.f, 0.f, 0.f, 0.f};
#pragma unroll 4
                    for (int i = 0; i < 16; ++i) { const int r = rg + 64 * i; const f32x4 w = *(const f32x4*)(ada_w + (size_t)r * 6144 + 24 * cb + 4 * f4);
                        a0 += w * sc[r]; a1 += w * sc[1024 + r]; }
                    red[(rg * 6 + f4) * 2 + 0] = a0; red[(rg * 6 + f4) * 2 + 1] = a1;
                }
                __syncthreads();
                if (tid < 48) { const int b = tid / 24, col = tid % 24; float s = 0.f;
                    for (int rg = 0; rg < 64; ++rg) s += red[(rg * 6 + (col >> 2)) * 2 + b][col & 3];
                    MOD[b * 6144 + 24 * cb + col] = s + ada_b[24 * cb + col]; }
                __syncthreads();
            }
        }
        for (int it = bx; it < 128; it += G) {
            const int g = it >> 5, nb = (it >> 1) & 15, cb = it & 1;
            LAS float* PW = (LAS float*)lds;
            LAS float* WO = (LAS float*)(lds + 32768);
            for (int i = tid; i < 64 * 128; i += NTHR) { const int c = i >> 7, j = i & 127; PW[i] = pool_w[(size_t)(g * 128 + cb * 64 + c) * 128 + j] * pool_scale[g * 128 + j]; }
            for (int i = tid; i < 128 * 64; i += NTHR) { const int j = i >> 6, n = i & 63; WO[i] = w_out[(size_t)(512 + g * 128 + j) * 1024 + nb * 64 + n]; }
            __syncthreads();
            const int n = tid & 63, cg = tid >> 6;
            float a[8];
#pragma unroll
            for (int q = 0; q < 8; ++q) a[q] = 0.f;
            for (int j = 0; j < 128; ++j) { const float wo = WO[j * 64 + n];
#pragma unroll
                for (int q = 0; q < 8; ++q) a[q] += PW[(cg * 8 + q) * 128 + j] * wo; }
            u32x4 o; o.x = pk2(a[0], a[1]); o.y = pk2(a[2], a[3]); o.z = pk2(a[4], a[5]); o.w = pk2(a[6], a[7]);
            *(u32x4*)(WOUT + (size_t)(nb * 64 + n) * 1024 + 512 + g * 128 + cb * 64 + cg * 8) = o;
            __syncthreads();
        }
        {
            LAS float* scr = (LAS float*)(lds + wave * 16384);
            constexpr int I_IN = 16 * 64, I_Q = 16 * 64, I_O = 8 * 32;
            for (int it = gw; it < I_IN + I_Q + I_O; it += NGW) {
                int r = it;
                if (r < I_IN) { transpose_item(w_in, INLD, (r >> 6) * 64, (r & 63) * 32, WIN, 1024, 0, scr, lane); continue; } r -= I_IN;
                if (r < I_Q) { transpose_item(peer_wq, 2048, (r >> 6) * 64, (r & 63) * 32, WQ, 1024, 0, scr, lane); continue; } r -= I_Q;
                transpose_item(w_out, 1024, (r >> 5) * 64, (r & 31) * 32, WOUT, 1024, 0, scr, lane);
            }
        }
        for (int o = bx * NTHR + tid; o < 256 * 1024; o += G * NTHR) { const int j = o >> 10, k = o & 1023; float s = 0.f;
#pragma unroll
            for (int r = 0; r < 16; ++r) s += w_in[(size_t)k * INLD + 2048 + r] * gate_w[r * 256 + j];
            WIN[(size_t)(2048 + j) * 1024 + k] = (bf16_t)f2bf(s); }
        for (int r = gw; r < 2 * NEXP; r += NGW) {
            const bool isv = r >= NEXP; const int row = isv ? r - NEXP : r;
            const float* src = (isv ? peer_v : peer_u) + (size_t)row * 1024 + 16 * lane;
            f32x4 v[4]; float am = 0.f;
#pragma unroll
            for (int q = 0; q < 4; ++q) { v[q] = *(const f32x4*)(src + 4 * q); am = fmaxf(am, fmaxf(fmaxf(fabsf(v[q].x), fabsf(v[q].y)), fmaxf(fabsf(v[q].z), fabsf(v[q].w)))); }
#pragma unroll
            for (int off = 1; off < 64; off <<= 1) am = fmaxf(am, __shfl_xor(am, off));
            const float sc = am > 0.f ? am * (1.0f / 384.0f) : 1.0f, inv = 1.0f / sc;
            u32x4 o; unsigned* op = (unsigned*)&o;
#pragma unroll
            for (int q = 0; q < 4; ++q) { int w = 0; w = __builtin_amdgcn_cvt_pk_fp8_f32(v[q].x * inv, v[q].y * inv, w, false); w = __builtin_amdgcn_cvt_pk_fp8_f32(v[q].z * inv, v[q].w * inv, w, true); op[q] = (unsigned)w; }
            *(u32x4*)((isv ? V8 : U8) + (size_t)row * 1024 + 16 * lane) = o;
            if (lane == 0) (isv ? SV : SU)[row] = sc;
        }
        for (int i = bx * NTHR + tid; i < 2 * 128 * 128; i += G * NTHR) KK[i] = (bf16_t)f2bf(i < 16384 ? peer_k1[i] : peer_k2[i - 16384]);
    }
    SEAM(0);

    if (IN(1)) {
        for (int m = gw; m < M; m += NGW) { const float* md = MOD + (m >= SEQ ? 6144 : 0); norm_mod_row(x + (size_t)m * D, norm1_g, md, md + 1024, H + (size_t)m * D, lane); }
    }
    SEAM(1);

    if (IN(2)) {
        pg8::Gemm g{H, WIN, M, NIN, D}; pg8::StaticOrder S; S.init(M, NIN, G, bx);
        EpiProj E{PROJ, LOGA, gate_b};
        pg8::gemm_phase<EpiProj, pg8::StaticOrder, true, true>(lds, g, S, E);
    }
    SEAM(2);

    if (IN(3)) {
        const int hb = tid >> 8, ht = tid & 255;
        LAS float* LAT = (LAS float*)(lds + hb * 69632);
        LAS float* KST = (LAS float*)(lds + hb * 69632 + 16640);
        LAS float* VV = (LAS float*)(lds + hb * 69632 + 16640 + 17408);
        for (int it = 0; it < (NUNIT + 2 * G - 1) / (2 * G); ++it) {
            const int u = (it * G + bx) * 2 + hb;
            const bool act = u < NUNIT;
            const int h = u & 3, t0 = (u >> 2) * 64;
            const int c = ht & 63, dc = ht >> 6;
            if (act) {
                const float* la = LOGA + (size_t)(t0 + c) * 256 + h * 64 + dc * 16;
#pragma unroll
                for (int q = 0; q < 4; ++q) { const f32x4 v = *(const f32x4*)(la + 4 * q);
#pragma unroll
                    for (int j = 0; j < 4; ++j) LAT[(dc * 16 + q * 4 + j) * 65 + c] = v[j]; }
            }
            __syncthreads();
            if (act && ht < 64) { float b = 0.f; for (int i = 0; i < 64; ++i) { b += LAT[ht * 65 + i]; LAT[ht * 65 + i] = b; } DEC[u * 64 + ht] = __expf(b); }
            __syncthreads();
            if (act) {
                const bf16_t* kp = PROJ + (size_t)(t0 + c) * NPROJ + 256 + h * 64 + dc * 16;
                const u32x4 k0 = *(const u32x4*)kp, k1 = *(const u32x4*)(kp + 8);
                const unsigned kw[8] = {k0.x, k0.y, k0.z, k0.w, k1.x, k1.y, k1.z, k1.w};
#pragma unroll
                for (int q = 0; q < 8; ++q) { const int d = dc * 16 + 2 * q;
                    KST[c * 68 + d] = bflo(kw[q]) * __expf(LAT[d * 65 + 63] - LAT[d * 65 + c]);
                    KST[c * 68 + d + 1] = bfhi(kw[q]) * __expf(LAT[(d + 1) * 65 + 63] - LAT[(d + 1) * 65 + c]); }
                const bf16_t* vp = PROJ + (size_t)(t0 + c) * NPROJ + 512 + h * 128 + dc * 32;
#pragma unroll
                for (int q = 0; q < 4; ++q) { const u32x4 w = *(const u32x4*)(vp + 8 * q);
                    f32x4 a = {bflo(w.x), bfhi(w.x), bflo(w.y), bfhi(w.y)}, b = {bflo(w.z), bfhi(w.z), bflo(w.w), bfhi(w.w)};
                    *(LAS f32x4*)(VV + c * 132 + dc * 32 + 8 * q) = a; *(LAS f32x4*)(VV + c * 132 + dc * 32 + 8 * q + 4) = b; }
            }
            __syncthreads();
            if (act) {
                const int tv = ht & 31, td = ht >> 5;
                f32x4 a[8];
#pragma unroll
                for (int q = 0; q < 8; ++q) a[q] = (f32x4){0.f, 0.f, 0.f, 0.f};
                for (int cc = 0; cc < 64; ++cc) {
                    const f32x4 vv = *(const LAS f32x4*)(VV + cc * 132 + 4 * tv);
                    const f32x4 ka = *(const LAS f32x4*)(KST + cc * 68 + 8 * td), kb = *(const LAS f32x4*)(KST + cc * 68 + 8 * td + 4);
                    a[0] += vv * ka.x; a[1] += vv * ka.y; a[2] += vv * ka.z; a[3] += vv * ka.w;
                    a[4] += vv * kb.x; a[5] += vv * kb.y; a[6] += vv * kb.z; a[7] += vv * kb.w;
                }
                float* kvp = KV + (size_t)u * 8192 + (8 * td) * 128 + 4 * tv;
#pragma unroll
                for (int q = 0; q < 8; ++q) *(f32x4*)(kvp + q * 128) = a[q];
            }
            __syncthreads();
        }
        for (int it = bx * NTHR + tid; it < (M / 8) * 64; it += G * NTHR) {
            const int cv = it & 63, run = it >> 6, ch = cv * 8, gq = ch >> 7, w = 2 << gq;
            const int t0 = run * 8, pos0 = t0 & (SEQ - 1);
            const bf16_t* pp = PROJ + 1536 + ch;
            float s[8];
#pragma unroll
            for (int j = 0; j < 8; ++j) s[j] = 0.f;
            for (int q = 1; q <= w; ++q) if (pos0 - q >= 0) { const u32x4 v = *(const u32x4*)(pp + (size_t)(t0 - q) * NPROJ);
                s[0] += bflo(v.x); s[1] += bfhi(v.x); s[2] += bflo(v.y); s[3] += bfhi(v.y); s[4] += bflo(v.z); s[5] += bfhi(v.z); s[6] += bflo(v.w); s[7] += bfhi(v.w); }
            for (int r = 0; r < 8; ++r) {
                const int t = t0 + r, pos = pos0 + r;
                const u32x4 v = *(const u32x4*)(pp + (size_t)t * NPROJ);
                const float cur[8] = {bflo(v.x), bfhi(v.x), bflo(v.y), bfhi(v.y), bflo(v.z), bfhi(v.z), bflo(v.w), bfhi(v.w)};
#pragma unroll
                for (int j = 0; j < 8; ++j) s[j] += cur[j];
                if (pos >= w) { const u32x4 o = *(const u32x4*)(pp + (size_t)(t - w) * NPROJ);
                    s[0] -= bflo(o.x); s[1] -= bfhi(o.x); s[2] -= bflo(o.y); s[3] -= bfhi(o.y); s[4] -= bflo(o.z); s[5] -= bfhi(o.z); s[6] -= bflo(o.w); s[7] -= bfhi(o.w); }
                const float inv = 1.f / (float)((pos + 1) < w ? (pos + 1) : w);
                u32x4 ov; ov.x = pk2(s[0] * inv - cur[0], s[1] * inv - cur[1]); ov.y = pk2(s[2] * inv - cur[2], s[3] * inv - cur[3]);
                ov.z = pk2(s[4] * inv - cur[4], s[5] * inv - cur[5]); ov.w = pk2(s[6] * inv - cur[6], s[7] * inv - cur[7]);
                *(u32x4*)(H + (size_t)t * D + 512 + ch) = ov;
            }
        }
    }
    SEAM(3);

    if (IN(4)) {
        for (int sq = bx * NTHR + tid; sq < 8 * 8192; sq += G * NTHR) {
            const int bh = sq >> 13, e = sq & 8191, b = bh >> 2, h = bh & 3, d = e >> 7;
            float st = 0.f;
            for (int n0 = 0; n0 < 128; n0 += 8) {
                float kv[8], dc[8];
#pragma unroll
                for (int q = 0; q < 8; ++q) { const int u = ((b * 128 + n0 + q) * 4 + h); kv[q] = KV[(size_t)u * 8192 + e]; dc[q] = DEC[u * 64 + d]; }
#pragma unroll
                for (int q = 0; q < 8; ++q) { const int u = ((b * 128 + n0 + q) * 4 + h); KV[(size_t)u * 8192 + e] = st; st = st * dc[q] + kv[q]; }
            }
        }
    }
    SEAM(4);

    if (IN(5)) {
        LAS float* LAT = (LAS float*)lds;
        LAS float* QIT = (LAS float*)(lds + 16640);
        LAS float* KIT = (LAS float*)(lds + 16640 + 16384);
        LAS float* VV = (LAS float*)(lds + 16640 + 32768);
        LAS float* ST = (LAS float*)(lds + 16640 + 32768 + 32768);
        for (int u = bx; u < NUNIT; u += G) {
            const int h = u & 3, t0 = (u >> 2) * 64;
            const int i = tid & 63, dc = tid >> 6;
            {
                const float* la = LOGA + (size_t)(t0 + i) * 256 + h * 64 + dc * 8;
                const f32x4 a = *(const f32x4*)la, b = *(const f32x4*)(la + 4);
#pragma unroll
                for (int j = 0; j < 4; ++j) { LAT[(dc * 8 + j) * 65 + i] = a[j]; LAT[(dc * 8 + 4 + j) * 65 + i] = b[j]; }
            }
            __syncthreads();
            if (tid < 64) { float b = 0.f; for (int r = 0; r < 64; ++r) { b += LAT[tid * 65 + r]; LAT[tid * 65 + r] = b; } }
            __syncthreads();
            {
                const bf16_t* qp = PROJ + (size_t)(t0 + i) * NPROJ + h * 64 + dc * 8;
                const u32x4 qv = *(const u32x4*)qp, kv = *(const u32x4*)(qp + 256);
                const unsigned qw[4] = {qv.x, qv.y, qv.z, qv.w}, kw[4] = {kv.x, kv.y, kv.z, kv.w};
#pragma unroll
                for (int q = 0; q < 4; ++q) { const int d = dc * 8 + 2 * q; const float b0 = LAT[d * 65 + i], b1 = LAT[(d + 1) * 65 + i];
                    QIT[d * 64 + i] = bflo(qw[q]) * __expf(b0) * 0.125f; QIT[(d + 1) * 64 + i] = bfhi(qw[q]) * __expf(b1) * 0.125f;
                    KIT[d * 64 + i] = bflo(kw[q]) * __expf(-b0); KIT[(d + 1) * 64 + i] = bfhi(kw[q]) * __expf(-b1); }
                const bf16_t* vp = PROJ + (size_t)(t0 + i) * NPROJ + 512 + h * 128 + dc * 16;
#pragma unroll
                for (int q = 0; q < 2; ++q) { const u32x4 w = *(const u32x4*)(vp + 8 * q);
                    f32x4 a = {bflo(w.x), bfhi(w.x), bflo(w.y), bfhi(w.y)}, b = {bflo(w.z), bfhi(w.z), bflo(w.w), bfhi(w.w)};
                    *(LAS f32x4*)(VV + i * 128 + dc * 16 + 8 * q) = a; *(LAS f32x4*)(VV + i * 128 + dc * 16 + 8 * q + 4) = b; }
                const float* sp = KV + (size_t)u * 8192;
#pragma unroll
                for (int q = 0; q < 4; ++q) *(LAS f32x4*)(ST + (q * NTHR + tid) * 4) = *(const f32x4*)(sp + (q * NTHR + tid) * 4);
            }
            __syncthreads();
            float att[2][4];
            {
                const int tj = tid & 15, ti = tid >> 4;
#pragma unroll
                for (int a = 0; a < 2; ++a)
#pragma unroll
                    for (int b = 0; b < 4; ++b) att[a][b] = 0.f;
                for (int d = 0; d < 64; ++d) { const f32x2 q = *(const LAS f32x2*)(QIT + d * 64 + 2 * ti); const f32x4 k = *(const LAS f32x4*)(KIT + d * 64 + 4 * tj);
#pragma unroll
                    for (int b = 0; b < 4; ++b) { att[0][b] += q.x * k[b]; att[1][b] += q.y * k[b]; } }
#pragma unroll
                for (int a = 0; a < 2; ++a)
#pragma unroll
                    for (int b = 0; b < 4; ++b) if (4 * tj + b > 2 * ti + a) att[a][b] = 0.f;
            }
            __syncthreads();
            {
                const int tj = tid & 15, ti = tid >> 4;
                LAS float* ATTT = KIT;
#pragma unroll
                for (int b = 0; b < 4; ++b) *(LAS f32x2*)(ATTT + (4 * tj + b) * 64 + 2 * ti) = (f32x2){att[0][b], att[1][b]};
            }
            __syncthreads();
            {
                const int tv = tid & 31, ti = tid >> 5;
                LAS float* ATTT = KIT;
                f32x4 o[4];
#pragma unroll
                for (int a = 0; a < 4; ++a) o[a] = (f32x4){0.f, 0.f, 0.f, 0.f};
                for (int j = 0; j < 64; ++j) { const f32x4 vv = *(const LAS f32x4*)(VV + j * 128 + 4 * tv); const f32x4 at = *(const LAS f32x4*)(ATTT + j * 64 + 4 * ti);
                    o[0] += vv * at.x; o[1] += vv * at.y; o[2] += vv * at.z; o[3] += vv * at.w; }
                for (int d = 0; d < 64; ++d) { const f32x4 sv = *(const LAS f32x4*)(ST + d * 128 + 4 * tv); const f32x4 q = *(const LAS f32x4*)(QIT + d * 64 + 4 * ti);
                    o[0] += sv * q.x; o[1] += sv * q.y; o[2] += sv * q.z; o[3] += sv * q.w; }
                const f32x4 gn = *(const f32x4*)(gla_norm_g + 4 * tv);
#pragma unroll
                for (int a = 0; a < 4; ++a) {
                    float ss = o[a].x * o[a].x + o[a].y * o[a].y + o[a].z * o[a].z + o[a].w * o[a].w;
#pragma unroll
                    for (int off = 1; off < 32; off <<= 1) ss += __shfl_xor(ss, off);
                    const float rstd = 1.f / sqrtf(ss * (1.f / 128.f) + 1e-6f);
                    const int t = t0 + 4 * ti + a;
                    const u32x2 gw2 = *(const u32x2*)(PROJ + (size_t)t * NPROJ + 1024 + h * 128 + 4 * tv);
                    const f32x4 gg = {bflo(gw2.x), bfhi(gw2.x), bflo(gw2.y), bfhi(gw2.y)};
                    f32x4 y;
#pragma unroll
                    for (int j = 0; j < 4; ++j) y[j] = o[a][j] * rstd * gn[j] * silu_f(gg[j]);
                    u32x2 ov; ov.x = pk2(y.x, y.y); ov.y = pk2(y.z, y.w);
                    *(u32x2*)(H + (size_t)t * D + h * 128 + 4 * tv) = ov;
                }
            }
            __syncthreads();
        }
    }
    SEAM(5);

    if (IN(6)) {
        pg8::Gemm g{H, WOUT, M, D, D}; pg8::StaticOrder S; S.init(M, D, G, bx);
        EpiX1 E{x, X1, MOD + 2048};
        pg8::gemm_phase<EpiX1, pg8::StaticOrder, true, true>(lds, g, S, E);
    }
    SEAM(6);

    if (IN(7)) {
        for (int m = gw; m < M; m += NGW) { const float* md = MOD + (m >= SEQ ? 6144 : 0) + 3072; norm_mod_row(X1 + (size_t)m * D, norm2_g, md, md + 1024, H + (size_t)m * D, lane); }
    }
    SEAM(7);

    if (IN(8)) {
        pg8::Gemm g{H, WQ, M, 2048, D}; pg8::StaticOrder S; S.init(M, 2048, G, bx);
        EpiQ E{PROJ};
        pg8::gemm_phase<EpiQ, pg8::StaticOrder, true, true>(lds, g, S, E);
    }
    SEAM(8);

    if (IN(9)) {
        LAS bf16_t* KL = (LAS bf16_t*)lds;
        LAS float* SC = (LAS float*)(lds + 69632);
        for (int i = tid; i < 2 * 128 * 16; i += NTHR) { const int row = i >> 4, ck = i & 15; *(LAS u32x4*)(KL + row * 136 + ck * 8) = *(const u32x4*)(KK + row * 128 + ck * 8); }
        __syncthreads();
        const unsigned ij = CAND_IJ[lane];
        const int ci = ij >> 4, cj = ij & 15;
        const bf16_t* Q = PROJ;
        for (int it = bx; it < (M / 64) * 8; it += G) {
            const int tt = it >> 3, h = it & 7, t0 = tt * 64;
            {
                const int half = wave >> 2, mt = wave & 3, fr = lane & 15, fq = lane >> 4;
                const bf16_t* qp = Q + (size_t)(t0 + mt * 16 + fr) * 2048 + h * 256 + half * 128 + fq * 8;
                bf16x8 af[4];
#pragma unroll
                for (int ks = 0; ks < 4; ++ks) af[ks] = *(const bf16x8*)(qp + ks * 32);
                const LAS bf16_t* kb = KL + half * 128 * 136 + fr * 136 + fq * 8;
#pragma unroll
                for (int nt = 0; nt < 8; ++nt) {
                    f32x4 c = {0.f, 0.f, 0.f, 0.f};
#pragma unroll
                    for (int ks = 0; ks < 4; ++ks) { const bf16x8 bf = *(const LAS bf16x8*)(kb + nt * 16 * 136 + ks * 32); c = __builtin_amdgcn_mfma_f32_16x16x32_bf16(af[ks], bf, c, 0, 0, 0); }
#pragma unroll
                    for (int r = 0; r < 4; ++r) SC[(half * 64 + mt * 16 + fq * 4 + r) * 132 + nt * 16 + fr] = c[r];
                }
            }
            __syncthreads();
            for (int tk = 0; tk < 8; ++tk) {
                const int tl = wave * 8 + tk, hl = lane & 31, half = lane >> 5;
                const f32x4 s = *(const LAS f32x4*)(SC + (half * 64 + tl) * 132 + 4 * hl);
                unsigned k0 = fkey(s.x, 127u - (4 * hl + 0), 127u), k1 = fkey(s.y, 127u - (4 * hl + 1), 127u), k2 = fkey(s.z, 127u - (4 * hl + 2), 127u), k3 = fkey(s.w, 127u - (4 * hl + 3), 127u);
                unsigned res = 0u;
#pragma unroll
                for (int r = 0; r < 16; ++r) {
                    unsigned m = umax_(umax_(k0, k1), umax_(k2, k3));
                    m = umax_(m, dpp_u<0x111, 0xF>(m)); m = umax_(m, dpp_u<0x112, 0xF>(m)); m = umax_(m, dpp_u<0x114, 0xF>(m)); m = umax_(m, dpp_u<0x118, 0xF>(m));
                    m = umax_(m, dpp_u<0x142, 0xA>(m));
                    const unsigned m1 = __builtin_amdgcn_readlane(m, 31), m2 = __builtin_amdgcn_readlane(m, 63);
                    const unsigned mm = half ? m2 : m1;
                    k0 = (k0 == mm) ? 0u : k0; k1 = (k1 == mm) ? 0u : k1; k2 = (k2 == mm) ? 0u : k2; k3 = (k3 == mm) ? 0u : k3;
                    res = (hl == r) ? mm : res;
                }
                const unsigned ka = __builtin_amdgcn_ds_bpermute(4 * ci, res), kb2 = __builtin_amdgcn_ds_bpermute(4 * (32 + cj), res);
                const float csum = fkey_val(ka, 127u) + fkey_val(kb2, 127u);
                unsigned ck = (lane < 50) ? fkey(csum, 63u - lane, 63u) : 0u;
                unsigned res2 = 0u;
#pragma unroll
                for (int r = 0; r < 16; ++r) {
                    unsigned m = ck;
                    m = umax_(m, dpp_u<0x111, 0xF>(m)); m = umax_(m, dpp_u<0x112, 0xF>(m)); m = umax_(m, dpp_u<0x114, 0xF>(m)); m = umax_(m, dpp_u<0x118, 0xF>(m));
                    m = umax_(m, dpp_u<0x142, 0xA>(m)); m = umax_(m, dpp_u<0x143, 0xC>(m));
                    const unsigned mm = __builtin_amdgcn_readlane(m, 63);
                    ck = (ck == mm) ? 0u : ck;
                    res2 = (lane == r) ? mm : res2;
                }
                const unsigned L = 63u - (res2 & 63u);
                const unsigned ij2 = __builtin_amdgcn_ds_bpermute(4 * L, ij);
                const unsigned wa = __builtin_amdgcn_ds_bpermute(4 * (ij2 >> 4), res), wb = __builtin_amdgcn_ds_bpermute(4 * (32 + (ij2 & 15)), res);
                const int eid = (int)((127u - (wa & 127u)) * 128u + (127u - (wb & 127u)));
                const float sv = fkey_val(res2, 63u);
                const float mx = __builtin_bit_cast(float, __builtin_amdgcn_readlane(__builtin_bit_cast(int, sv), 0));
                const float ex = (lane < 16) ? __expf(sv - mx) : 0.f;
                float sm = ex;
                sm += dpp_f<0x111, 0xF>(sm); sm += dpp_f<0x112, 0xF>(sm); sm += dpp_f<0x114, 0xF>(sm); sm += dpp_f<0x118, 0xF>(sm);
                const float tot = __builtin_bit_cast(float, __builtin_amdgcn_readlane(__builtin_bit_cast(int, sm), 15));
                if (lane < 16) { const size_t o = (size_t)(t0 + tl) * 128 + h * 16 + lane; IDX[o] = eid; GATE[o] = ex / tot; }
            }
            __syncthreads();
        }
    }
    SEAM(9);

    if (IN(10)) {
        for (int t = gw; t < M; t += NGW) {
            const bf16_t* hp = H + (size_t)t * D + 16 * lane;
            const u32x4 ha = *(const u32x4*)hp, hb = *(const u32x4*)(hp + 8);
            const float hf[16] = {bflo(ha.x), bfhi(ha.x), bflo(ha.y), bfhi(ha.y), bflo(ha.z), bfhi(ha.z), bflo(ha.w), bfhi(ha.w),
                                  bflo(hb.x), bfhi(hb.x), bflo(hb.y), bfhi(hb.y), bflo(hb.z), bfhi(hb.z), bflo(hb.w), bfhi(hb.w)};
            float o[16];
#pragma unroll
            for (int j = 0; j < 16; ++j) o[j] = 0.f;
#pragma unroll 1
            for (int half = 0; half < 2; ++half) {
                const int idr = IDX[(size_t)t * 128 + half * 64 + lane];
                const float zs = SU[idr];
                const float as = GATE[(size_t)t * 128 + half * 64 + lane] * SV[idr];
#pragma unroll 1
                for (int c = 0; c < 8; ++c) {
                    u32x4 uu[8], vv[8];
#pragma unroll
                    for (int q = 0; q < 8; ++q) { const int eid = __builtin_amdgcn_readlane(idr, 8 * c + q);
                        uu[q] = *(const u32x4*)(U8 + (size_t)eid * 1024 + 16 * lane); vv[q] = *(const u32x4*)(V8 + (size_t)eid * 1024 + 16 * lane); }
                    float z[8];
#pragma unroll
                    for (int q = 0; q < 8; ++q) { const unsigned* w = (const unsigned*)&uu[q]; float a0 = 0.f, a1 = 0.f;
#pragma unroll
                        for (int k = 0; k < 4; ++k) { const f32x2 lo = __builtin_amdgcn_cvt_pk_f32_fp8((int)w[k], false), hi2 = __builtin_amdgcn_cvt_pk_f32_fp8((int)w[k], true);
                            a0 += hf[4 * k] * lo.x; a1 += hf[4 * k + 1] * lo.y; a0 += hf[4 * k + 2] * hi2.x; a1 += hf[4 * k + 3] * hi2.y; }
                        z[q] = a0 + a1; }
                    float r1[4], r2[2], r3;
#pragma unroll
                    for (int k = 0; k < 4; ++k) { const bool hi1 = lane & 1; const float keep = hi1 ? z[2 * k + 1] : z[2 * k], send = hi1 ? z[2 * k] : z[2 * k + 1]; r1[k] = keep + __shfl_xor(send, 1); }
#pragma unroll
                    for (int k = 0; k < 2; ++k) { const bool hi1 = lane & 2; const float keep = hi1 ? r1[2 * k + 1] : r1[2 * k], send = hi1 ? r1[2 * k] : r1[2 * k + 1]; r2[k] = keep + __shfl_xor(send, 2); }
                    { const bool hi1 = lane & 4; const float keep = hi1 ? r2[1] : r2[0], send = hi1 ? r2[0] : r2[1]; r3 = keep + __shfl_xor(send, 4); }
                    r3 += __shfl_xor(r3, 8); r3 += __shfl_xor(r3, 16); r3 += __shfl_xor(r3, 32);
                    const float act = gelu_f(r3 * zs) * as;
#pragma unroll
                    for (int q = 0; q < 8; ++q) { const float a = __builtin_bit_cast(float, __builtin_amdgcn_readlane(__builtin_bit_cast(int, act), 8 * c + q));
                        const unsigned* w = (const unsigned*)&vv[q];
#pragma unroll
                        for (int k = 0; k < 4; ++k) { const f32x2 lo = __builtin_amdgcn_cvt_pk_f32_fp8((int)w[k], false), hi2 = __builtin_amdgcn_cvt_pk_f32_fp8((int)w[k], true);
                            o[4 * k] += a * lo.x; o[4 * k + 1] += a * lo.y; o[4 * k + 2] += a * hi2.x; o[4 * k + 3] += a * hi2.y; } }
                }
            }
            const float* g2p = MOD + (t >= SEQ ? 6144 : 0) + 5120 + 16 * lane;
            float* xr = X1 + (size_t)t * D + 16 * lane;
            f32x4 xv[4]; float ss = 0.f;
#pragma unroll
            for (int q = 0; q < 4; ++q) { const f32x4 xx = *(const f32x4*)(xr + 4 * q), gg = *(const f32x4*)(g2p + 4 * q);
                const f32x4 ov = {o[q * 4 + 0], o[q * 4 + 1], o[q * 4 + 2], o[q * 4 + 3]};
                xv[q] = xx + gg * ov; ss += (xv[q].x * xv[q].x + xv[q].y * xv[q].y) + (xv[q].z * xv[q].z + xv[q].w * xv[q].w); }
            const float rstd = 1.f / sqrtf(wave_sum(ss) * (1.f / D) + 1e-6f);
#pragma unroll
            for (int q = 0; q < 4; ++q) { const f32x4 fg = *(const f32x4*)(final_g + 16 * lane + 4 * q);
                *(f32x4*)(xr + 4 * q) = xv[q] * rstd * fg; }
        }
    }
#undef IN
#undef SEAM
}

extern "C" void kernel_launch(void* const* d_in, const int* in_sizes, int n_in, void* d_out, int out_size, void* d_ws, size_t ws_size, hipStream_t stream) {
    static int grid = 0;
    if (grid == 0) {
        if (n_in != 19 || out_size != M * D || ws_size < WS_END) { fprintf(stderr, "kernel_launch: unexpected shapes (n_in %d out %d ws %zu)\n", n_in, out_size, ws_size); grid = -1; return; }
        int dev = 0, cus = 0, per_cu = 0;
        (void)hipGetDevice(&dev); (void)hipDeviceGetAttribute(&cus, hipDeviceAttributeMultiprocessorCount, dev);
        (void)hipFuncSetAttribute((const void*)fwd_kernel, hipFuncAttributeMaxDynamicSharedMemorySize, LDS_BYTES);
        (void)hipOccupancyMaxActiveBlocksPerMultiprocessor(&per_cu, (const void*)fwd_kernel, NTHR, LDS_BYTES);
        (void)hipGetLastError();
        if (per_cu < 1) { fprintf(stderr, "kernel_launch: occupancy query says %d blocks/CU\n", per_cu); per_cu = 1; }
        grid = cus;
    }
    if (grid < 0) return;
    (void)hipMemsetAsync((char*)d_ws + WS_CTL, 0, CTL_ZERO_BYTES, stream);
    Params p{};
    for (int i = 0; i < 19; ++i) p.in[i] = (const float*)d_in[i];
    p.out = (float*)d_out; p.ws = (unsigned char*)d_ws; p.ph_lo = 0; p.ph_hi = 11;
    void* args[] = {&p};
    hipError_t e = hipLaunchCooperativeKernel((const void*)fwd_kernel, dim3(grid), dim3(NTHR), args, LDS_BYTES, stream);
    if (e != hipSuccess) fprintf(stderr, "kernel_launch: cooperative launch failed: %s (grid %d)\n", hipGetErrorString(e), grid);
}
```

```cpp
#include <hip/hip_runtime.h>
#include <cstdio>
#include <cstdint>

#define LAS __attribute__((address_space(3)))
#define GAS __attribute__((address_space(1)))
typedef unsigned short bf16_t;
typedef short bf16x8 __attribute__((ext_vector_type(8)));
typedef float f32x4 __attribute__((ext_vector_type(4)));
typedef float f32x2 __attribute__((ext_vector_type(2)));
typedef unsigned u32x4 __attribute__((ext_vector_type(4)));
typedef unsigned u32x2 __attribute__((ext_vector_type(2)));
typedef __bf16 bf16x2_t __attribute__((ext_vector_type(2)));

namespace pg8 {
#define PG8_LAS __attribute__((address_space(3)))
constexpr int BM = 256, BK = 64, HALF = 128, HTB = HALF * BK * 2, STAGE_BYTES = 8 * HTB, NXCD = 8, WGM = 8;
__host__ __device__ __forceinline__ int lds_byte(int r, int c) { const int st = (r >> 4) * 2 + (c >> 5), rr = r & 15, cc = c & 31, ob = rr * 64 + cc * 2; return st * 1024 + (ob ^ (((ob >> 9) & 1) << 5)); }
__host__ __device__ __forceinline__ void stage_rc(int b, int& R, int& C) { const int st = b / 1024, sb = b % 1024, swz = sb ^ (((sb >> 9) & 1) << 5); R = (st >> 1) * 16 + swz / 64; C = (st & 1) * 32 + (swz % 64) / 2; }
__host__ __device__ __forceinline__ int perm32(int rho) { const int n = rho >> 4, i = rho & 15; return 8 * (i >> 2) + 4 * n + (i & 3); }
struct Unit { int pm, pn; };
struct Gemm { const bf16_t* A; const bf16_t* Bt; int M, N, K; };
struct StaticOrder {
    int nM, nN, nwg, G, c;
    __host__ __device__ void init(int M, int N, int G_, int c_) { nM = M / BM; nN = N / BM; nwg = nM * nN; G = G_; c = c_; }
    __host__ __device__ bool next(int i, Unit& u) const {
        const long L = (long)i * G + c; if (L >= nwg) return false;
        int wgid = (int)L; { const int q = nwg / NXCD, r = nwg % NXCD, xcd = wgid % NXCD, off = wgid / NXCD; wgid = (xcd < r ? xcd * (q + 1) : r * (q + 1) + (xcd - r) * q) + off; }
        const int nig = WGM * nN, gid = wgid / nig, fm = gid * WGM, gsz = (nM - fm) < WGM ? (nM - fm) : WGM;
        u.pm = fm + ((wgid % nig) % gsz); u.pn = (wgid % nig) / gsz; return true;
    }
    __device__ __forceinline__ void a_ready(const Unit&) const {}
    __device__ __forceinline__ void done(const Unit&) const {}
};
__device__ __forceinline__ unsigned cvt_pk_bf16(float lo, float hi) { unsigned r; asm volatile("v_cvt_pk_bf16_f32 %0, %1, %2" : "=v"(r) : "v"(lo), "v"(hi)); return r; }

template <class Epi, class Sched, bool ALIGN_EPI = false, bool SP2 = false>
__device__ __forceinline__ void gemm_phase(PG8_LAS unsigned char* lds, const Gemm g, const Sched& S, const Epi& E) {
    const int tid = threadIdx.x, wid = __builtin_amdgcn_readfirstlane(tid >> 6), lane = tid & 63, wr = wid >> 2, wc = wid & 3, fr = lane & 15, fq = lane >> 4;
    const int K = g.K, nt = K / BK;
    unsigned voffA[2], voffB[2];
#pragma unroll
    for (int i = 0; i < 2; ++i) { int R, C; stage_rc(tid * 16 + i * 8192, R, C); const int Rb = Epi::PERM ? ((R & ~31) + perm32(R & 31)) : R;
        voffA[i] = (unsigned)(R * K + C) * 2u; voffB[i] = (unsigned)(Rb * K + C) * 2u; }
    const size_t kstep = (size_t)(BK * 2);
    const size_t hstep = (size_t)HALF * K * 2;
    const size_t tstep = 2 * hstep;
    const unsigned ldsw = (unsigned)wid * 1024u;
    const int aoff = lds_byte(wr * 64 + fr, fq * 8), boff = lds_byte(wc * 32 + fr, fq * 8);
#define PG8_SA(b, h) (((b) * 2 + (h)) * HTB)
#define PG8_SB(b, h) ((4 + (b) * 2 + (h)) * HTB)
#define PG8_STAGE(bufoff, gbase, voff) do { _Pragma("unroll") for (int _i = 0; _i < 2; ++_i) \
        __builtin_amdgcn_global_load_lds((const unsigned*)((const char*)(gbase) + (voff)[_i]), (PG8_LAS unsigned*)(lds + (bufoff) + ldsw + _i * 8192), 16, 0, 0); } while (0)
#define PG8_LDA(dst, b, h) do { _Pragma("unroll") for (int m = 0; m < 4; ++m) _Pragma("unroll") for (int k = 0; k < 2; ++k) dst[m][k] = *(const PG8_LAS bf16x8*)(lds + PG8_SA(b, h) + aoff + m * 2048 + k * 1024); } while (0)
#define PG8_LDB(dst, b, h) do { _Pragma("unroll") for (int n = 0; n < 2; ++n) _Pragma("unroll") for (int k = 0; k < 2; ++k) dst[n][k] = *(const PG8_LAS bf16x8*)(lds + PG8_SB(b, h) + boff + n * 2048 + k * 1024); } while (0)
#define PG8_MMA(ai, bj, At, Bt) do { __builtin_amdgcn_s_setprio(1); _Pragma("unroll") for (int m = 0; m < 4; ++m) _Pragma("unroll") for (int n = 0; n < 2; ++n) _Pragma("unroll") for (int k = 0; k < 2; ++k) \
        acc[ai][bj][m][n] = __builtin_amdgcn_mfma_f32_16x16x32_bf16(Bt[n][k], At[m][k], acc[ai][bj][m][n], 0, 0, 0); __builtin_amdgcn_s_setprio(0); } while (0)
#define PG8_WAIT_V(n) asm volatile("s_waitcnt vmcnt(" #n ")" ::: "memory")
#define PG8_WAIT_L(n) asm volatile("s_waitcnt lgkmcnt(" #n ")" ::: "memory")
#define PG8_BAR __builtin_amdgcn_s_barrier()
#define PG8_SCHED __builtin_amdgcn_sched_barrier(0)
    Unit cur, nxt; int ui = 0;
    if (!S.next(0, cur)) return;
    f32x4 acc[2][2][4][2];
#pragma unroll
    for (int a = 0; a < 2; ++a)
#pragma unroll
        for (int b = 0; b < 2; ++b)
#pragma unroll
            for (int m = 0; m < 4; ++m)
#pragma unroll
                for (int n = 0; n < 2; ++n) acc[a][b][m][n] = (f32x4){0.f, 0.f, 0.f, 0.f};
    bf16x8 At[4][2], B0[2][2], B1[2][2];
    const char* cA = (const char*)g.A + (size_t)cur.pm * tstep; const char* cB = (const char*)g.Bt + (size_t)cur.pn * tstep;
    S.a_ready(cur);
    if constexpr (SP2) {
        PG8_STAGE(PG8_SB(0, 0), cB, voffB); PG8_STAGE(PG8_SB(0, 1), cB + hstep, voffB); PG8_STAGE(PG8_SA(0, 0), cA, voffA); PG8_STAGE(PG8_SA(0, 1), cA + hstep, voffA);
        if (wr == 1) PG8_BAR;
        PG8_WAIT_V(2); PG8_BAR;
        PG8_STAGE(PG8_SB(1, 0), cB + kstep, voffB); PG8_STAGE(PG8_SA(1, 0), cA + kstep, voffA); PG8_STAGE(PG8_SB(1, 1), cB + hstep + kstep, voffB);
        PG8_WAIT_V(6); PG8_BAR;
    } else {
        PG8_STAGE(PG8_SB(0, 0), cB, voffB); PG8_STAGE(PG8_SA(0, 0), cA, voffA); PG8_STAGE(PG8_SB(0, 1), cB + hstep, voffB); PG8_STAGE(PG8_SA(0, 1), cA + hstep, voffA);
        if (wr == 1) PG8_BAR;
        PG8_WAIT_V(4); PG8_BAR;
        PG8_STAGE(PG8_SB(1, 0), cB + kstep, voffB); PG8_STAGE(PG8_SA(1, 0), cA + kstep, voffA); PG8_STAGE(PG8_SB(1, 1), cB + hstep + kstep, voffB);
        PG8_WAIT_V(6); PG8_BAR;
    }
    for (;;) {
        const bool has_next = S.next(ui + 1, nxt);
        const char* nA = has_next ? (const char*)g.A + (size_t)nxt.pm * tstep : cA; const char* nB = has_next ? (const char*)g.Bt + (size_t)nxt.pn * tstep : cB;
        for (int t = 0; t < nt; t += 2) {
            const bool last = (t == nt - 2);
            const char* a1 = cA + (size_t)(t + 1) * kstep;
            const char* a2 = last ? nA : cA + (size_t)(t + 2) * kstep; const char* b2 = last ? nB : cB + (size_t)(t + 2) * kstep;
            const char* a3 = a2 + kstep; const char* b3 = b2 + kstep;
            if (last && has_next) S.a_ready(nxt);
            if constexpr (SP2) {
            PG8_LDB(B0, 0, 0); PG8_LDB(B1, 0, 1); PG8_SCHED; PG8_LDA(At, 0, 0); PG8_STAGE(PG8_SA(1, 1), a1 + hstep, voffA);
            PG8_WAIT_V(8); PG8_WAIT_L(0); PG8_BAR; PG8_MMA(0, 0, At, B0); PG8_MMA(0, 1, At, B1); PG8_BAR; PG8_SCHED;
            PG8_LDA(At, 0, 1); PG8_STAGE(PG8_SB(0, 0), b2, voffB); PG8_STAGE(PG8_SB(0, 1), b2 + hstep, voffB); PG8_STAGE(PG8_SA(0, 0), a2, voffA);
            PG8_WAIT_V(8); PG8_WAIT_L(0); PG8_BAR; PG8_MMA(1, 0, At, B0); PG8_MMA(1, 1, At, B1); PG8_BAR; PG8_SCHED;
            PG8_LDB(B0, 1, 0); PG8_LDB(B1, 1, 1); PG8_SCHED; PG8_LDA(At, 1, 0); PG8_STAGE(PG8_SA(0, 1), a2 + hstep, voffA);
            PG8_WAIT_V(8); PG8_WAIT_L(0); PG8_BAR; PG8_MMA(0, 0, At, B0); PG8_MMA(0, 1, At, B1); PG8_BAR; PG8_SCHED;
            PG8_LDA(At, 1, 1); PG8_STAGE(PG8_SB(1, 0), b3, voffB); PG8_STAGE(PG8_SB(1, 1), b3 + hstep, voffB); PG8_STAGE(PG8_SA(1, 0), a3, voffA);
            PG8_WAIT_V(8); PG8_WAIT_L(0); PG8_BAR; PG8_MMA(1, 0, At, B0); PG8_MMA(1, 1, At, B1); PG8_BAR; PG8_SCHED;
            } else {
            PG8_LDB(B0, 0, 0); PG8_SCHED; PG8_LDA(At, 0, 0); PG8_STAGE(PG8_SA(1, 1), a1 + hstep, voffA);
            PG8_WAIT_L(8); PG8_BAR; PG8_WAIT_L(0); PG8_MMA(0, 0, At, B0); PG8_BAR; PG8_SCHED;
            PG8_LDB(B1, 0, 1); PG8_STAGE(PG8_SB(0, 0), b2, voffB);
            PG8_BAR; PG8_WAIT_L(0); PG8_MMA(0, 1, At, B1); PG8_BAR;
            PG8_LDA(At, 0, 1); PG8_STAGE(PG8_SA(0, 0), a2, voffA);
            PG8_BAR; PG8_WAIT_L(0); PG8_MMA(1, 0, At, B0); PG8_BAR; PG8_SCHED;
            PG8_STAGE(PG8_SB(0, 1), b2 + hstep, voffB);
            PG8_WAIT_V(6); PG8_BAR; PG8_MMA(1, 1, At, B1); PG8_BAR;
            PG8_LDB(B0, 1, 0); PG8_SCHED; PG8_LDA(At, 1, 0); PG8_STAGE(PG8_SA(0, 1), a2 + hstep, voffA);
            PG8_WAIT_L(8); PG8_BAR; PG8_WAIT_L(0); PG8_MMA(0, 0, At, B0); PG8_BAR; PG8_SCHED;
            PG8_LDB(B1, 1, 1); PG8_STAGE(PG8_SB(1, 0), b3, voffB);
            PG8_BAR; PG8_WAIT_L(0); PG8_MMA(0, 1, At, B1); PG8_BAR;
            PG8_LDA(At, 1, 1); PG8_STAGE(PG8_SA(1, 0), a3, voffA);
            PG8_BAR; PG8_WAIT_L(0); PG8_MMA(1, 0, At, B0); PG8_BAR; PG8_SCHED;
            PG8_STAGE(PG8_SB(1, 1), b3 + hstep, voffB);
            PG8_WAIT_V(6); PG8_BAR; PG8_MMA(1, 1, At, B1); PG8_BAR;
            }
        }
        if constexpr (ALIGN_EPI) { if (wr == 0) PG8_BAR; }
        E(acc, cur, wr, wc, fr, fq); S.done(cur);
        if (!has_next) break;
#pragma unroll
        for (int a = 0; a < 2; ++a)
#pragma unroll
            for (int b = 0; b < 2; ++b)
#pragma unroll
                for (int m = 0; m < 4; ++m)
#pragma unroll
                    for (int n = 0; n < 2; ++n) acc[a][b][m][n] = (f32x4){0.f, 0.f, 0.f, 0.f};
        cur = nxt; cA = nA; cB = nB; ++ui;
        if constexpr (ALIGN_EPI) { if (wr == 1) PG8_BAR; }
    }
    PG8_WAIT_V(0);
    if constexpr (!ALIGN_EPI) { if (wr == 0) PG8_BAR; }
    PG8_BAR;
#undef PG8_SA
#undef PG8_SB
#undef PG8_STAGE
#undef PG8_LDA
#undef PG8_LDB
#undef PG8_MMA
#undef PG8_WAIT_V
#undef PG8_WAIT_L
#undef PG8_BAR
#undef PG8_SCHED
}
}

#ifndef DUPMASK
#define DUPMASK 0
#endif
constexpr int NB = 2, SEQ = 8192, D = 1024, M = NB * SEQ;
constexpr int NPROJ = 2048, NIN = 2304, INLD = 2064;
constexpr int NUNIT = 1024;
constexpr int NEXP = 16384;
constexpr size_t MiB = 1u << 20;
constexpr size_t WS_CTL = 0, CTL_ZERO_BYTES = 64 * 1024;
constexpr size_t WS_MOD = 1 * MiB;
constexpr size_t WS_DEC = 1 * MiB + 512 * 1024;
constexpr size_t WS_WIN = 2 * MiB;
constexpr size_t WS_WOUT = 7 * MiB;
constexpr size_t WS_WQ = 9 * MiB;
constexpr size_t WS_KK = 13 * MiB;
constexpr size_t WS_IDX = 14 * MiB;
constexpr size_t WS_GATE = 22 * MiB;
constexpr size_t WS_LOGA = 30 * MiB;
constexpr size_t WS_KV = 46 * MiB;
constexpr size_t WS_H = 78 * MiB;
constexpr size_t WS_U8 = 110 * MiB;
constexpr size_t WS_V8 = 126 * MiB;
constexpr size_t WS_SU = 142 * MiB;
constexpr size_t WS_SV = 142 * MiB + 65536;
constexpr size_t WS_PROJ = 174 * MiB;
constexpr size_t WS_END = 238 * MiB;
constexpr int CW_BAR = 1024;
constexpr int NWAVES = 8, NTHR = 512;
constexpr int LDS_BYTES = 147456, MISC_OFF = 147456 - 256;

#define XB_TMO      128
#define XB_XCNT(j)  (256  + 64 * (j))
#define XB_XSUB(j)  (1280 + 64 * (j))
#define XB_XGEN(j)  (2304 + 64 * (j))
#define XB_TOP      3328
#define XB_TOPGEN   3392
#define XCD_BAR_WORDS 3456
#define XB_SPIN_CAP (1u << 20)
__device__ __forceinline__ unsigned xb_ld(unsigned* p)              { return __hip_atomic_load(p, __ATOMIC_RELAXED, __HIP_MEMORY_SCOPE_AGENT); }
__device__ __forceinline__ unsigned xb_add(unsigned* p, unsigned v) { return __hip_atomic_fetch_add(p, v, __ATOMIC_RELAXED, __HIP_MEMORY_SCOPE_AGENT); }
__device__ __forceinline__ unsigned xb_xcc_id() { return (unsigned)__builtin_amdgcn_s_getreg((3 << 11) | 20) & 0xFu; }
#define XB_SPIN(cond, bar) do { unsigned _sp = 0; while (cond) { __builtin_amdgcn_s_sleep(1); \
    if ((++_sp & 255u) == 0u) { if (xb_ld(&(bar)[XB_TMO])) break; if (_sp > XB_SPIN_CAP) { atomicAdd(&(bar)[XB_TMO], 1u); break; } } } } while (0)
struct XcdBarrier { unsigned* bar; unsigned x; volatile LAS unsigned* st; };
__device__ __forceinline__ XcdBarrier xcd_barrier_post(unsigned* bar, volatile LAS unsigned* st) {
    XcdBarrier b; b.bar = bar; b.x = xb_xcc_id(); b.st = st;
    if (threadIdx.x == 0) (void)xb_add(&bar[XB_XCNT(b.x)], 1u);
    return b;
}
__device__ __forceinline__ void xcd_barrier_complete(unsigned* bar, unsigned x, unsigned& nloc, unsigned& nx) {
    const unsigned G = gridDim.x * gridDim.y * gridDim.z;
    unsigned sum, cnt, mine, sp = 0u;
    for (;;) {
        sum = 0u; cnt = 0u; mine = 0u;
#pragma unroll
        for (unsigned j = 0; j < 16; ++j) { const unsigned c = xb_ld(&bar[XB_XCNT(j)]); sum += c; cnt += (c > 0u) ? 1u : 0u; mine = (j == x) ? c : mine; }
        if (sum == G) break;
        __builtin_amdgcn_s_sleep(1);
        if ((++sp & 255u) == 0u) { if (xb_ld(&bar[XB_TMO])) break; if (sp > XB_SPIN_CAP) { atomicAdd(&bar[XB_TMO], 1u); break; } }
    }
    nloc = mine > 0u ? mine : 1u; nx = cnt > 0u ? cnt : 1u;
}
__device__ __forceinline__ void xcd_barrier(const XcdBarrier& b) {
    asm volatile("s_waitcnt vmcnt(0)" ::: "memory");
    __syncthreads();
    if (threadIdx.x == 0) {
        unsigned* bar = b.bar;
        __builtin_amdgcn_s_waitcnt(0);
        unsigned nloc = b.st[0], nx = b.st[1];
        if (nloc == 0u) { xcd_barrier_complete(bar, b.x, nloc, nx); b.st[0] = nloc; b.st[1] = nx; }
        const unsigned old = xb_add(&bar[XB_XSUB(b.x)], 1u);
        const unsigned gen = old / nloc;
        if (old + 1u == (gen + 1u) * nloc) {
            __builtin_amdgcn_fence(__ATOMIC_RELEASE, "agent");
            asm volatile("s_waitcnt vmcnt(0)" ::: "memory");
            const unsigned og = xb_add(&bar[XB_TOP], 1u);
            const unsigned tg = og / nx;
            if (og + 1u == (tg + 1u) * nx) xb_add(&bar[XB_TOPGEN], 1u);
            else XB_SPIN(xb_ld(&bar[XB_TOPGEN]) == tg, bar);
            __builtin_amdgcn_fence(__ATOMIC_ACQUIRE, "agent");
            xb_add(&bar[XB_XGEN(b.x)], 1u);
            asm volatile("s_waitcnt vmcnt(0)" ::: "memory");
        } else {
            XB_SPIN(xb_ld(&bar[XB_XGEN(b.x)]) == gen, bar);
            __builtin_amdgcn_fence(__ATOMIC_ACQUIRE, "agent");
            asm volatile("s_waitcnt vmcnt(0)" ::: "memory");
        }
    }
    __syncthreads();
}

__device__ __forceinline__ unsigned f2bf(float f) { unsigned u = __builtin_bit_cast(unsigned, f); return (u + 0x7fffu + ((u >> 16) & 1u)) >> 16; }
__device__ __forceinline__ unsigned pk2(float lo, float hi) { return f2bf(lo) | (f2bf(hi) << 16); }
__device__ __forceinline__ float bflo(unsigned w) { return __builtin_bit_cast(float, w << 16); }
__device__ __forceinline__ float bfhi(unsigned w) { return __builtin_bit_cast(float, w & 0xffff0000u); }
__device__ __forceinline__ float wave_sum(float v) {
#pragma unroll
    for (int o = 1; o < 64; o <<= 1) v += __shfl_xor(v, o);
    return v;
}
__device__ __forceinline__ float silu_f(float x) { return x / (1.f + __expf(-x)); }
__device__ __forceinline__ float logsig_f(float x) { return fminf(x, 0.f) - log1pf(__expf(-fabsf(x))); }
__device__ __forceinline__ float gelu_f(float x) { return 0.5f * x * (1.f + erff(x * 0.70710678118654752f)); }

struct Params { const float* in[19]; float* out; unsigned char* ws; int ph_lo, ph_hi; };

struct EpiProj {
    static constexpr bool PERM = true;
    bf16_t* P; float* LA; const float* gb;
    __device__ __forceinline__ void operator()(const f32x4 (&acc)[2][2][4][2], const pg8::Unit& u, int wr, int wc, int fr, int fq) const {
        const int row0 = u.pm * 256 + wr * 64 + fr;
        if (u.pn < 8) {
            const int col0 = u.pn * 256 + wc * 32 + 8 * fq;
#pragma unroll
            for (int ai = 0; ai < 2; ++ai)
#pragma unroll
                for (int m = 0; m < 4; ++m) { bf16_t* rowp = P + (size_t)(row0 + ai * 128 + m * 16) * NPROJ + col0;
#pragma unroll
                    for (int bj = 0; bj < 2; ++bj) { const f32x4 v0 = acc[ai][bj][m][0], v1 = acc[ai][bj][m][1];
                        u32x4 w; w.x = pg8::cvt_pk_bf16(v0[0], v0[1]); w.y = pg8::cvt_pk_bf16(v0[2], v0[3]); w.z = pg8::cvt_pk_bf16(v1[0], v1[1]); w.w = pg8::cvt_pk_bf16(v1[2], v1[3]);
                        *(u32x4*)(rowp + bj * 128) = w; } }
        } else {
            const int col0 = wc * 32 + 8 * fq;
            f32x4 bv[2][2];
#pragma unroll
            for (int bj = 0; bj < 2; ++bj)
#pragma unroll
                for (int n = 0; n < 2; ++n) bv[bj][n] = *(const f32x4*)(gb + col0 + bj * 128 + 4 * n);
#pragma unroll
            for (int ai = 0; ai < 2; ++ai)
#pragma unroll
                for (int m = 0; m < 4; ++m) { float* rowp = LA + (size_t)(row0 + ai * 128 + m * 16) * 256 + col0;
#pragma unroll
                    for (int bj = 0; bj < 2; ++bj)
#pragma unroll
                        for (int n = 0; n < 2; ++n) { const f32x4 v = acc[ai][bj][m][n] + bv[bj][n]; f32x4 o;
#pragma unroll
                            for (int j = 0; j < 4; ++j) o[j] = logsig_f(v[j]) * (1.0f / 16.0f);
                            *(f32x4*)(rowp + bj * 128 + 4 * n) = o; } }
        }
    }
};
struct EpiX1 {
    static constexpr bool PERM = false;
    const float* x; float* X1; const float* gate;
    __device__ __forceinline__ void operator()(const f32x4 (&acc)[2][2][4][2], const pg8::Unit& u, int wr, int wc, int fr, int fq) const {
        const int row0 = u.pm * 256 + wr * 64 + fr, col0 = u.pn * 256 + wc * 32 + 4 * fq;
        const float* gp = gate + (u.pm >= 32 ? 6144 : 0);
        f32x4 gv[2][2];
#pragma unroll
        for (int bj = 0; bj < 2; ++bj)
#pragma unroll
            for (int n = 0; n < 2; ++n) gv[bj][n] = *(const f32x4*)(gp + col0 + bj * 128 + n * 16);
#pragma unroll
        for (int ai = 0; ai < 2; ++ai)
#pragma unroll
            for (int m = 0; m < 4; ++m) { const size_t ro = (size_t)(row0 + ai * 128 + m * 16) * D + col0;
#pragma unroll
                for (int bj = 0; bj < 2; ++bj)
#pragma unroll
                    for (int n = 0; n < 2; ++n) { const f32x4 xv = *(const f32x4*)(x + ro + bj * 128 + n * 16);
                        *(f32x4*)(X1 + ro + bj * 128 + n * 16) = xv + gv[bj][n] * acc[ai][bj][m][n]; } }
    }
};
struct EpiQ {
    static constexpr bool PERM = true;
    bf16_t* Q;
    __device__ __forceinline__ void operator()(const f32x4 (&acc)[2][2][4][2], const pg8::Unit& u, int wr, int wc, int fr, int fq) const {
        const int row0 = u.pm * 256 + wr * 64 + fr, col0 = u.pn * 256 + wc * 32 + 8 * fq;
#pragma unroll
        for (int ai = 0; ai < 2; ++ai)
#pragma unroll
            for (int m = 0; m < 4; ++m) { bf16_t* rowp = Q + (size_t)(row0 + ai * 128 + m * 16) * 2048 + col0;
#pragma unroll
                for (int bj = 0; bj < 2; ++bj) { const f32x4 v0 = acc[ai][bj][m][0], v1 = acc[ai][bj][m][1];
                    u32x4 w; w.x = pg8::cvt_pk_bf16(v0[0], v0[1]); w.y = pg8::cvt_pk_bf16(v0[2], v0[3]); w.z = pg8::cvt_pk_bf16(v1[0], v1[1]); w.w = pg8::cvt_pk_bf16(v1[2], v1[3]);
                    *(u32x4*)(rowp + bj * 128) = w; } }
    }
};

__device__ __forceinline__ void transpose_item(const float* W, int ldw, int k0, int n0, bf16_t* WT, int ldt, int row0, LAS float* scr, int lane) {
#pragma unroll 8
    for (int i = 0; i < 32; ++i) { const int kk = 2 * i + (lane >> 5); scr[kk * 33 + (lane & 31)] = W[(size_t)(k0 + kk) * ldw + n0 + (lane & 31)]; }
    asm volatile("s_waitcnt lgkmcnt(0)" ::: "memory");
    const int c = lane & 7;
#pragma unroll
    for (int j = 0; j < 4; ++j) { const int n = (lane >> 3) + 8 * j; const LAS float* s = scr + (8 * c) * 33 + n;
        u32x4 o; o.x = pk2(s[0 * 33], s[1 * 33]); o.y = pk2(s[2 * 33], s[3 * 33]); o.z = pk2(s[4 * 33], s[5 * 33]); o.w = pk2(s[6 * 33], s[7 * 33]);
        *(u32x4*)(WT + (size_t)(row0 + n0 + n) * ldt + k0 + 8 * c) = o; }
    asm volatile("s_waitcnt lgkmcnt(0)" ::: "memory");
}

__device__ __forceinline__ void norm_mod_row(const float* xrow, const float* g, const float* shift, const float* scale, bf16_t* orow, int lane) {
    f32x4 v[4]; float s = 0.f;
#pragma unroll
    for (int j = 0; j < 4; ++j) { v[j] = *(const f32x4*)(xrow + 4 * lane + 256 * j); s += (v[j].x * v[j].x + v[j].y * v[j].y) + (v[j].z * v[j].z + v[j].w * v[j].w); }
    const float rstd = 1.f / sqrtf(wave_sum(s) * (1.f / D) + 1e-6f);
#pragma unroll
    for (int j = 0; j < 4; ++j) { const int c = 4 * lane + 256 * j;
        const f32x4 gg = *(const f32x4*)(g + c), sh = *(const f32x4*)(shift + c), sc = *(const f32x4*)(scale + c);
        const f32x4 y = v[j] * rstd * gg * (sc + 1.0f) + sh;
        u32x2 o; o.x = pk2(y.x, y.y); o.y = pk2(y.z, y.w);
        *(u32x2*)(orow + c) = o; }
}

__constant__ unsigned char CAND_IJ[64] = {
    0x00,0x01,0x02,0x03,0x04,0x05,0x06,0x07,0x08,0x09,0x0a,0x0b,0x0c,0x0d,0x0e,0x0f,
    0x10,0x11,0x12,0x13,0x14,0x15,0x16,0x17,
    0x20,0x21,0x22,0x23,0x24,
    0x30,0x31,0x32,0x33,
    0x40,0x41,0x42,
    0x50,0x51, 0x60,0x61, 0x70,0x71,
    0x80,0x90,0xa0,0xb0,0xc0,0xd0,0xe0,0xf0,
    0,0,0,0,0,0,0,0,0,0,0,0,0,0};

__device__ __forceinline__ unsigned fkey(float f, unsigned idbits, unsigned idmask) {
    unsigned u = __builtin_bit_cast(unsigned, f); u = (u & 0x80000000u) ? ~u : (u | 0x80000000u);
    return (u & ~idmask) | idbits;
}
__device__ __forceinline__ float fkey_val(unsigned key, unsigned idmask) {
    unsigned u = key & ~idmask; u = (u & 0x80000000u) ? (u ^ 0x80000000u) : ~u;
    return __builtin_bit_cast(float, u);
}
template <int CTRL, int ROWMASK> __device__ __forceinline__ unsigned dpp_u(unsigned v) { return (unsigned)__builtin_amdgcn_update_dpp(0, (int)v, CTRL, ROWMASK, 0xF, true); }
template <int CTRL, int ROWMASK> __device__ __forceinline__ float dpp_f(float v) { return __builtin_bit_cast(float, __builtin_amdgcn_update_dpp(0, __builtin_bit_cast(int, v), CTRL, ROWMASK, 0xF, true)); }
__device__ __forceinline__ unsigned umax_(unsigned a, unsigned b) { return a > b ? a : b; }
__device__ __forceinline__ unsigned umin_(unsigned a, unsigned b) { return a < b ? a : b; }
template <int N> __device__ __forceinline__ unsigned ror_u(unsigned v) { return (unsigned)__builtin_amdgcn_update_dpp((int)v, (int)v, 0x120 + N, 0xF, 0xF, false); }
template <int N> __device__ __forceinline__ float ror_f(float v) { return __builtin_bit_cast(float, __builtin_amdgcn_update_dpp(__builtin_bit_cast(int, v), __builtin_bit_cast(int, v), 0x120 + N, 0xF, 0xF, false)); }
__device__ __forceinline__ unsigned row_allmax(unsigned m) { m = umax_(m, ror_u<1>(m)); m = umax_(m, ror_u<2>(m)); m = umax_(m, ror_u<4>(m)); m = umax_(m, ror_u<8>(m)); return m; }
__device__ __forceinline__ float row_allsum(float m) { m += ror_f<1>(m); m += ror_f<2>(m); m += ror_f<4>(m); m += ror_f<8>(m); return m; }

__global__ void __launch_bounds__(NTHR, 2) fwd_kernel(Params p) {
    extern __shared__ __attribute__((aligned(16))) unsigned char lds_raw[];
    LAS unsigned char* lds = (LAS unsigned char*)lds_raw;
    const int tid = threadIdx.x, lane = tid & 63, wave = __builtin_amdgcn_readfirstlane(tid >> 6);
    const int G = gridDim.x, bx = blockIdx.x;
    const int gw = bx * NWAVES + wave, NGW = G * NWAVES;
    unsigned char* ws = p.ws;
    unsigned* ctl = (unsigned*)(ws + WS_CTL);
    float* MOD = (float*)(ws + WS_MOD);
    float* DEC = (float*)(ws + WS_DEC);
    bf16_t* WIN = (bf16_t*)(ws + WS_WIN);
    bf16_t* WOUT = (bf16_t*)(ws + WS_WOUT);
    bf16_t* WQ = (bf16_t*)(ws + WS_WQ);
    bf16_t* KK = (bf16_t*)(ws + WS_KK);
    int* IDX = (int*)(ws + WS_IDX);
    float* GATE = (float*)(ws + WS_GATE);
    float* LOGA = (float*)(ws + WS_LOGA);
    float* KV = (float*)(ws + WS_KV);
    bf16_t* H = (bf16_t*)(ws + WS_H);
    unsigned char* U8 = ws + WS_U8;
    unsigned char* V8 = ws + WS_V8;
    float* SU = (float*)(ws + WS_SU);
    float* SV = (float*)(ws + WS_SV);
    bf16_t* PROJ = (bf16_t*)(ws + WS_PROJ);
    const float* x = p.in[0]; const float* cvec = p.in[1]; const float* ada_w = p.in[2]; const float* ada_b = p.in[3]; const float* norm1_g = p.in[4];
    const float* w_in = p.in[5]; const float* gate_w = p.in[6]; const float* gate_b = p.in[7]; const float* gla_norm_g = p.in[8];
    const float* pool_w = p.in[9]; const float* pool_scale = p.in[10]; const float* w_out = p.in[11]; const float* norm2_g = p.in[12];
    const float* peer_wq = p.in[13]; const float* peer_k1 = p.in[14]; const float* peer_k2 = p.in[15]; const float* peer_u = p.in[16]; const float* peer_v = p.in[17];
    const float* final_g = p.in[18];
    float* X1 = p.out;

    volatile LAS unsigned* MISC = (volatile LAS unsigned*)(lds + MISC_OFF);
    if (tid < 64) MISC[tid] = 0u;
    __syncthreads();
    XcdBarrier bar = xcd_barrier_post(ctl + CW_BAR, MISC + 8);
    const int lo = p.ph_lo, hi = p.ph_hi;
#define IN(k) (lo <= (k) && (k) < hi)
#define REP(k) for (int rep_ = 0; rep_ < 1 + ((DUPMASK >> (k)) & 1); ++rep_)
#define SEAM(k) do { if (IN(k) && IN((k) + 1)) xcd_barrier(bar); } while (0)

    if (IN(0)) REP(0) {
        {
            LAS float* sc = (LAS float*)lds;
            LAS f32x4* red = (LAS f32x4*)(lds + 8192);
            for (int i = tid; i < 2048; i += NTHR) sc[i] = silu_f(cvec[i]);
            __syncthreads();
            for (int cb = bx; cb < 256; cb += G) {
                if (tid < 384) {
                    const int f4 = tid % 6, rg = tid / 6;
                    f32x4 a0 = {0.f, 0.f, 0.f, 0.f}, a1 = {0.f, 0.f, 0.f, 0.f};
#pragma unroll 4
                    for (int i = 0; i < 16; ++i) { const int r = rg + 64 * i; const f32x4 w = *(const f32x4*)(ada_w + (size_t)r * 6144 + 24 * cb + 4 * f4);
                        a0 += w * sc[r]; a1 += w * sc[1024 + r]; }
                    red[(rg * 6 + f4) * 2 + 0] = a0; red[(rg * 6 + f4) * 2 + 1] = a1;
                }
                __syncthreads();
                if (tid < 48) { const int b = tid / 24, col = tid % 24; float s = 0.f;
                    for (int rg = 0; rg < 64; ++rg) s += red[(rg * 6 + (col >> 2)) * 2 + b][col & 3];
                    MOD[b * 6144 + 24 * cb + col] = s + ada_b[24 * cb + col]; }
                __syncthreads();
            }
        }
        for (int it = bx; it < 128; it += G) {
            const int g = it >> 5, nb = (it >> 1) & 15, cb = it & 1;
            LAS float* PW = (LAS float*)lds;
            LAS float* WO = (LAS float*)(lds + 32768);
            for (int i = tid; i < 64 * 128; i += NTHR) { const int c = i >> 7, j = i & 127; PW[i] = pool_w[(size_t)(g * 128 + cb * 64 + c) * 128 + j] * pool_scale[g * 128 + j]; }
            for (int i = tid; i < 128 * 64; i += NTHR) { const int j = i >> 6, n = i & 63; WO[i] = w_out[(size_t)(512 + g * 128 + j) * 1024 + nb * 64 + n]; }
            __syncthreads();
            const int n = tid & 63, cg = tid >> 6;
            float a[8];
#pragma unroll
            for (int q = 0; q < 8; ++q) a[q] = 0.f;
            for (int j = 0; j < 128; ++j) { const float wo = WO[j * 64 + n];
#pragma unroll
                for (int q = 0; q < 8; ++q) a[q] += PW[(cg * 8 + q) * 128 + j] * wo; }
            u32x4 o; o.x = pk2(a[0], a[1]); o.y = pk2(a[2], a[3]); o.z = pk2(a[4], a[5]); o.w = pk2(a[6], a[7]);
            *(u32x4*)(WOUT + (size_t)(nb * 64 + n) * 1024 + 512 + g * 128 + cb * 64 + cg * 8) = o;
            __syncthreads();
        }
        {
            LAS float* scr = (LAS float*)(lds + wave * 16384);
            constexpr int I_IN = 16 * 64, I_Q = 16 * 64, I_O = 8 * 32;
            for (int it = gw; it < I_IN + I_Q + I_O; it += NGW) {
                int r = it;
                if (r < I_IN) { transpose_item(w_in, INLD, (r >> 6) * 64, (r & 63) * 32, WIN, 1024, 0, scr, lane); continue; } r -= I_IN;
                if (r < I_Q) { transpose_item(peer_wq, 2048, (r >> 6) * 64, (r & 63) * 32, WQ, 1024, 0, scr, lane); continue; } r -= I_Q;
                transpose_item(w_out, 1024, (r >> 5) * 64, (r & 31) * 32, WOUT, 1024, 0, scr, lane);
            }
        }
        for (int o = bx * NTHR + tid; o < 256 * 1024; o += G * NTHR) { const int j = o >> 10, k = o & 1023; float s = 0.f;
#pragma unroll
            for (int r = 0; r < 16; ++r) s += w_in[(size_t)k * INLD + 2048 + r] * gate_w[r * 256 + j];
            WIN[(size_t)(2048 + j) * 1024 + k] = (bf16_t)f2bf(s); }
        for (int r = gw; r < 2 * NEXP; r += NGW) {
            const bool isv = r >= NEXP; const int row = isv ? r - NEXP : r;
            const float* src = (isv ? peer_v : peer_u) + (size_t)row * 1024 + 16 * lane;
            f32x4 v[4]; float am = 0.f;
#pragma unroll
            for (int q = 0; q < 4; ++q) { v[q] = *(const f32x4*)(src + 4 * q); am = fmaxf(am, fmaxf(fmaxf(fabsf(v[q].x), fabsf(v[q].y)), fmaxf(fabsf(v[q].z), fabsf(v[q].w)))); }
#pragma unroll
            for (int off = 1; off < 64; off <<= 1) am = fmaxf(am, __shfl_xor(am, off));
            const float sc = am > 0.f ? am * (1.0f / 384.0f) : 1.0f, inv = 1.0f / sc;
            u32x4 o; unsigned* op = (unsigned*)&o;
#pragma unroll
            for (int q = 0; q < 4; ++q) { int w = 0; w = __builtin_amdgcn_cvt_pk_fp8_f32(v[q].x * inv, v[q].y * inv, w, false); w = __builtin_amdgcn_cvt_pk_fp8_f32(v[q].z * inv, v[q].w * inv, w, true); op[q] = (unsigned)w; }
            *(u32x4*)((isv ? V8 : U8) + (size_t)row * 1024 + 16 * lane) = o;
            if (lane == 0) (isv ? SV : SU)[row] = sc;
        }
        for (int i = bx * NTHR + tid; i < 2 * 128 * 128; i += G * NTHR) KK[i] = (bf16_t)f2bf(i < 16384 ? peer_k1[i] : peer_k2[i - 16384]);
    }
    SEAM(0);

    if (IN(1)) REP(1) {
        for (int m = gw; m < M; m += NGW) { const float* md = MOD + (m >= SEQ ? 6144 : 0); norm_mod_row(x + (size_t)m * D, norm1_g, md, md + 1024, H + (size_t)m * D, lane); }
    }
    SEAM(1);

    if (IN(2)) REP(2) {
        pg8::Gemm g{H, WIN, M, NIN, D}; pg8::StaticOrder S; S.init(M, NIN, G, bx);
        EpiProj E{PROJ, LOGA, gate_b};
        pg8::gemm_phase<EpiProj, pg8::StaticOrder, true, true>(lds, g, S, E);
    }
    SEAM(2);

    if (IN(3)) REP(3) {
        const int hb = tid >> 8, ht = tid & 255;
        LAS float* LAT = (LAS float*)(lds + hb * 69632);
        LAS float* KST = (LAS float*)(lds + hb * 69632 + 16640);
        LAS float* VV = (LAS float*)(lds + hb * 69632 + 16640 + 17408);
        for (int it = 0; it < (NUNIT + 2 * G - 1) / (2 * G); ++it) {
            const int u = (it * G + bx) * 2 + hb;
            const bool act = u < NUNIT;
            const int h = u & 3, t0 = (u >> 2) * 64;
            const int c = ht & 63, dc = ht >> 6;
            if (act) {
                const float* la = LOGA + (size_t)(t0 + c) * 256 + h * 64 + dc * 16;
#pragma unroll
                for (int q = 0; q < 4; ++q) { const f32x4 v = *(const f32x4*)(la + 4 * q);
#pragma unroll
                    for (int j = 0; j < 4; ++j) LAT[(dc * 16 + q * 4 + j) * 65 + c] = v[j]; }
            }
            __syncthreads();
            if (act && ht < 64) { float b = 0.f; for (int i = 0; i < 64; ++i) { b += LAT[ht * 65 + i]; LAT[ht * 65 + i] = b; } DEC[u * 64 + ht] = __expf(b); }
            __syncthreads();
            if (act) {
                const bf16_t* kp = PROJ + (size_t)(t0 + c) * NPROJ + 256 + h * 64 + dc * 16;
                const u32x4 k0 = *(const u32x4*)kp, k1 = *(const u32x4*)(kp + 8);
                const unsigned kw[8] = {k0.x, k0.y, k0.z, k0.w, k1.x, k1.y, k1.z, k1.w};
#pragma unroll
                for (int q = 0; q < 8; ++q) { const int d = dc * 16 + 2 * q;
                    KST[c * 68 + d] = bflo(kw[q]) * __expf(LAT[d * 65 + 63] - LAT[d * 65 + c]);
                    KST[c * 68 + d + 1] = bfhi(kw[q]) * __expf(LAT[(d + 1) * 65 + 63] - LAT[(d + 1) * 65 + c]); }
                const bf16_t* vp = PROJ + (size_t)(t0 + c) * NPROJ + 512 + h * 128 + dc * 32;
#pragma unroll
                for (int q = 0; q < 4; ++q) { const u32x4 w = *(const u32x4*)(vp + 8 * q);
                    f32x4 a = {bflo(w.x), bfhi(w.x), bflo(w.y), bfhi(w.y)}, b = {bflo(w.z), bfhi(w.z), bflo(w.w), bfhi(w.w)};
                    *(LAS f32x4*)(VV + c * 132 + dc * 32 + 8 * q) = a; *(LAS f32x4*)(VV + c * 132 + dc * 32 + 8 * q + 4) = b; }
            }
            __syncthreads();
            if (act) {
                const int tv = ht & 31, td = ht >> 5;
                f32x4 a[8];
#pragma unroll
                for (int q = 0; q < 8; ++q) a[q] = (f32x4){0.f, 0.f, 0.f, 0.f};
                for (int cc = 0; cc < 64; ++cc) {
                    const f32x4 vv = *(const LAS f32x4*)(VV + cc * 132 + 4 * tv);
                    const f32x4 ka = *(const LAS f32x4*)(KST + cc * 68 + 8 * td), kb = *(const LAS f32x4*)(KST + cc * 68 + 8 * td + 4);
                    a[0] += vv * ka.x; a[1] += vv * ka.y; a[2] += vv * ka.z; a[3] += vv * ka.w;
                    a[4] += vv * kb.x; a[5] += vv * kb.y; a[6] += vv * kb.z; a[7] += vv * kb.w;
                }
                float* kvp = KV + (size_t)u * 8192 + (8 * td) * 128 + 4 * tv;
#pragma unroll
                for (int q = 0; q < 8; ++q) *(f32x4*)(kvp + q * 128) = a[q];
            }
            __syncthreads();
        }
        for (int it = bx * NTHR + tid; it < (M / 8) * 64; it += G * NTHR) {
            const int cv = it & 63, run = it >> 6, ch = cv * 8, gq = ch >> 7, w = 2 << gq;
            const int t0 = run * 8, pos0 = t0 & (SEQ - 1);
            const bf16_t* pp = PROJ + 1536 + ch;
            float s[8];
#pragma unroll
            for (int j = 0; j < 8; ++j) s[j] = 0.f;
            for (int q = 1; q <= w; ++q) if (pos0 - q >= 0) { const u32x4 v = *(const u32x4*)(pp + (size_t)(t0 - q) * NPROJ);
                s[0] += bflo(v.x); s[1] += bfhi(v.x); s[2] += bflo(v.y); s[3] += bfhi(v.y); s[4] += bflo(v.z); s[5] += bfhi(v.z); s[6] += bflo(v.w); s[7] += bfhi(v.w); }
            for (int r = 0; r < 8; ++r) {
                const int t = t0 + r, pos = pos0 + r;
                const u32x4 v = *(const u32x4*)(pp + (size_t)t * NPROJ);
                const float cur[8] = {bflo(v.x), bfhi(v.x), bflo(v.y), bfhi(v.y), bflo(v.z), bfhi(v.z), bflo(v.w), bfhi(v.w)};
#pragma unroll
                for (int j = 0; j < 8; ++j) s[j] += cur[j];
                if (pos >= w) { const u32x4 o = *(const u32x4*)(pp + (size_t)(t - w) * NPROJ);
                    s[0] -= bflo(o.x); s[1] -= bfhi(o.x); s[2] -= bflo(o.y); s[3] -= bfhi(o.y); s[4] -= bflo(o.z); s[5] -= bfhi(o.z); s[6] -= bflo(o.w); s[7] -= bfhi(o.w); }
                const float inv = 1.f / (float)((pos + 1) < w ? (pos + 1) : w);
                u32x4 ov; ov.x = pk2(s[0] * inv - cur[0], s[1] * inv - cur[1]); ov.y = pk2(s[2] * inv - cur[2], s[3] * inv - cur[3]);
                ov.z = pk2(s[4] * inv - cur[4], s[5] * inv - cur[5]); ov.w = pk2(s[6] * inv - cur[6], s[7] * inv - cur[7]);
                *(u32x4*)(H + (size_t)t * D + 512 + ch) = ov;
            }
        }
    }
    SEAM(3);

    if (IN(4)) REP(4) {
        for (int sq = bx * NTHR + tid; sq < 8 * 8192; sq += G * NTHR) {
            const int bh = sq >> 13, e = sq & 8191, b = bh >> 2, h = bh & 3, d = e >> 7;
            float st = 0.f;
            for (int n0 = 0; n0 < 128; n0 += 8) {
                float kv[8], dc[8];
#pragma unroll
                for (int q = 0; q < 8; ++q) { const int u = ((b * 128 + n0 + q) * 4 + h); kv[q] = KV[(size_t)u * 8192 + e]; dc[q] = DEC[u * 64 + d]; }
#pragma unroll
                for (int q = 0; q < 8; ++q) { const int u = ((b * 128 + n0 + q) * 4 + h); KV[(size_t)u * 8192 + e] = st; st = st * dc[q] + kv[q]; }
            }
        }
    }
    SEAM(4);

    if (IN(5)) REP(5) {
        LAS float* LAT = (LAS float*)lds;
        LAS float* QIT = (LAS float*)(lds + 16640);
        LAS float* KIT = (LAS float*)(lds + 16640 + 16384);
        LAS float* VV = (LAS float*)(lds + 16640 + 32768);
        LAS float* ST = (LAS float*)(lds + 16640 + 32768 + 32768);
        for (int u = bx; u < NUNIT; u += G) {
            const int h = u & 3, t0 = (u >> 2) * 64;
            const int i = tid & 63, dc = tid >> 6;
            {
                const float* la = LOGA + (size_t)(t0 + i) * 256 + h * 64 + dc * 8;
                const f32x4 a = *(const f32x4*)la, b = *(const f32x4*)(la + 4);
#pragma unroll
                for (int j = 0; j < 4; ++j) { LAT[(dc * 8 + j) * 65 + i] = a[j]; LAT[(dc * 8 + 4 + j) * 65 + i] = b[j]; }
            }
            __syncthreads();
            if (tid < 64) { float b = 0.f; for (int r = 0; r < 64; ++r) { b += LAT[tid * 65 + r]; LAT[tid * 65 + r] = b; } }
            __syncthreads();
            {
                const bf16_t* qp = PROJ + (size_t)(t0 + i) * NPROJ + h * 64 + dc * 8;
                const u32x4 qv = *(const u32x4*)qp, kv = *(const u32x4*)(qp + 256);
                const unsigned qw[4] = {qv.x, qv.y, qv.z, qv.w}, kw[4] = {kv.x, kv.y, kv.z, kv.w};
#pragma unroll
                for (int q = 0; q < 4; ++q) { const int d = dc * 8 + 2 * q; const float b0 = LAT[d * 65 + i], b1 = LAT[(d + 1) * 65 + i];
                    QIT[d * 64 + i] = bflo(qw[q]) * __expf(b0) * 0.125f; QIT[(d + 1) * 64 + i] = bfhi(qw[q]) * __expf(b1) * 0.125f;
                    KIT[d * 64 + i] = bflo(kw[q]) * __expf(-b0); KIT[(d + 1) * 64 + i] = bfhi(kw[q]) * __expf(-b1); }
                const bf16_t* vp = PROJ + (size_t)(t0 + i) * NPROJ + 512 + h * 128 + dc * 16;
#pragma unroll
                for (int q = 0; q < 2; ++q) { const u32x4 w = *(const u32x4*)(vp + 8 * q);
                    f32x4 a = {bflo(w.x), bfhi(w.x), bflo(w.y), bfhi(w.y)}, b = {bflo(w.z), bfhi(w.z), bflo(w.w), bfhi(w.w)};
                    *(LAS f32x4*)(VV + i * 128 + dc * 16 + 8 * q) = a; *(LAS f32x4*)(VV + i * 128 + dc * 16 + 8 * q + 4) = b; }
                const float* sp = KV + (size_t)u * 8192;
#pragma unroll
                for (int q = 0; q < 4; ++q) *(LAS f32x4*)(ST + (q * NTHR + tid) * 4) = *(const f32x4*)(sp + (q * NTHR + tid) * 4);
            }
            __syncthreads();
            float att[2][4];
            {
                const int tj = tid & 15, ti = tid >> 4;
#pragma unroll
                for (int a = 0; a < 2; ++a)
#pragma unroll
                    for (int b = 0; b < 4; ++b) att[a][b] = 0.f;
                for (int d = 0; d < 64; ++d) { const f32x2 q = *(const LAS f32x2*)(QIT + d * 64 + 2 * ti); const f32x4 k = *(const LAS f32x4*)(KIT + d * 64 + 4 * tj);
#pragma unroll
                    for (int b = 0; b < 4; ++b) { att[0][b] += q.x * k[b]; att[1][b] += q.y * k[b]; } }
#pragma unroll
                for (int a = 0; a < 2; ++a)
#pragma unroll
                    for (int b = 0; b < 4; ++b) if (4 * tj + b > 2 * ti + a) att[a][b] = 0.f;
            }
            __syncthreads();
            {
                const int tj = tid & 15, ti = tid >> 4;
                LAS float* ATTT = KIT;
#pragma unroll
                for (int b = 0; b < 4; ++b) *(LAS f32x2*)(ATTT + (4 * tj + b) * 64 + 2 * ti) = (f32x2){att[0][b], att[1][b]};
            }
            __syncthreads();
            {
                const int tv = tid & 31, ti = tid >> 5;
                LAS float* ATTT = KIT;
                f32x4 o[4];
#pragma unroll
                for (int a = 0; a < 4; ++a) o[a] = (f32x4){0.f, 0.f, 0.f, 0.f};
                for (int j = 0; j < 64; ++j) { const f32x4 vv = *(const LAS f32x4*)(VV + j * 128 + 4 * tv); const f32x4 at = *(const LAS f32x4*)(ATTT + j * 64 + 4 * ti);
                    o[0] += vv * at.x; o[1] += vv * at.y; o[2] += vv * at.z; o[3] += vv * at.w; }
                for (int d = 0; d < 64; ++d) { const f32x4 sv = *(const LAS f32x4*)(ST + d * 128 + 4 * tv); const f32x4 q = *(const LAS f32x4*)(QIT + d * 64 + 4 * ti);
                    o[0] += sv * q.x; o[1] += sv * q.y; o[2] += sv * q.z; o[3] += sv * q.w; }
                const f32x4 gn = *(const f32x4*)(gla_norm_g + 4 * tv);
#pragma unroll
                for (int a = 0; a < 4; ++a) {
                    float ss = o[a].x * o[a].x + o[a].y * o[a].y + o[a].z * o[a].z + o[a].w * o[a].w;
#pragma unroll
                    for (int off = 1; off < 32; off <<= 1) ss += __shfl_xor(ss, off);
                    const float rstd = 1.f / sqrtf(ss * (1.f / 128.f) + 1e-6f);
                    const int t = t0 + 4 * ti + a;
                    const u32x2 gw2 = *(const u32x2*)(PROJ + (size_t)t * NPROJ + 1024 + h * 128 + 4 * tv);
                    const f32x4 gg = {bflo(gw2.x), bfhi(gw2.x), bflo(gw2.y), bfhi(gw2.y)};
                    f32x4 y;
#pragma unroll
                    for (int j = 0; j < 4; ++j) y[j] = o[a][j] * rstd * gn[j] * silu_f(gg[j]);
                    u32x2 ov; ov.x = pk2(y.x, y.y); ov.y = pk2(y.z, y.w);
                    *(u32x2*)(H + (size_t)t * D + h * 128 + 4 * tv) = ov;
                }
            }
            __syncthreads();
        }
    }
    SEAM(5);

    if (IN(6)) REP(6) {
        pg8::Gemm g{H, WOUT, M, D, D}; pg8::StaticOrder S; S.init(M, D, G, bx);
        EpiX1 E{x, X1, MOD + 2048};
        pg8::gemm_phase<EpiX1, pg8::StaticOrder, true, true>(lds, g, S, E);
    }
    SEAM(6);

    if (IN(7)) REP(7) {
        for (int m = gw; m < M; m += NGW) { const float* md = MOD + (m >= SEQ ? 6144 : 0) + 3072; norm_mod_row(X1 + (size_t)m * D, norm2_g, md, md + 1024, H + (size_t)m * D, lane); }
    }
    SEAM(7);

    if (IN(8)) REP(8) {
        pg8::Gemm g{H, WQ, M, 2048, D}; pg8::StaticOrder S; S.init(M, 2048, G, bx);
        EpiQ E{PROJ};
        pg8::gemm_phase<EpiQ, pg8::StaticOrder, true, true>(lds, g, S, E);
    }
    SEAM(8);

    if (IN(9)) REP(9) {
        LAS bf16_t* KL = (LAS bf16_t*)lds;
        LAS unsigned char* CT = lds + 69632;
        for (int i = tid; i < 2 * 128 * 16; i += NTHR) { const int row = i >> 4, ck = i & 15; *(LAS u32x4*)(KL + row * 136 + ck * 8) = *(const u32x4*)(KK + row * 128 + ck * 8); }
        if (tid < 64) CT[tid] = CAND_IJ[tid];
        __syncthreads();
        const int fr = lane & 15, fq = lane >> 4, rb4 = (lane & 48) * 4;
        int cia[4], cja[4];
#pragma unroll
        for (int sl = 0; sl < 4; ++sl) { const unsigned ij = CAND_IJ[fr * 4 + sl]; cia[sl] = rb4 + 4 * (int)(ij >> 4); cja[sl] = rb4 + 4 * (int)(ij & 15); }
        const bf16_t* Q = PROJ;
        for (int wi = gw; wi < (M / 16) * 8; wi += NGW) {
            const int h = wi & 7, t0 = (wi >> 3) * 16;
            unsigned kk[8][8];
#pragma unroll
            for (int half = 0; half < 2; ++half) {
                const bf16_t* qp = Q + (size_t)(t0 + fr) * 2048 + h * 256 + half * 128 + fq * 8;
                bf16x8 af[4];
#pragma unroll
                for (int ks = 0; ks < 4; ++ks) af[ks] = *(const bf16x8*)(qp + ks * 32);
                int kboff = half * 128 * 136 + fr * 136 + fq * 8;
                asm volatile("" : "+v"(kboff));
                const LAS bf16_t* kb = KL + kboff;
#pragma unroll
                for (int nt = 0; nt < 8; ++nt) {
                    f32x4 c = {0.f, 0.f, 0.f, 0.f};
#pragma unroll
                    for (int ks = 0; ks < 4; ++ks) { const bf16x8 bf = *(const LAS bf16x8*)(kb + nt * 16 * 136 + ks * 32); c = __builtin_amdgcn_mfma_f32_16x16x32_bf16(af[ks], bf, c, 0, 0, 0); }
#pragma unroll
                    for (int r = 0; r < 4; ++r) kk[half * 4 + r][nt] = fkey(c[r], 127u - (unsigned)(nt * 16 + fr), 127u);
                }
            }
#define CE(a, b) do { const unsigned hi_ = umax_(kx[a], kx[b]), lo_ = umin_(kx[a], kx[b]); kx[a] = hi_; kx[b] = lo_; } while (0)
#pragma unroll
            for (int x = 0; x < 8; ++x) { unsigned (&kx)[8] = kk[x];
                CE(0, 1); CE(2, 3); CE(4, 5); CE(6, 7); CE(0, 2); CE(1, 3); CE(4, 6); CE(5, 7); CE(1, 2); CE(5, 6);
                CE(0, 4); CE(1, 5); CE(2, 6); CE(3, 7); CE(2, 4); CE(3, 5); CE(1, 2); CE(3, 4); CE(5, 6); }
            unsigned res[8];
#pragma unroll
            for (int x = 0; x < 8; ++x) res[x] = 0u;
#pragma unroll 1
            for (int rd = 0; rd < 16; ++rd)
#pragma unroll
                for (int x = 0; x < 8; ++x) { unsigned (&kx)[8] = kk[x];
                    const unsigned m = row_allmax(kx[0]); const bool own = kx[0] == m;
#pragma unroll
                    for (int j = 0; j < 7; ++j) kx[j] = own ? kx[j + 1] : kx[j];
                    kx[7] = own ? 0u : kx[7];
                    res[x] = (fr == rd) ? m : res[x]; }
            unsigned ck[4][4];
#pragma unroll
            for (int r = 0; r < 4; ++r)
#pragma unroll
                for (int sl = 0; sl < 4; ++sl) { const unsigned va = __builtin_amdgcn_ds_bpermute(cia[sl], res[r]), vb = __builtin_amdgcn_ds_bpermute(cja[sl], res[4 + r]);
                    const float sum = fkey_val(va, 127u) + fkey_val(vb, 127u);
                    ck[r][sl] = (fr * 4 + sl < 50) ? fkey(sum, 63u - (unsigned)(fr * 4 + sl), 63u) : 0u; }
#pragma unroll
            for (int r = 0; r < 4; ++r) { unsigned (&kx)[4] = ck[r]; CE(0, 1); CE(2, 3); CE(0, 2); CE(1, 3); CE(1, 2); }
#undef CE
            unsigned res3[4], mfirst[4];
#pragma unroll
            for (int r = 0; r < 4; ++r) { res3[r] = 0u; mfirst[r] = 0u; }
#pragma unroll 1
            for (int rd = 0; rd < 16; ++rd)
#pragma unroll
                for (int r = 0; r < 4; ++r) { unsigned (&kx)[4] = ck[r];
                    const unsigned m = row_allmax(kx[0]); const bool own = kx[0] == m;
                    kx[0] = own ? kx[1] : kx[0]; kx[1] = own ? kx[2] : kx[1]; kx[2] = own ? kx[3] : kx[2]; kx[3] = own ? 0u : kx[3];
                    res3[r] = (fr == rd) ? m : res3[r]; mfirst[r] = (rd == 0) ? m : mfirst[r]; }
#pragma unroll
            for (int r = 0; r < 4; ++r) {
                const unsigned cidx = 63u - (res3[r] & 63u);
                const unsigned ij = CT[cidx];
                const unsigned wa = __builtin_amdgcn_ds_bpermute(rb4 + 4 * (int)(ij >> 4), res[r]), wb = __builtin_amdgcn_ds_bpermute(rb4 + 4 * (int)(ij & 15), res[4 + r]);
                const int eid = (int)((127u - (wa & 127u)) * 128u + (127u - (wb & 127u)));
                const float ex = __expf(fkey_val(res3[r], 63u) - fkey_val(mfirst[r], 63u));
                const float tot = row_allsum(ex);
                const size_t o = (size_t)(t0 + 4 * fq + r) * 128 + h * 16 + fr;
                IDX[o] = eid; GATE[o] = ex / tot;
            }
        }
    }
    SEAM(9);

    if (IN(10)) REP(10) {
        for (int t = gw; t < M; t += NGW) {
            const bf16_t* hp = H + (size_t)t * D + 16 * lane;
            const u32x4 ha = *(const u32x4*)hp, hb = *(const u32x4*)(hp + 8);
            const float hf[16] = {bflo(ha.x), bfhi(ha.x), bflo(ha.y), bfhi(ha.y), bflo(ha.z), bfhi(ha.z), bflo(ha.w), bfhi(ha.w),
                                  bflo(hb.x), bfhi(hb.x), bflo(hb.y), bfhi(hb.y), bflo(hb.z), bfhi(hb.z), bflo(hb.w), bfhi(hb.w)};
            float o[16];
#pragma unroll
            for (int j = 0; j < 16; ++j) o[j] = 0.f;
#pragma unroll 1
            for (int half = 0; half < 2; ++half) {
                const int idr = IDX[(size_t)t * 128 + half * 64 + lane];
                const float zs = SU[idr];
                const float as = GATE[(size_t)t * 128 + half * 64 + lane] * SV[idr];
#pragma unroll 1
                for (int c = 0; c < 8; ++c) {
                    u32x4 uu[8], vv[8];
#pragma unroll
                    for (int q = 0; q < 8; ++q) { const int eid = __builtin_amdgcn_readlane(idr, 8 * c + q);
                        uu[q] = *(const u32x4*)(U8 + (size_t)eid * 1024 + 16 * lane); vv[q] = *(const u32x4*)(V8 + (size_t)eid * 1024 + 16 * lane); }
                    float z[8];
#pragma unroll
                    for (int q = 0; q < 8; ++q) { const unsigned* w = (const unsigned*)&uu[q]; float a0 = 0.f, a1 = 0.f;
#pragma unroll
                        for (int k = 0; k < 4; ++k) { const f32x2 lo = __builtin_amdgcn_cvt_pk_f32_fp8((int)w[k], false), hi2 = __builtin_amdgcn_cvt_pk_f32_fp8((int)w[k], true);
                            a0 += hf[4 * k] * lo.x; a1 += hf[4 * k + 1] * lo.y; a0 += hf[4 * k + 2] * hi2.x; a1 += hf[4 * k + 3] * hi2.y; }
                        z[q] = a0 + a1; }
                    float r1[4], r2[2], r3;
#pragma unroll
                    for (int k = 0; k < 4; ++k) { const bool hi1 = lane & 1; const float keep = hi1 ? z[2 * k + 1] : z[2 * k], send = hi1 ? z[2 * k] : z[2 * k + 1]; r1[k] = keep + __shfl_xor(send, 1); }
#pragma unroll
                    for (int k = 0; k < 2; ++k) { const bool hi1 = lane & 2; const float keep = hi1 ? r1[2 * k + 1] : r1[2 * k], send = hi1 ? r1[2 * k] : r1[2 * k + 1]; r2[k] = keep + __shfl_xor(send, 2); }
                    { const bool hi1 = lane & 4; const float keep = hi1 ? r2[1] : r2[0], send = hi1 ? r2[0] : r2[1]; r3 = keep + __shfl_xor(send, 4); }
                    r3 += __shfl_xor(r3, 8); r3 += __shfl_xor(r3, 16); r3 += __shfl_xor(r3, 32);
                    const float act = gelu_f(r3 * zs) * as;
#pragma unroll
                    for (int q = 0; q < 8; ++q) { const float a = __builtin_bit_cast(float, __builtin_amdgcn_readlane(__builtin_bit_cast(int, act), 8 * c + q));
                        const unsigned* w = (const unsigned*)&vv[q];
#pragma unroll
                        for (int k = 0; k < 4; ++k) { const f32x2 lo = __builtin_amdgcn_cvt_pk_f32_fp8((int)w[k], false), hi2 = __builtin_amdgcn_cvt_pk_f32_fp8((int)w[k], true);
                            o[4 * k] += a * lo.x; o[4 * k + 1] += a * lo.y; o[4 * k + 2] += a * hi2.x; o[4 * k + 3] += a * hi2.y; } }
                }
            }
            const float* g2p = MOD + (t >= SEQ ? 6144 : 0) + 5120 + 16 * lane;
            float* xr = X1 + (size_t)t * D + 16 * lane;
            f32x4 xv[4]; float ss = 0.f;
#pragma unroll
            for (int q = 0; q < 4; ++q) { const f32x4 xx = *(const f32x4*)(xr + 4 * q), gg = *(const f32x4*)(g2p + 4 * q);
                const f32x4 ov = {o[q * 4 + 0], o[q * 4 + 1], o[q * 4 + 2], o[q * 4 + 3]};
                xv[q] = xx + gg * ov; ss += (xv[q].x * xv[q].x + xv[q].y * xv[q].y) + (xv[q].z * xv[q].z + xv[q].w * xv[q].w); }
            const float rstd = 1.f / sqrtf(wave_sum(ss) * (1.f / D) + 1e-6f);
#pragma unroll
            for (int q = 0; q < 4; ++q) { const f32x4 fg = *(const f32x4*)(final_g + 16 * lane + 4 * q);
                *(f32x4*)(xr + 4 * q) = xv[q] * rstd * fg; }
        }
    }
#undef IN
#undef REP
#undef SEAM
}

extern "C" void kernel_launch(void* const* d_in, const int* in_sizes, int n_in, void* d_out, int out_size, void* d_ws, size_t ws_size, hipStream_t stream) {
    static int grid = 0;
    if (grid == 0) {
        if (n_in != 19 || out_size != M * D || ws_size < WS_END) { fprintf(stderr, "kernel_launch: unexpected shapes (n_in %d out %d ws %zu)\n", n_in, out_size, ws_size); grid = -1; return; }
        int dev = 0, cus = 0, per_cu = 0;
        (void)hipGetDevice(&dev); (void)hipDeviceGetAttribute(&cus, hipDeviceAttributeMultiprocessorCount, dev);
        (void)hipFuncSetAttribute((const void*)fwd_kernel, hipFuncAttributeMaxDynamicSharedMemorySize, LDS_BYTES);
        (void)hipOccupancyMaxActiveBlocksPerMultiprocessor(&per_cu, (const void*)fwd_kernel, NTHR, LDS_BYTES);
        (void)hipGetLastError();
        if (per_cu < 1) { fprintf(stderr, "kernel_launch: occupancy query says %d blocks/CU\n", per_cu); per_cu = 1; }
        grid = cus;
    }
    if (grid < 0) return;
    (void)hipMemsetAsync((char*)d_ws + WS_CTL, 0, CTL_ZERO_BYTES, stream);
    Params p{};
    for (int i = 0; i < 19; ++i) p.in[i] = (const float*)d_in[i];
    p.out = (float*)d_out; p.ws = (unsigned char*)d_ws; p.ph_lo = 0; p.ph_hi = 11;
    void* args[] = {&p};
    hipError_t e = hipLaunchCooperativeKernel((const void*)fwd_kernel, dim3(grid), dim3(NTHR), args, LDS_BYTES, stream);
    if (e != hipSuccess) fprintf(stderr, "kernel_launch: cooperative launch failed: %s (grid %d)\n", hipGetErrorString(e), grid);
}
```

```cpp
#include <hip/hip_runtime.h>
#include <cstdio>
#include <cstdint>

#define LAS __attribute__((address_space(3)))
#define GAS __attribute__((address_space(1)))
typedef unsigned short bf16_t;
typedef short bf16x8 __attribute__((ext_vector_type(8)));
typedef float f32x4 __attribute__((ext_vector_type(4)));
typedef float f32x2 __attribute__((ext_vector_type(2)));
typedef unsigned u32x4 __attribute__((ext_vector_type(4)));
typedef unsigned u32x2 __attribute__((ext_vector_type(2)));
typedef __bf16 bf16x2_t __attribute__((ext_vector_type(2)));

namespace pg8 {
#define PG8_LAS __attribute__((address_space(3)))
constexpr int BM = 256, BK = 64, HALF = 128, HTB = HALF * BK * 2, STAGE_BYTES = 8 * HTB, NXCD = 8, WGM = 8;
__host__ __device__ __forceinline__ int lds_byte(int r, int c) { const int st = (r >> 4) * 2 + (c >> 5), rr = r & 15, cc = c & 31, ob = rr * 64 + cc * 2; return st * 1024 + (ob ^ (((ob >> 9) & 1) << 5)); }
__host__ __device__ __forceinline__ void stage_rc(int b, int& R, int& C) { const int st = b / 1024, sb = b % 1024, swz = sb ^ (((sb >> 9) & 1) << 5); R = (st >> 1) * 16 + swz / 64; C = (st & 1) * 32 + (swz % 64) / 2; }
__host__ __device__ __forceinline__ int perm32(int rho) { const int n = rho >> 4, i = rho & 15; return 8 * (i >> 2) + 4 * n + (i & 3); }
struct Unit { int pm, pn; };
struct Gemm { const bf16_t* A; const bf16_t* Bt; int M, N, K; };
struct StaticOrder {
    int nM, nN, nwg, G, c;
    __host__ __device__ void init(int M, int N, int G_, int c_) { nM = M / BM; nN = N / BM; nwg = nM * nN; G = G_; c = c_; }
    __host__ __device__ bool next(int i, Unit& u) const {
        const long L = (long)i * G + c; if (L >= nwg) return false;
        int wgid = (int)L; { const int q = nwg / NXCD, r = nwg % NXCD, xcd = wgid % NXCD, off = wgid / NXCD; wgid = (xcd < r ? xcd * (q + 1) : r * (q + 1) + (xcd - r) * q) + off; }
        const int nig = WGM * nN, gid = wgid / nig, fm = gid * WGM, gsz = (nM - fm) < WGM ? (nM - fm) : WGM;
        u.pm = fm + ((wgid % nig) % gsz); u.pn = (wgid % nig) / gsz; return true;
    }
    __device__ __forceinline__ void a_ready(const Unit&) const {}
    __device__ __forceinline__ void done(const Unit&) const {}
};
__device__ __forceinline__ unsigned cvt_pk_bf16(float lo, float hi) { unsigned r; asm volatile("v_cvt_pk_bf16_f32 %0, %1, %2" : "=v"(r) : "v"(lo), "v"(hi)); return r; }

template <class Epi, class Sched, bool ALIGN_EPI = false, bool SP2 = false>
__device__ __forceinline__ void gemm_phase(PG8_LAS unsigned char* lds, const Gemm g, const Sched& S, const Epi& E) {
    const int tid = threadIdx.x, wid = __builtin_amdgcn_readfirstlane(tid >> 6), lane = tid & 63, wr = wid >> 2, wc = wid & 3, fr = lane & 15, fq = lane >> 4;
    const int K = g.K, nt = K / BK;
    unsigned voffA[2], voffB[2];
#pragma unroll
    for (int i = 0; i < 2; ++i) { int R, C; stage_rc(tid * 16 + i * 8192, R, C); const int Rb = Epi::PERM ? ((R & ~31) + perm32(R & 31)) : R;
        voffA[i] = (unsigned)(R * K + C) * 2u; voffB[i] = (unsigned)(Rb * K + C) * 2u; }
    const size_t kstep = (size_t)(BK * 2);
    const size_t hstep = (size_t)HALF * K * 2;
    const size_t tstep = 2 * hstep;
    const unsigned ldsw = (unsigned)wid * 1024u;
    const int aoff = lds_byte(wr * 64 + fr, fq * 8), boff = lds_byte(wc * 32 + fr, fq * 8);
#define PG8_SA(b, h) (((b) * 2 + (h)) * HTB)
#define PG8_SB(b, h) ((4 + (b) * 2 + (h)) * HTB)
#define PG8_STAGE(bufoff, gbase, voff) do { _Pragma("unroll") for (int _i = 0; _i < 2; ++_i) \
        __builtin_amdgcn_global_load_lds((const unsigned*)((const char*)(gbase) + (voff)[_i]), (PG8_LAS unsigned*)(lds + (bufoff) + ldsw + _i * 8192), 16, 0, 0); } while (0)
#define PG8_LDA(dst, b, h) do { _Pragma("unroll") for (int m = 0; m < 4; ++m) _Pragma("unroll") for (int k = 0; k < 2; ++k) dst[m][k] = *(const PG8_LAS bf16x8*)(lds + PG8_SA(b, h) + aoff + m * 2048 + k * 1024); } while (0)
#define PG8_LDB(dst, b, h) do { _Pragma("unroll") for (int n = 0; n < 2; ++n) _Pragma("unroll") for (int k = 0; k < 2; ++k) dst[n][k] = *(const PG8_LAS bf16x8*)(lds + PG8_SB(b, h) + boff + n * 2048 + k * 1024); } while (0)
#define PG8_MMA(ai, bj, At, Bt) do { __builtin_amdgcn_s_setprio(1); _Pragma("unroll") for (int m = 0; m < 4; ++m) _Pragma("unroll") for (int n = 0; n < 2; ++n) _Pragma("unroll") for (int k = 0; k < 2; ++k) \
        acc[ai][bj][m][n] = __builtin_amdgcn_mfma_f32_16x16x32_bf16(Bt[n][k], At[m][k], acc[ai][bj][m][n], 0, 0, 0); __builtin_amdgcn_s_setprio(0); } while (0)
#define PG8_WAIT_V(n) asm volatile("s_waitcnt vmcnt(" #n ")" ::: "memory")
#define PG8_WAIT_L(n) asm volatile("s_waitcnt lgkmcnt(" #n ")" ::: "memory")
#define PG8_BAR __builtin_amdgcn_s_barrier()
#define PG8_SCHED __builtin_amdgcn_sched_barrier(0)
    Unit cur, nxt; int ui = 0;
    if (!S.next(0, cur)) return;
    f32x4 acc[2][2][4][2];
#pragma unroll
    for (int a = 0; a < 2; ++a)
#pragma unroll
        for (int b = 0; b < 2; ++b)
#pragma unroll
            for (int m = 0; m < 4; ++m)
#pragma unroll
                for (int n = 0; n < 2; ++n) acc[a][b][m][n] = (f32x4){0.f, 0.f, 0.f, 0.f};
    bf16x8 At[4][2], B0[2][2], B1[2][2];
    const char* cA = (const char*)g.A + (size_t)cur.pm * tstep; const char* cB = (const char*)g.Bt + (size_t)cur.pn * tstep;
    S.a_ready(cur);
    if constexpr (SP2) {
        PG8_STAGE(PG8_SB(0, 0), cB, voffB); PG8_STAGE(PG8_SB(0, 1), cB + hstep, voffB); PG8_STAGE(PG8_SA(0, 0), cA, voffA); PG8_STAGE(PG8_SA(0, 1), cA + hstep, voffA);
        if (wr == 1) PG8_BAR;
        PG8_WAIT_V(2); PG8_BAR;
        PG8_STAGE(PG8_SB(1, 0), cB + kstep, voffB); PG8_STAGE(PG8_SA(1, 0), cA + kstep, voffA); PG8_STAGE(PG8_SB(1, 1), cB + hstep + kstep, voffB);
        PG8_WAIT_V(6); PG8_BAR;
    } else {
        PG8_STAGE(PG8_SB(0, 0), cB, voffB); PG8_STAGE(PG8_SA(0, 0), cA, voffA); PG8_STAGE(PG8_SB(0, 1), cB + hstep, voffB); PG8_STAGE(PG8_SA(0, 1), cA + hstep, voffA);
        if (wr == 1) PG8_BAR;
        PG8_WAIT_V(4); PG8_BAR;
        PG8_STAGE(PG8_SB(1, 0), cB + kstep, voffB); PG8_STAGE(PG8_SA(1, 0), cA + kstep, voffA); PG8_STAGE(PG8_SB(1, 1), cB + hstep + kstep, voffB);
        PG8_WAIT_V(6); PG8_BAR;
    }
    for (;;) {
        const bool has_next = S.next(ui + 1, nxt);
        const char* nA = has_next ? (const char*)g.A + (size_t)nxt.pm * tstep : cA; const char* nB = has_next ? (const char*)g.Bt + (size_t)nxt.pn * tstep : cB;
        for (int t = 0; t < nt; t += 2) {
            const bool last = (t == nt - 2);
            const char* a1 = cA + (size_t)(t + 1) * kstep;
            const char* a2 = last ? nA : cA + (size_t)(t + 2) * kstep; const char* b2 = last ? nB : cB + (size_t)(t + 2) * kstep;
            const char* a3 = a2 + kstep; const char* b3 = b2 + kstep;
            if (last && has_next) S.a_ready(nxt);
            if constexpr (SP2) {
            PG8_LDB(B0, 0, 0); PG8_LDB(B1, 0, 1); PG8_SCHED; PG8_LDA(At, 0, 0); PG8_STAGE(PG8_SA(1, 1), a1 + hstep, voffA);
            PG8_WAIT_V(8); PG8_WAIT_L(0); PG8_BAR; PG8_MMA(0, 0, At, B0); PG8_MMA(0, 1, At, B1); PG8_BAR; PG8_SCHED;
            PG8_LDA(At, 0, 1); PG8_STAGE(PG8_SB(0, 0), b2, voffB); PG8_STAGE(PG8_SB(0, 1), b2 + hstep, voffB); PG8_STAGE(PG8_SA(0, 0), a2, voffA);
            PG8_WAIT_V(8); PG8_WAIT_L(0); PG8_BAR; PG8_MMA(1, 0, At, B0); PG8_MMA(1, 1, At, B1); PG8_BAR; PG8_SCHED;
            PG8_LDB(B0, 1, 0); PG8_LDB(B1, 1, 1); PG8_SCHED; PG8_LDA(At, 1, 0); PG8_STAGE(PG8_SA(0, 1), a2 + hstep, voffA);
            PG8_WAIT_V(8); PG8_WAIT_L(0); PG8_BAR; PG8_MMA(0, 0, At, B0); PG8_MMA(0, 1, At, B1); PG8_BAR; PG8_SCHED;
            PG8_LDA(At, 1, 1); PG8_STAGE(PG8_SB(1, 0), b3, voffB); PG8_STAGE(PG8_SB(1, 1), b3 + hstep, voffB); PG8_STAGE(PG8_SA(1, 0), a3, voffA);
            PG8_WAIT_V(8); PG8_WAIT_L(0); PG8_BAR; PG8_MMA(1, 0, At, B0); PG8_MMA(1, 1, At, B1); PG8_BAR; PG8_SCHED;
            } else {
            PG8_LDB(B0, 0, 0); PG8_SCHED; PG8_LDA(At, 0, 0); PG8_STAGE(PG8_SA(1, 1), a1 + hstep, voffA);
            PG8_WAIT_L(8); PG8_BAR; PG8_WAIT_L(0); PG8_MMA(0, 0, At, B0); PG8_BAR; PG8_SCHED;
            PG8_LDB(B1, 0, 1); PG8_STAGE(PG8_SB(0, 0), b2, voffB);
            PG8_BAR; PG8_WAIT_L(0); PG8_MMA(0, 1, At, B1); PG8_BAR;
            PG8_LDA(At, 0, 1); PG8_STAGE(PG8_SA(0, 0), a2, voffA);
            PG8_BAR; PG8_WAIT_L(0); PG8_MMA(1, 0, At, B0); PG8_BAR; PG8_SCHED;
            PG8_STAGE(PG8_SB(0, 1), b2 + hstep, voffB);
            PG8_WAIT_V(6); PG8_BAR; PG8_MMA(1, 1, At, B1); PG8_BAR;
            PG8_LDB(B0, 1, 0); PG8_SCHED; PG8_LDA(At, 1, 0); PG8_STAGE(PG8_SA(0, 1), a2 + hstep, voffA);
            PG8_WAIT_L(8); PG8_BAR; PG8_WAIT_L(0); PG8_MMA(0, 0, At, B0); PG8_BAR; PG8_SCHED;
            PG8_LDB(B1, 1, 1); PG8_STAGE(PG8_SB(1, 0), b3, voffB);
            PG8_BAR; PG8_WAIT_L(0); PG8_MMA(0, 1, At, B1); PG8_BAR;
            PG8_LDA(At, 1, 1); PG8_STAGE(PG8_SA(1, 0), a3, voffA);
            PG8_BAR; PG8_WAIT_L(0); PG8_MMA(1, 0, At, B0); PG8_BAR; PG8_SCHED;
            PG8_STAGE(PG8_SB(1, 1), b3 + hstep, voffB);
            PG8_WAIT_V(6); PG8_BAR; PG8_MMA(1, 1, At, B1); PG8_BAR;
            }
        }
        if constexpr (ALIGN_EPI) { if (wr == 0) PG8_BAR; }
        E(acc, cur, wr, wc, fr, fq); S.done(cur);
        if (!has_next) break;
#pragma unroll
        for (int a = 0; a < 2; ++a)
#pragma unroll
            for (int b = 0; b < 2; ++b)
#pragma unroll
                for (int m = 0; m < 4; ++m)
#pragma unroll
                    for (int n = 0; n < 2; ++n) acc[a][b][m][n] = (f32x4){0.f, 0.f, 0.f, 0.f};
        cur = nxt; cA = nA; cB = nB; ++ui;
        if constexpr (ALIGN_EPI) { if (wr == 1) PG8_BAR; }
    }
    PG8_WAIT_V(0);
    if constexpr (!ALIGN_EPI) { if (wr == 0) PG8_BAR; }
    PG8_BAR;
#undef PG8_SA
#undef PG8_SB
#undef PG8_STAGE
#undef PG8_LDA
#undef PG8_LDB
#undef PG8_MMA
#undef PG8_WAIT_V
#undef PG8_WAIT_L
#undef PG8_BAR
#undef PG8_SCHED
}
}

#ifndef DUPMASK
#define DUPMASK 0
#endif
#ifndef UFMT
#define UFMT 4
#endif
#ifndef VFMT
#define VFMT 4
#endif
constexpr int NB = 2, SEQ = 8192, D = 1024, M = NB * SEQ;
constexpr int NPROJ = 2048, NIN = 2304, INLD = 2064;
constexpr int NUNIT = 1024;
constexpr int NEXP = 16384;
constexpr size_t MiB = 1u << 20;
constexpr size_t WS_CTL = 0, CTL_ZERO_BYTES = 64 * 1024;
constexpr size_t WS_MOD = 1 * MiB;
constexpr size_t WS_DEC = 1 * MiB + 512 * 1024;
constexpr size_t WS_WIN = 2 * MiB;
constexpr size_t WS_WOUT = 7 * MiB;
constexpr size_t WS_WQ = 9 * MiB;
constexpr size_t WS_KK = 13 * MiB;
constexpr size_t WS_IDX = 14 * MiB;
constexpr size_t WS_GATE = 22 * MiB;
constexpr size_t WS_LOGA = 30 * MiB;
constexpr size_t WS_KV = 46 * MiB;
constexpr size_t WS_H = 78 * MiB;
constexpr size_t WS_U8 = 110 * MiB;
constexpr size_t WS_V8 = 126 * MiB;
constexpr size_t WS_SU = 142 * MiB;
constexpr size_t WS_SV = 142 * MiB + 65536;
constexpr size_t WS_PROJ = 174 * MiB;
constexpr size_t WS_END = 238 * MiB;
constexpr int CW_BAR = 1024;
constexpr int NWAVES = 8, NTHR = 512;
constexpr int LDS_BYTES = 147456, MISC_OFF = 147456 - 256;

#define XB_TMO      128
#define XB_XCNT(j)  (256  + 64 * (j))
#define XB_XSUB(j)  (1280 + 64 * (j))
#define XB_XGEN(j)  (2304 + 64 * (j))
#define XB_TOP      3328
#define XB_TOPGEN   3392
#define XCD_BAR_WORDS 3456
#define XB_SPIN_CAP (1u << 20)
__device__ __forceinline__ unsigned xb_ld(unsigned* p)              { return __hip_atomic_load(p, __ATOMIC_RELAXED, __HIP_MEMORY_SCOPE_AGENT); }
__device__ __forceinline__ unsigned xb_add(unsigned* p, unsigned v) { return __hip_atomic_fetch_add(p, v, __ATOMIC_RELAXED, __HIP_MEMORY_SCOPE_AGENT); }
__device__ __forceinline__ unsigned xb_xcc_id() { return (unsigned)__builtin_amdgcn_s_getreg((3 << 11) | 20) & 0xFu; }
#define XB_SPIN(cond, bar) do { unsigned _sp = 0; while (cond) { __builtin_amdgcn_s_sleep(1); \
    if ((++_sp & 255u) == 0u) { if (xb_ld(&(bar)[XB_TMO])) break; if (_sp > XB_SPIN_CAP) { atomicAdd(&(bar)[XB_TMO], 1u); break; } } } } while (0)
struct XcdBarrier { unsigned* bar; unsigned x; volatile LAS unsigned* st; };
__device__ __forceinline__ XcdBarrier xcd_barrier_post(unsigned* bar, volatile LAS unsigned* st) {
    XcdBarrier b; b.bar = bar; b.x = xb_xcc_id(); b.st = st;
    if (threadIdx.x == 0) (void)xb_add(&bar[XB_XCNT(b.x)], 1u);
    return b;
}
__device__ __forceinline__ void xcd_barrier_complete(unsigned* bar, unsigned x, unsigned& nloc, unsigned& nx) {
    const unsigned G = gridDim.x * gridDim.y * gridDim.z;
    unsigned sum, cnt, mine, sp = 0u;
    for (;;) {
        sum = 0u; cnt = 0u; mine = 0u;
#pragma unroll
        for (unsigned j = 0; j < 16; ++j) { const unsigned c = xb_ld(&bar[XB_XCNT(j)]); sum += c; cnt += (c > 0u) ? 1u : 0u; mine = (j == x) ? c : mine; }
        if (sum == G) break;
        __builtin_amdgcn_s_sleep(1);
        if ((++sp & 255u) == 0u) { if (xb_ld(&bar[XB_TMO])) break; if (sp > XB_SPIN_CAP) { atomicAdd(&bar[XB_TMO], 1u); break; } }
    }
    nloc = mine > 0u ? mine : 1u; nx = cnt > 0u ? cnt : 1u;
}
__device__ __forceinline__ void xcd_barrier(const XcdBarrier& b) {
    asm volatile("s_waitcnt vmcnt(0)" ::: "memory");
    __syncthreads();
    if (threadIdx.x == 0) {
        unsigned* bar = b.bar;
        __builtin_amdgcn_s_waitcnt(0);
        unsigned nloc = b.st[0], nx = b.st[1];
        if (nloc == 0u) { xcd_barrier_complete(bar, b.x, nloc, nx); b.st[0] = nloc; b.st[1] = nx; }
        const unsigned old = xb_add(&bar[XB_XSUB(b.x)], 1u);
        const unsigned gen = old / nloc;
        if (old + 1u == (gen + 1u) * nloc) {
            __builtin_amdgcn_fence(__ATOMIC_RELEASE, "agent");
            asm volatile("s_waitcnt vmcnt(0)" ::: "memory");
            const unsigned og = xb_add(&bar[XB_TOP], 1u);
            const unsigned tg = og / nx;
            if (og + 1u == (tg + 1u) * nx) xb_add(&bar[XB_TOPGEN], 1u);
            else XB_SPIN(xb_ld(&bar[XB_TOPGEN]) == tg, bar);
            __builtin_amdgcn_fence(__ATOMIC_ACQUIRE, "agent");
            xb_add(&bar[XB_XGEN(b.x)], 1u);
            asm volatile("s_waitcnt vmcnt(0)" ::: "memory");
        } else {
            XB_SPIN(xb_ld(&bar[XB_XGEN(b.x)]) == gen, bar);
            __builtin_amdgcn_fence(__ATOMIC_ACQUIRE, "agent");
            asm volatile("s_waitcnt vmcnt(0)" ::: "memory");
        }
    }
    __syncthreads();
}

__device__ __forceinline__ unsigned f2bf(float f) { unsigned u = __builtin_bit_cast(unsigned, f); return (u + 0x7fffu + ((u >> 16) & 1u)) >> 16; }
__device__ __forceinline__ unsigned pk2(float lo, float hi) { return f2bf(lo) | (f2bf(hi) << 16); }
__device__ __forceinline__ float bflo(unsigned w) { return __builtin_bit_cast(float, w << 16); }
__device__ __forceinline__ float bfhi(unsigned w) { return __builtin_bit_cast(float, w & 0xffff0000u); }
__device__ __forceinline__ float wave_sum(float v) {
#pragma unroll
    for (int o = 1; o < 64; o <<= 1) v += __shfl_xor(v, o);
    return v;
}
__device__ __forceinline__ float silu_f(float x) { return x / (1.f + __expf(-x)); }
__device__ __forceinline__ float logsig_f(float x) { return fminf(x, 0.f) - log1pf(__expf(-fabsf(x))); }
__device__ __forceinline__ float gelu_f(float x) { return 0.5f * x * (1.f + erff(x * 0.70710678118654752f)); }

template <int FMT> struct RowVec { u32x4 w; };
template <> struct RowVec<4> { u32x2 w; };
template <int FMT> __device__ __forceinline__ RowVec<FMT> row_load(const unsigned char* tab, int eid, int lane) {
    RowVec<FMT> r;
    if constexpr (FMT == 4) r.w = *(const u32x2*)(tab + (size_t)eid * 512 + 8 * lane); else r.w = *(const u32x4*)(tab + (size_t)eid * 1024 + 16 * lane);
    return r;
}
template <int FMT> __device__ __forceinline__ void row_decode(const RowVec<FMT>& r, float (&f)[16]) {
    if constexpr (FMT == 4) {
        const unsigned w[2] = {r.w.x, r.w.y};
#pragma unroll
        for (int k = 0; k < 2; ++k) {
            const f32x2 p0 = __builtin_amdgcn_cvt_scalef32_pk_f32_fp4(w[k], 1.0f, 0), p1 = __builtin_amdgcn_cvt_scalef32_pk_f32_fp4(w[k], 1.0f, 1);
            const f32x2 p2 = __builtin_amdgcn_cvt_scalef32_pk_f32_fp4(w[k], 1.0f, 2), p3 = __builtin_amdgcn_cvt_scalef32_pk_f32_fp4(w[k], 1.0f, 3);
            f[8 * k] = p0.x; f[8 * k + 1] = p0.y; f[8 * k + 2] = p1.x; f[8 * k + 3] = p1.y; f[8 * k + 4] = p2.x; f[8 * k + 5] = p2.y; f[8 * k + 6] = p3.x; f[8 * k + 7] = p3.y; }
    } else {
        const unsigned w[4] = {r.w.x, r.w.y, r.w.z, r.w.w};
#pragma unroll
        for (int k = 0; k < 4; ++k) { const f32x2 lo = __builtin_amdgcn_cvt_pk_f32_fp8((int)w[k], false), hi = __builtin_amdgcn_cvt_pk_f32_fp8((int)w[k], true);
            f[4 * k] = lo.x; f[4 * k + 1] = lo.y; f[4 * k + 2] = hi.x; f[4 * k + 3] = hi.y; }
    }
}

struct Params { const float* in[19]; float* out; unsigned char* ws; int ph_lo, ph_hi; };

struct EpiProj {
    static constexpr bool PERM = true;
    bf16_t* P; float* LA; const float* gb;
    __device__ __forceinline__ void operator()(const f32x4 (&acc)[2][2][4][2], const pg8::Unit& u, int wr, int wc, int fr, int fq) const {
        const int row0 = u.pm * 256 + wr * 64 + fr;
        if (u.pn < 8) {
            const int col0 = u.pn * 256 + wc * 32 + 8 * fq;
#pragma unroll
            for (int ai = 0; ai < 2; ++ai)
#pragma unroll
                for (int m = 0; m < 4; ++m) { bf16_t* rowp = P + (size_t)(row0 + ai * 128 + m * 16) * NPROJ + col0;
#pragma unroll
                    for (int bj = 0; bj < 2; ++bj) { const f32x4 v0 = acc[ai][bj][m][0], v1 = acc[ai][bj][m][1];
                        u32x4 w; w.x = pg8::cvt_pk_bf16(v0[0], v0[1]); w.y = pg8::cvt_pk_bf16(v0[2], v0[3]); w.z = pg8::cvt_pk_bf16(v1[0], v1[1]); w.w = pg8::cvt_pk_bf16(v1[2], v1[3]);
                        *(u32x4*)(rowp + bj * 128) = w; } }
        } else {
            const int col0 = wc * 32 + 8 * fq;
            f32x4 bv[2][2];
#pragma unroll
            for (int bj = 0; bj < 2; ++bj)
#pragma unroll
                for (int n = 0; n < 2; ++n) bv[bj][n] = *(const f32x4*)(gb + col0 + bj * 128 + 4 * n);
#pragma unroll
            for (int ai = 0; ai < 2; ++ai)
#pragma unroll
                for (int m = 0; m < 4; ++m) { float* rowp = LA + (size_t)(row0 + ai * 128 + m * 16) * 256 + col0;
#pragma unroll
                    for (int bj = 0; bj < 2; ++bj)
#pragma unroll
                        for (int n = 0; n < 2; ++n) { const f32x4 v = acc[ai][bj][m][n] + bv[bj][n]; f32x4 o;
#pragma unroll
                            for (int j = 0; j < 4; ++j) o[j] = logsig_f(v[j]) * (1.0f / 16.0f);
                            *(f32x4*)(rowp + bj * 128 + 4 * n) = o; } }
        }
    }
};
struct EpiX1 {
    static constexpr bool PERM = false;
    const float* x; float* X1; const float* gate;
    __device__ __forceinline__ void operator()(const f32x4 (&acc)[2][2][4][2], const pg8::Unit& u, int wr, int wc, int fr, int fq) const {
        const int row0 = u.pm * 256 + wr * 64 + fr, col0 = u.pn * 256 + wc * 32 + 4 * fq;
        const float* gp = gate + (u.pm >= 32 ? 6144 : 0);
        f32x4 gv[2][2];
#pragma unroll
        for (int bj = 0; bj < 2; ++bj)
#pragma unroll
            for (int n = 0; n < 2; ++n) gv[bj][n] = *(const f32x4*)(gp + col0 + bj * 128 + n * 16);
#pragma unroll
        for (int ai = 0; ai < 2; ++ai)
#pragma unroll
            for (int m = 0; m < 4; ++m) { const size_t ro = (size_t)(row0 + ai * 128 + m * 16) * D + col0;
#pragma unroll
                for (int bj = 0; bj < 2; ++bj)
#pragma unroll
                    for (int n = 0; n < 2; ++n) { const f32x4 xv = *(const f32x4*)(x + ro + bj * 128 + n * 16);
                        *(f32x4*)(X1 + ro + bj * 128 + n * 16) = xv + gv[bj][n] * acc[ai][bj][m][n]; } }
    }
};
struct EpiQ {
    static constexpr bool PERM = true;
    bf16_t* Q;
    __device__ __forceinline__ void operator()(const f32x4 (&acc)[2][2][4][2], const pg8::Unit& u, int wr, int wc, int fr, int fq) const {
        const int row0 = u.pm * 256 + wr * 64 + fr, col0 = u.pn * 256 + wc * 32 + 8 * fq;
#pragma unroll
        for (int ai = 0; ai < 2; ++ai)
#pragma unroll
            for (int m = 0; m < 4; ++m) { bf16_t* rowp = Q + (size_t)(row0 + ai * 128 + m * 16) * 2048 + col0;
#pragma unroll
                for (int bj = 0; bj < 2; ++bj) { const f32x4 v0 = acc[ai][bj][m][0], v1 = acc[ai][bj][m][1];
                    u32x4 w; w.x = pg8::cvt_pk_bf16(v0[0], v0[1]); w.y = pg8::cvt_pk_bf16(v0[2], v0[3]); w.z = pg8::cvt_pk_bf16(v1[0], v1[1]); w.w = pg8::cvt_pk_bf16(v1[2], v1[3]);
                    *(u32x4*)(rowp + bj * 128) = w; } }
    }
};

__device__ __forceinline__ void transpose_item(const float* W, int ldw, int k0, int n0, bf16_t* WT, int ldt, int row0, LAS float* scr, int lane) {
#pragma unroll 8
    for (int i = 0; i < 32; ++i) { const int kk = 2 * i + (lane >> 5); scr[kk * 33 + (lane & 31)] = W[(size_t)(k0 + kk) * ldw + n0 + (lane & 31)]; }
    asm volatile("s_waitcnt lgkmcnt(0)" ::: "memory");
    const int c = lane & 7;
#pragma unroll
    for (int j = 0; j < 4; ++j) { const int n = (lane >> 3) + 8 * j; const LAS float* s = scr + (8 * c) * 33 + n;
        u32x4 o; o.x = pk2(s[0 * 33], s[1 * 33]); o.y = pk2(s[2 * 33], s[3 * 33]); o.z = pk2(s[4 * 33], s[5 * 33]); o.w = pk2(s[6 * 33], s[7 * 33]);
        *(u32x4*)(WT + (size_t)(row0 + n0 + n) * ldt + k0 + 8 * c) = o; }
    asm volatile("s_waitcnt lgkmcnt(0)" ::: "memory");
}

__device__ __forceinline__ void norm_mod_row(const float* xrow, const float* g, const float* shift, const float* scale, bf16_t* orow, int lane) {
    f32x4 v[4]; float s = 0.f;
#pragma unroll
    for (int j = 0; j < 4; ++j) { v[j] = *(const f32x4*)(xrow + 4 * lane + 256 * j); s += (v[j].x * v[j].x + v[j].y * v[j].y) + (v[j].z * v[j].z + v[j].w * v[j].w); }
    const float rstd = 1.f / sqrtf(wave_sum(s) * (1.f / D) + 1e-6f);
#pragma unroll
    for (int j = 0; j < 4; ++j) { const int c = 4 * lane + 256 * j;
        const f32x4 gg = *(const f32x4*)(g + c), sh = *(const f32x4*)(shift + c), sc = *(const f32x4*)(scale + c);
        const f32x4 y = v[j] * rstd * gg * (sc + 1.0f) + sh;
        u32x2 o; o.x = pk2(y.x, y.y); o.y = pk2(y.z, y.w);
        *(u32x2*)(orow + c) = o; }
}

__constant__ unsigned char CAND_IJ[64] = {
    0x00,0x01,0x02,0x03,0x04,0x05,0x06,0x07,0x08,0x09,0x0a,0x0b,0x0c,0x0d,0x0e,0x0f,
    0x10,0x11,0x12,0x13,0x14,0x15,0x16,0x17,
    0x20,0x21,0x22,0x23,0x24,
    0x30,0x31,0x32,0x33,
    0x40,0x41,0x42,
    0x50,0x51, 0x60,0x61, 0x70,0x71,
    0x80,0x90,0xa0,0xb0,0xc0,0xd0,0xe0,0xf0,
    0,0,0,0,0,0,0,0,0,0,0,0,0,0};

__device__ __forceinline__ unsigned fkey(float f, unsigned idbits, unsigned idmask) {
    unsigned u = __builtin_bit_cast(unsigned, f); u = (u & 0x80000000u) ? ~u : (u | 0x80000000u);
    return (u & ~idmask) | idbits;
}
__device__ __forceinline__ float fkey_val(unsigned key, unsigned idmask) {
    unsigned u = key & ~idmask; u = (u & 0x80000000u) ? (u ^ 0x80000000u) : ~u;
    return __builtin_bit_cast(float, u);
}
template <int CTRL, int ROWMASK> __device__ __forceinline__ unsigned dpp_u(unsigned v) { return (unsigned)__builtin_amdgcn_update_dpp(0, (int)v, CTRL, ROWMASK, 0xF, true); }
template <int CTRL, int ROWMASK> __device__ __forceinline__ float dpp_f(float v) { return __builtin_bit_cast(float, __builtin_amdgcn_update_dpp(0, __builtin_bit_cast(int, v), CTRL, ROWMASK, 0xF, true)); }
__device__ __forceinline__ unsigned umax_(unsigned a, unsigned b) { return a > b ? a : b; }
__device__ __forceinline__ unsigned umin_(unsigned a, unsigned b) { return a < b ? a : b; }
template <int N> __device__ __forceinline__ unsigned ror_u(unsigned v) { return (unsigned)__builtin_amdgcn_update_dpp((int)v, (int)v, 0x120 + N, 0xF, 0xF, false); }
template <int N> __device__ __forceinline__ float ror_f(float v) { return __builtin_bit_cast(float, __builtin_amdgcn_update_dpp(__builtin_bit_cast(int, v), __builtin_bit_cast(int, v), 0x120 + N, 0xF, 0xF, false)); }
__device__ __forceinline__ unsigned row_allmax(unsigned m) { m = umax_(m, ror_u<1>(m)); m = umax_(m, ror_u<2>(m)); m = umax_(m, ror_u<4>(m)); m = umax_(m, ror_u<8>(m)); return m; }
__device__ __forceinline__ float row_allsum(float m) { m += ror_f<1>(m); m += ror_f<2>(m); m += ror_f<4>(m); m += ror_f<8>(m); return m; }

__global__ void __launch_bounds__(NTHR, 2) fwd_kernel(Params p) {
    extern __shared__ __attribute__((aligned(16))) unsigned char lds_raw[];
    LAS unsigned char* lds = (LAS unsigned char*)lds_raw;
    const int tid = threadIdx.x, lane = tid & 63, wave = __builtin_amdgcn_readfirstlane(tid >> 6);
    const int G = gridDim.x, bx = blockIdx.x;
    const int gw = bx * NWAVES + wave, NGW = G * NWAVES;
    unsigned char* ws = p.ws;
    unsigned* ctl = (unsigned*)(ws + WS_CTL);
    float* MOD = (float*)(ws + WS_MOD);
    float* DEC = (float*)(ws + WS_DEC);
    bf16_t* WIN = (bf16_t*)(ws + WS_WIN);
    bf16_t* WOUT = (bf16_t*)(ws + WS_WOUT);
    bf16_t* WQ = (bf16_t*)(ws + WS_WQ);
    bf16_t* KK = (bf16_t*)(ws + WS_KK);
    int* IDX = (int*)(ws + WS_IDX);
    float* GATE = (float*)(ws + WS_GATE);
    float* LOGA = (float*)(ws + WS_LOGA);
    float* KV = (float*)(ws + WS_KV);
    bf16_t* H = (bf16_t*)(ws + WS_H);
    unsigned char* U8 = ws + WS_U8;
    unsigned char* V8 = ws + WS_V8;
    float* SU = (float*)(ws + WS_SU);
    float* SV = (float*)(ws + WS_SV);
    bf16_t* PROJ = (bf16_t*)(ws + WS_PROJ);
    const float* x = p.in[0]; const float* cvec = p.in[1]; const float* ada_w = p.in[2]; const float* ada_b = p.in[3]; const float* norm1_g = p.in[4];
    const float* w_in = p.in[5]; const float* gate_w = p.in[6]; const float* gate_b = p.in[7]; const float* gla_norm_g = p.in[8];
    const float* pool_w = p.in[9]; const float* pool_scale = p.in[10]; const float* w_out = p.in[11]; const float* norm2_g = p.in[12];
    const float* peer_wq = p.in[13]; const float* peer_k1 = p.in[14]; const float* peer_k2 = p.in[15]; const float* peer_u = p.in[16]; const float* peer_v = p.in[17];
    const float* final_g = p.in[18];
    float* X1 = p.out;

    volatile LAS unsigned* MISC = (volatile LAS unsigned*)(lds + MISC_OFF);
    if (tid < 64) MISC[tid] = 0u;
    __syncthreads();
    XcdBarrier bar = xcd_barrier_post(ctl + CW_BAR, MISC + 8);
    const int lo = p.ph_lo, hi = p.ph_hi;
#define IN(k) (lo <= (k) && (k) < hi)
#define REP(k) for (int rep_ = 0; rep_ < 1 + ((DUPMASK >> (k)) & 1); ++rep_)
#define SEAM(k) do { if (IN(k) && IN((k) + 1)) xcd_barrier(bar); } while (0)

    if (IN(0)) REP(0) {
        {
            LAS float* sc = (LAS float*)lds;
            LAS f32x4* red = (LAS f32x4*)(lds + 8192);
            for (int i = tid; i < 2048; i += NTHR) sc[i] = silu_f(cvec[i]);
            __syncthreads();
            for (int cb = bx; cb < 256; cb += G) {
                if (tid < 384) {
                    const int f4 = tid % 6, rg = tid / 6;
                    f32x4 a0 = {0.f, 0.f, 0.f, 0.f}, a1 = {0.f, 0.f, 0.f, 0.f};
#pragma unroll 4
                    for (int i = 0; i < 16; ++i) { const int r = rg + 64 * i; const f32x4 w = *(const f32x4*)(ada_w + (size_t)r * 6144 + 24 * cb + 4 * f4);
                        a0 += w * sc[r]; a1 += w * sc[1024 + r]; }
                    red[(rg * 6 + f4) * 2 + 0] = a0; red[(rg * 6 + f4) * 2 + 1] = a1;
                }
                __syncthreads();
                if (tid < 48) { const int b = tid / 24, col = tid % 24; float s = 0.f;
                    for (int rg = 0; rg < 64; ++rg) s += red[(rg * 6 + (col >> 2)) * 2 + b][col & 3];
                    MOD[b * 6144 + 24 * cb + col] = s + ada_b[24 * cb + col]; }
                __syncthreads();
            }
        }
        for (int it = bx; it < 128; it += G) {
            const int g = it >> 5, nb = (it >> 1) & 15, cb = it & 1;
            LAS float* PW = (LAS float*)lds;
            LAS float* WO = (LAS float*)(lds + 32768);
            for (int i = tid; i < 64 * 128; i += NTHR) { const int c = i >> 7, j = i & 127; PW[i] = pool_w[(size_t)(g * 128 + cb * 64 + c) * 128 + j] * pool_scale[g * 128 + j]; }
            for (int i = tid; i < 128 * 64; i += NTHR) { const int j = i >> 6, n = i & 63; WO[i] = w_out[(size_t)(512 + g * 128 + j) * 1024 + nb * 64 + n]; }
            __syncthreads();
            const int n = tid & 63, cg = tid >> 6;
            float a[8];
#pragma unroll
            for (int q = 0; q < 8; ++q) a[q] = 0.f;
            for (int j = 0; j < 128; ++j) { const float wo = WO[j * 64 + n];
#pragma unroll
                for (int q = 0; q < 8; ++q) a[q] += PW[(cg * 8 + q) * 128 + j] * wo; }
            u32x4 o; o.x = pk2(a[0], a[1]); o.y = pk2(a[2], a[3]); o.z = pk2(a[4], a[5]); o.w = pk2(a[6], a[7]);
            *(u32x4*)(WOUT + (size_t)(nb * 64 + n) * 1024 + 512 + g * 128 + cb * 64 + cg * 8) = o;
            __syncthreads();
        }
        {
            LAS float* scr = (LAS float*)(lds + wave * 16384);
            constexpr int I_IN = 16 * 64, I_Q = 16 * 64, I_O = 8 * 32;
            for (int it = gw; it < I_IN + I_Q + I_O; it += NGW) {
                int r = it;
                if (r < I_IN) { transpose_item(w_in, INLD, (r >> 6) * 64, (r & 63) * 32, WIN, 1024, 0, scr, lane); continue; } r -= I_IN;
                if (r < I_Q) { transpose_item(peer_wq, 2048, (r >> 6) * 64, (r & 63) * 32, WQ, 1024, 0, scr, lane); continue; } r -= I_Q;
                transpose_item(w_out, 1024, (r >> 5) * 64, (r & 31) * 32, WOUT, 1024, 0, scr, lane);
            }
        }
        for (int o = bx * NTHR + tid; o < 256 * 1024; o += G * NTHR) { const int j = o >> 10, k = o & 1023; float s = 0.f;
#pragma unroll
            for (int r = 0; r < 16; ++r) s += w_in[(size_t)k * INLD + 2048 + r] * gate_w[r * 256 + j];
            WIN[(size_t)(2048 + j) * 1024 + k] = (bf16_t)f2bf(s); }
        for (int r = gw; r < 2 * NEXP; r += NGW) {
            const bool isv = r >= NEXP; const int row = isv ? r - NEXP : r;
            const float* src = (isv ? peer_v : peer_u) + (size_t)row * 1024 + 16 * lane;
            f32x4 v[4]; float am = 0.f;
#pragma unroll
            for (int q = 0; q < 4; ++q) { v[q] = *(const f32x4*)(src + 4 * q); am = fmaxf(am, fmaxf(fmaxf(fabsf(v[q].x), fabsf(v[q].y)), fmaxf(fabsf(v[q].z), fabsf(v[q].w)))); }
#pragma unroll
            for (int off = 1; off < 64; off <<= 1) am = fmaxf(am, __shfl_xor(am, off));
            const bool f4 = isv ? (VFMT == 4) : (UFMT == 4);
            const float top = f4 ? 6.0f : 384.0f;
            const float sc = am > 0.f ? am / top : 1.0f, inv = 1.0f / sc;
            if (f4) {
                unsigned w0 = 0u, w1 = 0u;
                w0 = __builtin_amdgcn_cvt_scalef32_pk_fp4_f32(w0, v[0].x * inv, v[0].y * inv, 1.0f, 0); w0 = __builtin_amdgcn_cvt_scalef32_pk_fp4_f32(w0, v[0].z * inv, v[0].w * inv, 1.0f, 1);
                w0 = __builtin_amdgcn_cvt_scalef32_pk_fp4_f32(w0, v[1].x * inv, v[1].y * inv, 1.0f, 2); w0 = __builtin_amdgcn_cvt_scalef32_pk_fp4_f32(w0, v[1].z * inv, v[1].w * inv, 1.0f, 3);
                w1 = __builtin_amdgcn_cvt_scalef32_pk_fp4_f32(w1, v[2].x * inv, v[2].y * inv, 1.0f, 0); w1 = __builtin_amdgcn_cvt_scalef32_pk_fp4_f32(w1, v[2].z * inv, v[2].w * inv, 1.0f, 1);
                w1 = __builtin_amdgcn_cvt_scalef32_pk_fp4_f32(w1, v[3].x * inv, v[3].y * inv, 1.0f, 2); w1 = __builtin_amdgcn_cvt_scalef32_pk_fp4_f32(w1, v[3].z * inv, v[3].w * inv, 1.0f, 3);
                u32x2 o; o.x = w0; o.y = w1;
                *(u32x2*)((isv ? V8 : U8) + (size_t)row * 512 + 8 * lane) = o;
            } else {
                u32x4 o; unsigned* op = (unsigned*)&o;
#pragma unroll
                for (int q = 0; q < 4; ++q) { int w = 0; w = __builtin_amdgcn_cvt_pk_fp8_f32(v[q].x * inv, v[q].y * inv, w, false); w = __builtin_amdgcn_cvt_pk_fp8_f32(v[q].z * inv, v[q].w * inv, w, true); op[q] = (unsigned)w; }
                *(u32x4*)((isv ? V8 : U8) + (size_t)row * 1024 + 16 * lane) = o;
            }
            if (lane == 0) (isv ? SV : SU)[row] = sc;
        }
        for (int i = bx * NTHR + tid; i < 2 * 128 * 128; i += G * NTHR) KK[i] = (bf16_t)f2bf(i < 16384 ? peer_k1[i] : peer_k2[i - 16384]);
    }
    SEAM(0);

    if (IN(1)) REP(1) {
        for (int m = gw; m < M; m += NGW) { const float* md = MOD + (m >= SEQ ? 6144 : 0); norm_mod_row(x + (size_t)m * D, norm1_g, md, md + 1024, H + (size_t)m * D, lane); }
    }
    SEAM(1);

    if (IN(2)) REP(2) {
        pg8::Gemm g{H, WIN, M, NIN, D}; pg8::StaticOrder S; S.init(M, NIN, G, bx);
        EpiProj E{PROJ, LOGA, gate_b};
        pg8::gemm_phase<EpiProj, pg8::StaticOrder, true, true>(lds, g, S, E);
    }
    SEAM(2);

    if (IN(3)) REP(3) {
        const int hb = tid >> 8, ht = tid & 255;
        LAS float* LAT = (LAS float*)(lds + hb * 69632);
        LAS float* KST = (LAS float*)(lds + hb * 69632 + 16640);
        LAS float* VV = (LAS float*)(lds + hb * 69632 + 16640 + 17408);
        for (int it = 0; it < (NUNIT + 2 * G - 1) / (2 * G); ++it) {
            const int u = (it * G + bx) * 2 + hb;
            const bool act = u < NUNIT;
            const int h = u & 3, t0 = (u >> 2) * 64;
            const int c = ht & 63, dc = ht >> 6;
            if (act) {
                const float* la = LOGA + (size_t)(t0 + c) * 256 + h * 64 + dc * 16;
#pragma unroll
                for (int q = 0; q < 4; ++q) { const f32x4 v = *(const f32x4*)(la + 4 * q);
#pragma unroll
                    for (int j = 0; j < 4; ++j) LAT[(dc * 16 + q * 4 + j) * 65 + c] = v[j]; }
            }
            __syncthreads();
            if (act && ht < 64) { float b = 0.f; for (int i = 0; i < 64; ++i) { b += LAT[ht * 65 + i]; LAT[ht * 65 + i] = b; } DEC[u * 64 + ht] = __expf(b); }
            __syncthreads();
            if (act) {
                const bf16_t* kp = PROJ + (size_t)(t0 + c) * NPROJ + 256 + h * 64 + dc * 16;
                const u32x4 k0 = *(const u32x4*)kp, k1 = *(const u32x4*)(kp + 8);
                const unsigned kw[8] = {k0.x, k0.y, k0.z, k0.w, k1.x, k1.y, k1.z, k1.w};
#pragma unroll
                for (int q = 0; q < 8; ++q) { const int d = dc * 16 + 2 * q;
                    KST[c * 68 + d] = bflo(kw[q]) * __expf(LAT[d * 65 + 63] - LAT[d * 65 + c]);
                    KST[c * 68 + d + 1] = bfhi(kw[q]) * __expf(LAT[(d + 1) * 65 + 63] - LAT[(d + 1) * 65 + c]); }
                const bf16_t* vp = PROJ + (size_t)(t0 + c) * NPROJ + 512 + h * 128 + dc * 32;
#pragma unroll
                for (int q = 0; q < 4; ++q) { const u32x4 w = *(const u32x4*)(vp + 8 * q);
                    f32x4 a = {bflo(w.x), bfhi(w.x), bflo(w.y), bfhi(w.y)}, b = {bflo(w.z), bfhi(w.z), bflo(w.w), bfhi(w.w)};
                    *(LAS f32x4*)(VV + c * 132 + dc * 32 + 8 * q) = a; *(LAS f32x4*)(VV + c * 132 + dc * 32 + 8 * q + 4) = b; }
            }
            __syncthreads();
            if (act) {
                const int tv = ht & 31, td = ht >> 5;
                f32x4 a[8];
#pragma unroll
                for (int q = 0; q < 8; ++q) a[q] = (f32x4){0.f, 0.f, 0.f, 0.f};
                for (int cc = 0; cc < 64; ++cc) {
                    const f32x4 vv = *(const LAS f32x4*)(VV + cc * 132 + 4 * tv);
                    const f32x4 ka = *(const LAS f32x4*)(KST + cc * 68 + 8 * td), kb = *(const LAS f32x4*)(KST + cc * 68 + 8 * td + 4);
                    a[0] += vv * ka.x; a[1] += vv * ka.y; a[2] += vv * ka.z; a[3] += vv * ka.w;
                    a[4] += vv * kb.x; a[5] += vv * kb.y; a[6] += vv * kb.z; a[7] += vv * kb.w;
                }
                float* kvp = KV + (size_t)u * 8192 + (8 * td) * 128 + 4 * tv;
#pragma unroll
                for (int q = 0; q < 8; ++q) *(f32x4*)(kvp + q * 128) = a[q];
            }
            __syncthreads();
        }
        for (int it = bx * NTHR + tid; it < (M / 8) * 64; it += G * NTHR) {
            const int cv = it & 63, run = it >> 6, ch = cv * 8, gq = ch >> 7, w = 2 << gq;
            const int t0 = run * 8, pos0 = t0 & (SEQ - 1);
            const bf16_t* pp = PROJ + 1536 + ch;
            float s[8];
#pragma unroll
            for (int j = 0; j < 8; ++j) s[j] = 0.f;
            for (int q = 1; q <= w; ++q) if (pos0 - q >= 0) { const u32x4 v = *(const u32x4*)(pp + (size_t)(t0 - q) * NPROJ);
                s[0] += bflo(v.x); s[1] += bfhi(v.x); s[2] += bflo(v.y); s[3] += bfhi(v.y); s[4] += bflo(v.z); s[5] += bfhi(v.z); s[6] += bflo(v.w); s[7] += bfhi(v.w); }
            for (int r = 0; r < 8; ++r) {
                const int t = t0 + r, pos = pos0 + r;
                const u32x4 v = *(const u32x4*)(pp + (size_t)t * NPROJ);
                const float cur[8] = {bflo(v.x), bfhi(v.x), bflo(v.y), bfhi(v.y), bflo(v.z), bfhi(v.z), bflo(v.w), bfhi(v.w)};
#pragma unroll
                for (int j = 0; j < 8; ++j) s[j] += cur[j];
                if (pos >= w) { const u32x4 o = *(const u32x4*)(pp + (size_t)(t - w) * NPROJ);
                    s[0] -= bflo(o.x); s[1] -= bfhi(o.x); s[2] -= bflo(o.y); s[3] -= bfhi(o.y); s[4] -= bflo(o.z); s[5] -= bfhi(o.z); s[6] -= bflo(o.w); s[7] -= bfhi(o.w); }
                const float inv = 1.f / (float)((pos + 1) < w ? (pos + 1) : w);
                u32x4 ov; ov.x = pk2(s[0] * inv - cur[0], s[1] * inv - cur[1]); ov.y = pk2(s[2] * inv - cur[2], s[3] * inv - cur[3]);
                ov.z = pk2(s[4] * inv - cur[4], s[5] * inv - cur[5]); ov.w = pk2(s[6] * inv - cur[6], s[7] * inv - cur[7]);
                *(u32x4*)(H + (size_t)t * D + 512 + ch) = ov;
            }
        }
    }
    SEAM(3);

    if (IN(4)) REP(4) {
        for (int sq = bx * NTHR + tid; sq < 8 * 8192; sq += G * NTHR) {
            const int bh = sq >> 13, e = sq & 8191, b = bh >> 2, h = bh & 3, d = e >> 7;
            float st = 0.f;
            for (int n0 = 0; n0 < 128; n0 += 8) {
                float kv[8], dc[8];
#pragma unroll
                for (int q = 0; q < 8; ++q) { const int u = ((b * 128 + n0 + q) * 4 + h); kv[q] = KV[(size_t)u * 8192 + e]; dc[q] = DEC[u * 64 + d]; }
#pragma unroll
                for (int q = 0; q < 8; ++q) { const int u = ((b * 128 + n0 + q) * 4 + h); KV[(size_t)u * 8192 + e] = st; st = st * dc[q] + kv[q]; }
            }
        }
    }
    SEAM(4);

    if (IN(5)) REP(5) {
        LAS float* LAT = (LAS float*)lds;
        LAS float* QIT = (LAS float*)(lds + 16640);
        LAS float* KIT = (LAS float*)(lds + 16640 + 16384);
        LAS float* VV = (LAS float*)(lds + 16640 + 32768);
        LAS float* ST = (LAS float*)(lds + 16640 + 32768 + 32768);
        for (int u = bx; u < NUNIT; u += G) {
            const int h = u & 3, t0 = (u >> 2) * 64;
            const int i = tid & 63, dc = tid >> 6;
            {
                const float* la = LOGA + (size_t)(t0 + i) * 256 + h * 64 + dc * 8;
                const f32x4 a = *(const f32x4*)la, b = *(const f32x4*)(la + 4);
#pragma unroll
                for (int j = 0; j < 4; ++j) { LAT[(dc * 8 + j) * 65 + i] = a[j]; LAT[(dc * 8 + 4 + j) * 65 + i] = b[j]; }
            }
            __syncthreads();
            if (tid < 64) { float b = 0.f; for (int r = 0; r < 64; ++r) { b += LAT[tid * 65 + r]; LAT[tid * 65 + r] = b; } }
            __syncthreads();
            {
                const bf16_t* qp = PROJ + (size_t)(t0 + i) * NPROJ + h * 64 + dc * 8;
                const u32x4 qv = *(const u32x4*)qp, kv = *(const u32x4*)(qp + 256);
                const unsigned qw[4] = {qv.x, qv.y, qv.z, qv.w}, kw[4] = {kv.x, kv.y, kv.z, kv.w};
#pragma unroll
                for (int q = 0; q < 4; ++q) { const int d = dc * 8 + 2 * q; const float b0 = LAT[d * 65 + i], b1 = LAT[(d + 1) * 65 + i];
                    QIT[d * 64 + i] = bflo(qw[q]) * __expf(b0) * 0.125f; QIT[(d + 1) * 64 + i] = bfhi(qw[q]) * __expf(b1) * 0.125f;
                    KIT[d * 64 + i] = bflo(kw[q]) * __expf(-b0); KIT[(d + 1) * 64 + i] = bfhi(kw[q]) * __expf(-b1); }
                const bf16_t* vp = PROJ + (size_t)(t0 + i) * NPROJ + 512 + h * 128 + dc * 16;
#pragma unroll
                for (int q = 0; q < 2; ++q) { const u32x4 w = *(const u32x4*)(vp + 8 * q);
                    f32x4 a = {bflo(w.x), bfhi(w.x), bflo(w.y), bfhi(w.y)}, b = {bflo(w.z), bfhi(w.z), bflo(w.w), bfhi(w.w)};
                    *(LAS f32x4*)(VV + i * 128 + dc * 16 + 8 * q) = a; *(LAS f32x4*)(VV + i * 128 + dc * 16 + 8 * q + 4) = b; }
                const float* sp = KV + (size_t)u * 8192;
#pragma unroll
                for (int q = 0; q < 4; ++q) *(LAS f32x4*)(ST + (q * NTHR + tid) * 4) = *(const f32x4*)(sp + (q * NTHR + tid) * 4);
            }
            __syncthreads();
            float att[2][4];
            {
                const int tj = tid & 15, ti = tid >> 4;
#pragma unroll
                for (int a = 0; a < 2; ++a)
#pragma unroll
                    for (int b = 0; b < 4; ++b) att[a][b] = 0.f;
                for (int d = 0; d < 64; ++d) { const f32x2 q = *(const LAS f32x2*)(QIT + d * 64 + 2 * ti); const f32x4 k = *(const LAS f32x4*)(KIT + d * 64 + 4 * tj);
#pragma unroll
                    for (int b = 0; b < 4; ++b) { att[0][b] += q.x * k[b]; att[1][b] += q.y * k[b]; } }
#pragma unroll
                for (int a = 0; a < 2; ++a)
#pragma unroll
                    for (int b = 0; b < 4; ++b) if (4 * tj + b > 2 * ti + a) att[a][b] = 0.f;
            }
            __syncthreads();
            {
                const int tj = tid & 15, ti = tid >> 4;
                LAS float* ATTT = KIT;
#pragma unroll
                for (int b = 0; b < 4; ++b) *(LAS f32x2*)(ATTT + (4 * tj + b) * 64 + 2 * ti) = (f32x2){att[0][b], att[1][b]};
            }
            __syncthreads();
            {
                const int tv = tid & 31, ti = tid >> 5;
                LAS float* ATTT = KIT;
                f32x4 o[4];
#pragma unroll
                for (int a = 0; a < 4; ++a) o[a] = (f32x4){0.f, 0.f, 0.f, 0.f};
                for (int j = 0; j < 64; ++j) { const f32x4 vv = *(const LAS f32x4*)(VV + j * 128 + 4 * tv); const f32x4 at = *(const LAS f32x4*)(ATTT + j * 64 + 4 * ti);
                    o[0] += vv * at.x; o[1] += vv * at.y; o[2] += vv * at.z; o[3] += vv * at.w; }
                for (int d = 0; d < 64; ++d) { const f32x4 sv = *(const LAS f32x4*)(ST + d * 128 + 4 * tv); const f32x4 q = *(const LAS f32x4*)(QIT + d * 64 + 4 * ti);
                    o[0] += sv * q.x; o[1] += sv * q.y; o[2] += sv * q.z; o[3] += sv * q.w; }
                const f32x4 gn = *(const f32x4*)(gla_norm_g + 4 * tv);
#pragma unroll
                for (int a = 0; a < 4; ++a) {
                    float ss = o[a].x * o[a].x + o[a].y * o[a].y + o[a].z * o[a].z + o[a].w * o[a].w;
#pragma unroll
                    for (int off = 1; off < 32; off <<= 1) ss += __shfl_xor(ss, off);
                    const float rstd = 1.f / sqrtf(ss * (1.f / 128.f) + 1e-6f);
                    const int t = t0 + 4 * ti + a;
                    const u32x2 gw2 = *(const u32x2*)(PROJ + (size_t)t * NPROJ + 1024 + h * 128 + 4 * tv);
                    const f32x4 gg = {bflo(gw2.x), bfhi(gw2.x), bflo(gw2.y), bfhi(gw2.y)};
                    f32x4 y;
#pragma unroll
                    for (int j = 0; j < 4; ++j) y[j] = o[a][j] * rstd * gn[j] * silu_f(gg[j]);
                    u32x2 ov; ov.x = pk2(y.x, y.y); ov.y = pk2(y.z, y.w);
                    *(u32x2*)(H + (size_t)t * D + h * 128 + 4 * tv) = ov;
                }
            }
            __syncthreads();
        }
    }
    SEAM(5);

    if (IN(6)) REP(6) {
        pg8::Gemm g{H, WOUT, M, D, D}; pg8::StaticOrder S; S.init(M, D, G, bx);
        EpiX1 E{x, X1, MOD + 2048};
        pg8::gemm_phase<EpiX1, pg8::StaticOrder, true, true>(lds, g, S, E);
    }
    SEAM(6);

    if (IN(7)) REP(7) {
        for (int m = gw; m < M; m += NGW) { const float* md = MOD + (m >= SEQ ? 6144 : 0) + 3072; norm_mod_row(X1 + (size_t)m * D, norm2_g, md, md + 1024, H + (size_t)m * D, lane); }
    }
    SEAM(7);

    if (IN(8)) REP(8) {
        pg8::Gemm g{H, WQ, M, 2048, D}; pg8::StaticOrder S; S.init(M, 2048, G, bx);
        EpiQ E{PROJ};
        pg8::gemm_phase<EpiQ, pg8::StaticOrder, true, true>(lds, g, S, E);
    }
    SEAM(8);

    if (IN(9)) REP(9) {
        LAS bf16_t* KL = (LAS bf16_t*)lds;
        LAS unsigned char* CT = lds + 69632;
        for (int i = tid; i < 2 * 128 * 16; i += NTHR) { const int row = i >> 4, ck = i & 15; *(LAS u32x4*)(KL + row * 136 + ck * 8) = *(const u32x4*)(KK + row * 128 + ck * 8); }
        if (tid < 64) CT[tid] = CAND_IJ[tid];
        __syncthreads();
        const int fr = lane & 15, fq = lane >> 4, rb4 = (lane & 48) * 4;
        int cia[4], cja[4];
#pragma unroll
        for (int sl = 0; sl < 4; ++sl) { const unsigned ij = CAND_IJ[fr * 4 + sl]; cia[sl] = rb4 + 4 * (int)(ij >> 4); cja[sl] = rb4 + 4 * (int)(ij & 15); }
        const bf16_t* Q = PROJ;
        for (int wi = gw; wi < (M / 16) * 8; wi += NGW) {
            const int h = wi & 7, t0 = (wi >> 3) * 16;
            unsigned kk[8][8];
#pragma unroll
            for (int half = 0; half < 2; ++half) {
                const bf16_t* qp = Q + (size_t)(t0 + fr) * 2048 + h * 256 + half * 128 + fq * 8;
                bf16x8 af[4];
#pragma unroll
                for (int ks = 0; ks < 4; ++ks) af[ks] = *(const bf16x8*)(qp + ks * 32);
                int kboff = half * 128 * 136 + fr * 136 + fq * 8;
                asm volatile("" : "+v"(kboff));
                const LAS bf16_t* kb = KL + kboff;
#pragma unroll
                for (int nt = 0; nt < 8; ++nt) {
                    f32x4 c = {0.f, 0.f, 0.f, 0.f};
#pragma unroll
                    for (int ks = 0; ks < 4; ++ks) { const bf16x8 bf = *(const LAS bf16x8*)(kb + nt * 16 * 136 + ks * 32); c = __builtin_amdgcn_mfma_f32_16x16x32_bf16(af[ks], bf, c, 0, 0, 0); }
#pragma unroll
                    for (int r = 0; r < 4; ++r) kk[half * 4 + r][nt] = fkey(c[r], 127u - (unsigned)(nt * 16 + fr), 127u);
                }
            }
#define CE(a, b) do { const unsigned hi_ = umax_(kx[a], kx[b]), lo_ = umin_(kx[a], kx[b]); kx[a] = hi_; kx[b] = lo_; } while (0)
#pragma unroll
            for (int x = 0; x < 8; ++x) { unsigned (&kx)[8] = kk[x];
                CE(0, 1); CE(2, 3); CE(4, 5); CE(6, 7); CE(0, 2); CE(1, 3); CE(4, 6); CE(5, 7); CE(1, 2); CE(5, 6);
                CE(0, 4); CE(1, 5); CE(2, 6); CE(3, 7); CE(2, 4); CE(3, 5); CE(1, 2); CE(3, 4); CE(5, 6); }
            unsigned res[8];
#pragma unroll
            for (int x = 0; x < 8; ++x) res[x] = 0u;
#pragma unroll 1
            for (int rd = 0; rd < 16; ++rd)
#pragma unroll
                for (int x = 0; x < 8; ++x) { unsigned (&kx)[8] = kk[x];
                    const unsigned m = row_allmax(kx[0]); const bool own = kx[0] == m;
#pragma unroll
                    for (int j = 0; j < 7; ++j) kx[j] = own ? kx[j + 1] : kx[j];
                    kx[7] = own ? 0u : kx[7];
                    res[x] = (fr == rd) ? m : res[x]; }
            unsigned ck[4][4];
#pragma unroll
            for (int r = 0; r < 4; ++r)
#pragma unroll
                for (int sl = 0; sl < 4; ++sl) { const unsigned va = __builtin_amdgcn_ds_bpermute(cia[sl], res[r]), vb = __builtin_amdgcn_ds_bpermute(cja[sl], res[4 + r]);
                    const float sum = fkey_val(va, 127u) + fkey_val(vb, 127u);
                    ck[r][sl] = (fr * 4 + sl < 50) ? fkey(sum, 63u - (unsigned)(fr * 4 + sl), 63u) : 0u; }
#pragma unroll
            for (int r = 0; r < 4; ++r) { unsigned (&kx)[4] = ck[r]; CE(0, 1); CE(2, 3); CE(0, 2); CE(1, 3); CE(1, 2); }
#undef CE
            unsigned res3[4], mfirst[4];
#pragma unroll
            for (int r = 0; r < 4; ++r) { res3[r] = 0u; mfirst[r] = 0u; }
#pragma unroll 1
            for (int rd = 0; rd < 16; ++rd)
#pragma unroll
                for (int r = 0; r < 4; ++r) { unsigned (&kx)[4] = ck[r];
                    const unsigned m = row_allmax(kx[0]); const bool own = kx[0] == m;
                    kx[0] = own ? kx[1] : kx[0]; kx[1] = own ? kx[2] : kx[1]; kx[2] = own ? kx[3] : kx[2]; kx[3] = own ? 0u : kx[3];
                    res3[r] = (fr == rd) ? m : res3[r]; mfirst[r] = (rd == 0) ? m : mfirst[r]; }
#pragma unroll
            for (int r = 0; r < 4; ++r) {
                const unsigned cidx = 63u - (res3[r] & 63u);
                const unsigned ij = CT[cidx];
                const unsigned wa = __builtin_amdgcn_ds_bpermute(rb4 + 4 * (int)(ij >> 4), res[r]), wb = __builtin_amdgcn_ds_bpermute(rb4 + 4 * (int)(ij & 15), res[4 + r]);
                const int eid = (int)((127u - (wa & 127u)) * 128u + (127u - (wb & 127u)));
                const float ex = __expf(fkey_val(res3[r], 63u) - fkey_val(mfirst[r], 63u));
                const float tot = row_allsum(ex);
                const size_t o = (size_t)(t0 + 4 * fq + r) * 128 + h * 16 + fr;
                IDX[o] = eid; GATE[o] = ex / tot;
            }
        }
    }
    SEAM(9);

    if (IN(10)) REP(10) {
        for (int t = gw; t < M; t += NGW) {
            const bf16_t* hp = H + (size_t)t * D + 16 * lane;
            const u32x4 ha = *(const u32x4*)hp, hb = *(const u32x4*)(hp + 8);
            const float hf[16] = {bflo(ha.x), bfhi(ha.x), bflo(ha.y), bfhi(ha.y), bflo(ha.z), bfhi(ha.z), bflo(ha.w), bfhi(ha.w),
                                  bflo(hb.x), bfhi(hb.x), bflo(hb.y), bfhi(hb.y), bflo(hb.z), bfhi(hb.z), bflo(hb.w), bfhi(hb.w)};
            float o[16];
#pragma unroll
            for (int j = 0; j < 16; ++j) o[j] = 0.f;
#pragma unroll 1
            for (int half = 0; half < 2; ++half) {
                const int idr = IDX[(size_t)t * 128 + half * 64 + lane];
                const float zs = SU[idr];
                const float as = GATE[(size_t)t * 128 + half * 64 + lane] * SV[idr];
#pragma unroll 1
                for (int c = 0; c < 8; ++c) {
                    RowVec<UFMT> uu[8]; RowVec<VFMT> vv[8];
#pragma unroll
                    for (int q = 0; q < 8; ++q) { const int eid = __builtin_amdgcn_readlane(idr, 8 * c + q);
                        uu[q] = row_load<UFMT>(U8, eid, lane); vv[q] = row_load<VFMT>(V8, eid, lane); }
                    float z[8];
#pragma unroll
                    for (int q = 0; q < 8; ++q) { float f[16]; row_decode<UFMT>(uu[q], f); float a0 = 0.f, a1 = 0.f;
#pragma unroll
                        for (int k = 0; k < 8; ++k) { a0 += hf[2 * k] * f[2 * k]; a1 += hf[2 * k + 1] * f[2 * k + 1]; }
                        z[q] = a0 + a1; }
                    float r1[4], r2[2], r3;
#pragma unroll
                    for (int k = 0; k < 4; ++k) { const bool hi1 = lane & 1; const float keep = hi1 ? z[2 * k + 1] : z[2 * k], send = hi1 ? z[2 * k] : z[2 * k + 1]; r1[k] = keep + __shfl_xor(send, 1); }
#pragma unroll
                    for (int k = 0; k < 2; ++k) { const bool hi1 = lane & 2; const float keep = hi1 ? r1[2 * k + 1] : r1[2 * k], send = hi1 ? r1[2 * k] : r1[2 * k + 1]; r2[k] = keep + __shfl_xor(send, 2); }
                    { const bool hi1 = lane & 4; const float keep = hi1 ? r2[1] : r2[0], send = hi1 ? r2[0] : r2[1]; r3 = keep + __shfl_xor(send, 4); }
                    r3 += __shfl_xor(r3, 8); r3 += __shfl_xor(r3, 16); r3 += __shfl_xor(r3, 32);
                    const float act = gelu_f(r3 * zs) * as;
#pragma unroll
                    for (int q = 0; q < 8; ++q) { const float a = __builtin_bit_cast(float, __builtin_amdgcn_readlane(__builtin_bit_cast(int, act), 8 * c + q));
                        float f[16]; row_decode<VFMT>(vv[q], f);
#pragma unroll
                        for (int k = 0; k < 16; ++k) o[k] += a * f[k]; }
                }
            }
            const float* g2p = MOD + (t >= SEQ ? 6144 : 0) + 5120 + 16 * lane;
            float* xr = X1 + (size_t)t * D + 16 * lane;
            f32x4 xv[4]; float ss = 0.f;
#pragma unroll
            for (int q = 0; q < 4; ++q) { const f32x4 xx = *(const f32x4*)(xr + 4 * q), gg = *(const f32x4*)(g2p + 4 * q);
                const f32x4 ov = {o[q * 4 + 0], o[q * 4 + 1], o[q * 4 + 2], o[q * 4 + 3]};
                xv[q] = xx + gg * ov; ss += (xv[q].x * xv[q].x + xv[q].y * xv[q].y) + (xv[q].z * xv[q].z + xv[q].w * xv[q].w); }
            const float rstd = 1.f / sqrtf(wave_sum(ss) * (1.f / D) + 1e-6f);
#pragma unroll
            for (int q = 0; q < 4; ++q) { const f32x4 fg = *(const f32x4*)(final_g + 16 * lane + 4 * q);
                *(f32x4*)(xr + 4 * q) = xv[q] * rstd * fg; }
        }
    }
#undef IN
#undef REP
#undef SEAM
}

extern "C" void kernel_launch(void* const* d_in, const int* in_sizes, int n_in, void* d_out, int out_size, void* d_ws, size_t ws_size, hipStream_t stream) {
    static int grid = 0;
    if (grid == 0) {
        if (n_in != 19 || out_size != M * D || ws_size < WS_END) { fprintf(stderr, "kernel_launch: unexpected shapes (n_in %d out %d ws %zu)\n", n_in, out_size, ws_size); grid = -1; return; }
        int dev = 0, cus = 0, per_cu = 0;
        (void)hipGetDevice(&dev); (void)hipDeviceGetAttribute(&cus, hipDeviceAttributeMultiprocessorCount, dev);
        (void)hipFuncSetAttribute((const void*)fwd_kernel, hipFuncAttributeMaxDynamicSharedMemorySize, LDS_BYTES);
        (void)hipOccupancyMaxActiveBlocksPerMultiprocessor(&per_cu, (const void*)fwd_kernel, NTHR, LDS_BYTES);
        (void)hipGetLastError();
        if (per_cu < 1) { fprintf(stderr, "kernel_launch: occupancy query says %d blocks/CU\n", per_cu); per_cu = 1; }
        grid = cus;
    }
    if (grid < 0) return;
    (void)hipMemsetAsync((char*)d_ws + WS_CTL, 0, CTL_ZERO_BYTES, stream);
    Params p{};
    for (int i = 0; i < 19; ++i) p.in[i] = (const float*)d_in[i];
    p.out = (float*)d_out; p.ws = (unsigned char*)d_ws; p.ph_lo = 0; p.ph_hi = 11;
    void* args[] = {&p};
    hipError_t e = hipLaunchCooperativeKernel((const void*)fwd_kernel, dim3(grid), dim3(NTHR), args, LDS_BYTES, stream);
    if (e != hipSuccess) fprintf(stderr, "kernel_launch: cooperative launch failed: %s (grid %d)\n", hipGetErrorString(e), grid);
}
```

```cpp
#include <hip/hip_runtime.h>
#include <cstdio>
#include <cstdint>

#define LAS __attribute__((address_space(3)))
#define GAS __attribute__((address_space(1)))
typedef unsigned short bf16_t;
typedef short bf16x8 __attribute__((ext_vector_type(8)));
typedef float f32x4 __attribute__((ext_vector_type(4)));
typedef float f32x2 __attribute__((ext_vector_type(2)));
typedef unsigned u32x4 __attribute__((ext_vector_type(4)));
typedef unsigned u32x2 __attribute__((ext_vector_type(2)));
typedef __bf16 bf16x2_t __attribute__((ext_vector_type(2)));

namespace pg8 {
#define PG8_LAS __attribute__((address_space(3)))
constexpr int BM = 256, BK = 64, HALF = 128, HTB = HALF * BK * 2, STAGE_BYTES = 8 * HTB, NXCD = 8, WGM = 8;
__host__ __device__ __forceinline__ int lds_byte(int r, int c) { const int st = (r >> 4) * 2 + (c >> 5), rr = r & 15, cc = c & 31, ob = rr * 64 + cc * 2; return st * 1024 + (ob ^ (((ob >> 9) & 1) << 5)); }
__host__ __device__ __forceinline__ void stage_rc(int b, int& R, int& C) { const int st = b / 1024, sb = b % 1024, swz = sb ^ (((sb >> 9) & 1) << 5); R = (st >> 1) * 16 + swz / 64; C = (st & 1) * 32 + (swz % 64) / 2; }
__host__ __device__ __forceinline__ int perm32(int rho) { const int n = rho >> 4, i = rho & 15; return 8 * (i >> 2) + 4 * n + (i & 3); }
struct Unit { int pm, pn; };
struct Gemm { const bf16_t* A; const bf16_t* Bt; int M, N, K; };
struct StaticOrder {
    int nM, nN, nwg, G, c;
    __host__ __device__ void init(int M, int N, int G_, int c_) { nM = M / BM; nN = N / BM; nwg = nM * nN; G = G_; c = c_; }
    __host__ __device__ bool next(int i, Unit& u) const {
        const long L = (long)i * G + c; if (L >= nwg) return false;
        int wgid = (int)L; { const int q = nwg / NXCD, r = nwg % NXCD, xcd = wgid % NXCD, off = wgid / NXCD; wgid = (xcd < r ? xcd * (q + 1) : r * (q + 1) + (xcd - r) * q) + off; }
        const int nig = WGM * nN, gid = wgid / nig, fm = gid * WGM, gsz = (nM - fm) < WGM ? (nM - fm) : WGM;
        u.pm = fm + ((wgid % nig) % gsz); u.pn = (wgid % nig) / gsz; return true;
    }
    __device__ __forceinline__ void a_ready(const Unit&) const {}
    __device__ __forceinline__ void done(const Unit&) const {}
};
__device__ __forceinline__ unsigned cvt_pk_bf16(float lo, float hi) { unsigned r; asm volatile("v_cvt_pk_bf16_f32 %0, %1, %2" : "=v"(r) : "v"(lo), "v"(hi)); return r; }

template <class Epi, class Sched, bool ALIGN_EPI = false, bool SP2 = false>
__device__ __forceinline__ void gemm_phase(PG8_LAS unsigned char* lds, const Gemm g, const Sched& S, const Epi& E) {
    const int tid = threadIdx.x, wid = __builtin_amdgcn_readfirstlane(tid >> 6), lane = tid & 63, wr = wid >> 2, wc = wid & 3, fr = lane & 15, fq = lane >> 4;
    const int K = g.K, nt = K / BK;
    unsigned voffA[2], voffB[2];
#pragma unroll
    for (int i = 0; i < 2; ++i) { int R, C; stage_rc(tid * 16 + i * 8192, R, C); const int Rb = Epi::PERM ? ((R & ~31) + perm32(R & 31)) : R;
        voffA[i] = (unsigned)(R * K + C) * 2u; voffB[i] = (unsigned)(Rb * K + C) * 2u; }
    const size_t kstep = (size_t)(BK * 2);
    const size_t hstep = (size_t)HALF * K * 2;
    const size_t tstep = 2 * hstep;
    const unsigned ldsw = (unsigned)wid * 1024u;
    const int aoff = lds_byte(wr * 64 + fr, fq * 8), boff = lds_byte(wc * 32 + fr, fq * 8);
#define PG8_SA(b, h) (((b) * 2 + (h)) * HTB)
#define PG8_SB(b, h) ((4 + (b) * 2 + (h)) * HTB)
#define PG8_STAGE(bufoff, gbase, voff) do { _Pragma("unroll") for (int _i = 0; _i < 2; ++_i) \
        __builtin_amdgcn_global_load_lds((const unsigned*)((const char*)(gbase) + (voff)[_i]), (PG8_LAS unsigned*)(lds + (bufoff) + ldsw + _i * 8192), 16, 0, 0); } while (0)
#define PG8_LDA(dst, b, h) do { _Pragma("unroll") for (int m = 0; m < 4; ++m) _Pragma("unroll") for (int k = 0; k < 2; ++k) dst[m][k] = *(const PG8_LAS bf16x8*)(lds + PG8_SA(b, h) + aoff + m * 2048 + k * 1024); } while (0)
#define PG8_LDB(dst, b, h) do { _Pragma("unroll") for (int n = 0; n < 2; ++n) _Pragma("unroll") for (int k = 0; k < 2; ++k) dst[n][k] = *(const PG8_LAS bf16x8*)(lds + PG8_SB(b, h) + boff + n * 2048 + k * 1024); } while (0)
#define PG8_MMA(ai, bj, At, Bt) do { __builtin_amdgcn_s_setprio(1); _Pragma("unroll") for (int m = 0; m < 4; ++m) _Pragma("unroll") for (int n = 0; n < 2; ++n) _Pragma("unroll") for (int k = 0; k < 2; ++k) \
        acc[ai][bj][m][n] = __builtin_amdgcn_mfma_f32_16x16x32_bf16(Bt[n][k], At[m][k], acc[ai][bj][m][n], 0, 0, 0); __builtin_amdgcn_s_setprio(0); } while (0)
#define PG8_WAIT_V(n) asm volatile("s_waitcnt vmcnt(" #n ")" ::: "memory")
#define PG8_WAIT_L(n) asm volatile("s_waitcnt lgkmcnt(" #n ")" ::: "memory")
#define PG8_BAR __builtin_amdgcn_s_barrier()
#define PG8_SCHED __builtin_amdgcn_sched_barrier(0)
    Unit cur, nxt; int ui = 0;
    if (!S.next(0, cur)) return;
    f32x4 acc[2][2][4][2];
#pragma unroll
    for (int a = 0; a < 2; ++a)
#pragma unroll
        for (int b = 0; b < 2; ++b)
#pragma unroll
            for (int m = 0; m < 4; ++m)
#pragma unroll
                for (int n = 0; n < 2; ++n) acc[a][b][m][n] = (f32x4){0.f, 0.f, 0.f, 0.f};
    bf16x8 At[4][2], B0[2][2], B1[2][2];
    const char* cA = (const char*)g.A + (size_t)cur.pm * tstep; const char* cB = (const char*)g.Bt + (size_t)cur.pn * tstep;
    S.a_ready(cur);
    if constexpr (SP2) {
        PG8_STAGE(PG8_SB(0, 0), cB, voffB); PG8_STAGE(PG8_SB(0, 1), cB + hstep, voffB); PG8_STAGE(PG8_SA(0, 0), cA, voffA); PG8_STAGE(PG8_SA(0, 1), cA + hstep, voffA);
        if (wr == 1) PG8_BAR;
        PG8_WAIT_V(2); PG8_BAR;
        PG8_STAGE(PG8_SB(1, 0), cB + kstep, voffB); PG8_STAGE(PG8_SA(1, 0), cA + kstep, voffA); PG8_STAGE(PG8_SB(1, 1), cB + hstep + kstep, voffB);
        PG8_WAIT_V(6); PG8_BAR;
    } else {
        PG8_STAGE(PG8_SB(0, 0), cB, voffB); PG8_STAGE(PG8_SA(0, 0), cA, voffA); PG8_STAGE(PG8_SB(0, 1), cB + hstep, voffB); PG8_STAGE(PG8_SA(0, 1), cA + hstep, voffA);
        if (wr == 1) PG8_BAR;
        PG8_WAIT_V(4); PG8_BAR;
        PG8_STAGE(PG8_SB(1, 0), cB + kstep, voffB); PG8_STAGE(PG8_SA(1, 0), cA + kstep, voffA); PG8_STAGE(PG8_SB(1, 1), cB + hstep + kstep, voffB);
        PG8_WAIT_V(6); PG8_BAR;
    }
    for (;;) {
        const bool has_next = S.next(ui + 1, nxt);
        const char* nA = has_next ? (const char*)g.A + (size_t)nxt.pm * tstep : cA; const char* nB = has_next ? (const char*)g.Bt + (size_t)nxt.pn * tstep : cB;
        for (int t = 0; t < nt; t += 2) {
            const bool last = (t == nt - 2);
            const char* a1 = cA + (size_t)(t + 1) * kstep;
            const char* a2 = last ? nA : cA + (size_t)(t + 2) * kstep; const char* b2 = last ? nB : cB + (size_t)(t + 2) * kstep;
            const char* a3 = a2 + kstep; const char* b3 = b2 + kstep;
            if (last && has_next) S.a_ready(nxt);
            if constexpr (SP2) {
            PG8_LDB(B0, 0, 0); PG8_LDB(B1, 0, 1); PG8_SCHED; PG8_LDA(At, 0, 0); PG8_STAGE(PG8_SA(1, 1), a1 + hstep, voffA);
            PG8_WAIT_V(8); PG8_WAIT_L(0); PG8_BAR; PG8_MMA(0, 0, At, B0); PG8_MMA(0, 1, At, B1); PG8_BAR; PG8_SCHED;
            PG8_LDA(At, 0, 1); PG8_STAGE(PG8_SB(0, 0), b2, voffB); PG8_STAGE(PG8_SB(0, 1), b2 + hstep, voffB); PG8_STAGE(PG8_SA(0, 0), a2, voffA);
            PG8_WAIT_V(8); PG8_WAIT_L(0); PG8_BAR; PG8_MMA(1, 0, At, B0); PG8_MMA(1, 1, At, B1); PG8_BAR; PG8_SCHED;
            PG8_LDB(B0, 1, 0); PG8_LDB(B1, 1, 1); PG8_SCHED; PG8_LDA(At, 1, 0); PG8_STAGE(PG8_SA(0, 1), a2 + hstep, voffA);
            PG8_WAIT_V(8); PG8_WAIT_L(0); PG8_BAR; PG8_MMA(0, 0, At, B0); PG8_MMA(0, 1, At, B1); PG8_BAR; PG8_SCHED;
            PG8_LDA(At, 1, 1); PG8_STAGE(PG8_SB(1, 0), b3, voffB); PG8_STAGE(PG8_SB(1, 1), b3 + hstep, voffB); PG8_STAGE(PG8_SA(1, 0), a3, voffA);
            PG8_WAIT_V(8); PG8_WAIT_L(0); PG8_BAR; PG8_MMA(1, 0, At, B0); PG8_MMA(1, 1, At, B1); PG8_BAR; PG8_SCHED;
            } else {
            PG8_LDB(B0, 0, 0); PG8_SCHED; PG8_LDA(At, 0, 0); PG8_STAGE(PG8_SA(1, 1), a1 + hstep, voffA);
            PG8_WAIT_L(8); PG8_BAR; PG8_WAIT_L(0); PG8_MMA(0, 0, At, B0); PG8_BAR; PG8_SCHED;
            PG8_LDB(B1, 0, 1); PG8_STAGE(PG8_SB(0, 0), b2, voffB);
            PG8_BAR; PG8_WAIT_L(0); PG8_MMA(0, 1, At, B1); PG8_BAR;
            PG8_LDA(At, 0, 1); PG8_STAGE(PG8_SA(0, 0), a2, voffA);
            PG8_BAR; PG8_WAIT_L(0); PG8_MMA(1, 0, At, B0); PG8_BAR; PG8_SCHED;
            PG8_STAGE(PG8_SB(0, 1), b2 + hstep, voffB);
            PG8_WAIT_V(6); PG8_BAR; PG8_MMA(1, 1, At, B1); PG8_BAR;
            PG8_LDB(B0, 1, 0); PG8_SCHED; PG8_LDA(At, 1, 0); PG8_STAGE(PG8_SA(0, 1), a2 + hstep, voffA);
            PG8_WAIT_L(8); PG8_BAR; PG8_WAIT_L(0); PG8_MMA(0, 0, At, B0); PG8_BAR; PG8_SCHED;
            PG8_LDB(B1, 1, 1); PG8_STAGE(PG8_SB(1, 0), b3, voffB);
            PG8_BAR; PG8_WAIT_L(0); PG8_MMA(0, 1, At, B1); PG8_BAR;
            PG8_LDA(At, 1, 1); PG8_STAGE(PG8_SA(1, 0), a3, voffA);
            PG8_BAR; PG8_WAIT_L(0); PG8_MMA(1, 0, At, B0); PG8_BAR; PG8_SCHED;
            PG8_STAGE(PG8_SB(1, 1), b3 + hstep, voffB);
            PG8_WAIT_V(6); PG8_BAR; PG8_MMA(1, 1, At, B1); PG8_BAR;
            }
        }
        if constexpr (ALIGN_EPI) { if (wr == 0) PG8_BAR; }
        E(acc, cur, wr, wc, fr, fq); S.done(cur);
        if (!has_next) break;
#pragma unroll
        for (int a = 0; a < 2; ++a)
#pragma unroll
            for (int b = 0; b < 2; ++b)
#pragma unroll
                for (int m = 0; m < 4; ++m)
#pragma unroll
                    for (int n = 0; n < 2; ++n) acc[a][b][m][n] = (f32x4){0.f, 0.f, 0.f, 0.f};
        cur = nxt; cA = nA; cB = nB; ++ui;
        if constexpr (ALIGN_EPI) { if (wr == 1) PG8_BAR; }
    }
    PG8_WAIT_V(0);
    if constexpr (!ALIGN_EPI) { if (wr == 0) PG8_BAR; }
    PG8_BAR;
#undef PG8_SA
#undef PG8_SB
#undef PG8_STAGE
#undef PG8_LDA
#undef PG8_LDB
#undef PG8_MMA
#undef PG8_WAIT_V
#undef PG8_WAIT_L
#undef PG8_BAR
#undef PG8_SCHED
}
}

#ifndef DUPMASK
#define DUPMASK 0
#endif
#ifndef TMASK
#define TMASK 0
#endif
#ifndef UFMT
#define UFMT 4
#endif
#ifndef VFMT
#define VFMT 4
#endif
constexpr int NB = 2, SEQ = 8192, D = 1024, M = NB * SEQ;
constexpr int NPROJ = 2048, NIN = 2304, INLD = 2064;
constexpr int NUNIT = 1024;
constexpr int NEXP = 16384;
constexpr size_t MiB = 1u << 20;
constexpr size_t WS_CTL = 0, CTL_ZERO_BYTES = 64 * 1024;
constexpr size_t WS_MOD = 1 * MiB;
constexpr size_t WS_DEC = 1 * MiB + 512 * 1024;
constexpr size_t WS_WIN = 2 * MiB;
constexpr size_t WS_WOUT = 7 * MiB;
constexpr size_t WS_WQ = 9 * MiB;
constexpr size_t WS_KK = 13 * MiB;
constexpr size_t WS_IDX = 14 * MiB;
constexpr size_t WS_GATE = 22 * MiB;
constexpr size_t WS_LOGA = 30 * MiB;
constexpr size_t WS_KV = 46 * MiB;
constexpr size_t WS_H = 78 * MiB;
constexpr size_t WS_U8 = 110 * MiB;
constexpr size_t WS_V8 = 126 * MiB;
constexpr size_t WS_SU = 142 * MiB;
constexpr size_t WS_SV = 142 * MiB + 65536;
constexpr size_t WS_PROJ = 174 * MiB;
constexpr size_t WS_END = 238 * MiB;
constexpr int CW_BAR = 1024;
constexpr int NWAVES = 8, NTHR = 512;
constexpr int LDS_BYTES = 147456, MISC_OFF = 147456 - 256;

#define XB_TMO      128
#define XB_XCNT(j)  (256  + 64 * (j))
#define XB_XSUB(j)  (1280 + 64 * (j))
#define XB_XGEN(j)  (2304 + 64 * (j))
#define XB_TOP      3328
#define XB_TOPGEN   3392
#define XCD_BAR_WORDS 3456
#define XB_SPIN_CAP (1u << 20)
__device__ __forceinline__ unsigned xb_ld(unsigned* p)              { return __hip_atomic_load(p, __ATOMIC_RELAXED, __HIP_MEMORY_SCOPE_AGENT); }
__device__ __forceinline__ unsigned xb_add(unsigned* p, unsigned v) { return __hip_atomic_fetch_add(p, v, __ATOMIC_RELAXED, __HIP_MEMORY_SCOPE_AGENT); }
__device__ __forceinline__ unsigned xb_xcc_id() { return (unsigned)__builtin_amdgcn_s_getreg((3 << 11) | 20) & 0xFu; }
#define XB_SPIN(cond, bar) do { unsigned _sp = 0; while (cond) { __builtin_amdgcn_s_sleep(1); \
    if ((++_sp & 255u) == 0u) { if (xb_ld(&(bar)[XB_TMO])) break; if (_sp > XB_SPIN_CAP) { atomicAdd(&(bar)[XB_TMO], 1u); break; } } } } while (0)
struct XcdBarrier { unsigned* bar; unsigned x; volatile LAS unsigned* st; };
__device__ __forceinline__ XcdBarrier xcd_barrier_post(unsigned* bar, volatile LAS unsigned* st) {
    XcdBarrier b; b.bar = bar; b.x = xb_xcc_id(); b.st = st;
    if (threadIdx.x == 0) (void)xb_add(&bar[XB_XCNT(b.x)], 1u);
    return b;
}
__device__ __forceinline__ void xcd_barrier_complete(unsigned* bar, unsigned x, unsigned& nloc, unsigned& nx) {
    const unsigned G = gridDim.x * gridDim.y * gridDim.z;
    unsigned sum, cnt, mine, sp = 0u;
    for (;;) {
        sum = 0u; cnt = 0u; mine = 0u;
#pragma unroll
        for (unsigned j = 0; j < 16; ++j) { const unsigned c = xb_ld(&bar[XB_XCNT(j)]); sum += c; cnt += (c > 0u) ? 1u : 0u; mine = (j == x) ? c : mine; }
        if (sum == G) break;
        __builtin_amdgcn_s_sleep(1);
        if ((++sp & 255u) == 0u) { if (xb_ld(&bar[XB_TMO])) break; if (sp > XB_SPIN_CAP) { atomicAdd(&bar[XB_TMO], 1u); break; } }
    }
    nloc = mine > 0u ? mine : 1u; nx = cnt > 0u ? cnt : 1u;
}
__device__ __forceinline__ void xcd_barrier(const XcdBarrier& b) {
    asm volatile("s_waitcnt vmcnt(0)" ::: "memory");
    __syncthreads();
    if (threadIdx.x == 0) {
        unsigned* bar = b.bar;
        __builtin_amdgcn_s_waitcnt(0);
        unsigned nloc = b.st[0], nx = b.st[1];
        if (nloc == 0u) { xcd_barrier_complete(bar, b.x, nloc, nx); b.st[0] = nloc; b.st[1] = nx; }
        const unsigned old = xb_add(&bar[XB_XSUB(b.x)], 1u);
        const unsigned gen = old / nloc;
        if (old + 1u == (gen + 1u) * nloc) {
            __builtin_amdgcn_fence(__ATOMIC_RELEASE, "agent");
            asm volatile("s_waitcnt vmcnt(0)" ::: "memory");
            const unsigned og = xb_add(&bar[XB_TOP], 1u);
            const unsigned tg = og / nx;
            if (og + 1u == (tg + 1u) * nx) xb_add(&bar[XB_TOPGEN], 1u);
            else XB_SPIN(xb_ld(&bar[XB_TOPGEN]) == tg, bar);
            __builtin_amdgcn_fence(__ATOMIC_ACQUIRE, "agent");
            xb_add(&bar[XB_XGEN(b.x)], 1u);
            asm volatile("s_waitcnt vmcnt(0)" ::: "memory");
        } else {
            XB_SPIN(xb_ld(&bar[XB_XGEN(b.x)]) == gen, bar);
            __builtin_amdgcn_fence(__ATOMIC_ACQUIRE, "agent");
            asm volatile("s_waitcnt vmcnt(0)" ::: "memory");
        }
    }
    __syncthreads();
}

__device__ __forceinline__ unsigned f2bf(float f) { unsigned u = __builtin_bit_cast(unsigned, f); return (u + 0x7fffu + ((u >> 16) & 1u)) >> 16; }
__device__ __forceinline__ unsigned pk2(float lo, float hi) { return f2bf(lo) | (f2bf(hi) << 16); }
__device__ __forceinline__ float bflo(unsigned w) { return __builtin_bit_cast(float, w << 16); }
__device__ __forceinline__ float bfhi(unsigned w) { return __builtin_bit_cast(float, w & 0xffff0000u); }
__device__ __forceinline__ float wave_sum(float v) {
#pragma unroll
    for (int o = 1; o < 64; o <<= 1) v += __shfl_xor(v, o);
    return v;
}
__device__ __forceinline__ float silu_f(float x) { return x / (1.f + __expf(-x)); }
__device__ __forceinline__ float logsig_f(float x) { return fminf(x, 0.f) - log1pf(__expf(-fabsf(x))); }
__device__ __forceinline__ float gelu_f(float x) { return 0.5f * x * (1.f + erff(x * 0.70710678118654752f)); }

template <int FMT> struct RowVec { u32x4 w; };
template <> struct RowVec<4> { u32x2 w; };
template <int FMT> __device__ __forceinline__ RowVec<FMT> row_load(const unsigned char* tab, int eid, int lane) {
    RowVec<FMT> r;
    if constexpr (FMT == 4) r.w = *(const u32x2*)(tab + (size_t)eid * 512 + 8 * lane); else r.w = *(const u32x4*)(tab + (size_t)eid * 1024 + 16 * lane);
    return r;
}
template <int FMT> __device__ __forceinline__ void row_decode(const RowVec<FMT>& r, float (&f)[16]) {
    if constexpr (FMT == 4) {
        const unsigned w[2] = {r.w.x, r.w.y};
#pragma unroll
        for (int k = 0; k < 2; ++k) {
            const f32x2 p0 = __builtin_amdgcn_cvt_scalef32_pk_f32_fp4(w[k], 1.0f, 0), p1 = __builtin_amdgcn_cvt_scalef32_pk_f32_fp4(w[k], 1.0f, 1);
            const f32x2 p2 = __builtin_amdgcn_cvt_scalef32_pk_f32_fp4(w[k], 1.0f, 2), p3 = __builtin_amdgcn_cvt_scalef32_pk_f32_fp4(w[k], 1.0f, 3);
            f[8 * k] = p0.x; f[8 * k + 1] = p0.y; f[8 * k + 2] = p1.x; f[8 * k + 3] = p1.y; f[8 * k + 4] = p2.x; f[8 * k + 5] = p2.y; f[8 * k + 6] = p3.x; f[8 * k + 7] = p3.y; }
    } else {
        const unsigned w[4] = {r.w.x, r.w.y, r.w.z, r.w.w};
#pragma unroll
        for (int k = 0; k < 4; ++k) { const f32x2 lo = __builtin_amdgcn_cvt_pk_f32_fp8((int)w[k], false), hi = __builtin_amdgcn_cvt_pk_f32_fp8((int)w[k], true);
            f[4 * k] = lo.x; f[4 * k + 1] = lo.y; f[4 * k + 2] = hi.x; f[4 * k + 3] = hi.y; }
    }
}

template <int UF, int VF> __device__ __forceinline__ void peer_chunk_load(RowVec<UF> (&uu)[8], RowVec<VF> (&vv)[8], const unsigned char* U8, const unsigned char* V8, int idr, int c8, int lane) {
#pragma unroll
    for (int q = 0; q < 8; ++q) { const int eid = __builtin_amdgcn_readlane(idr, c8 + q); uu[q] = row_load<UF>(U8, eid, lane); vv[q] = row_load<VF>(V8, eid, lane); }
}
template <int UF, int VF> __device__ __forceinline__ void peer_chunk_compute(const RowVec<UF> (&uu)[8], const RowVec<VF> (&vv)[8], const float (&hf)[16], float (&o)[16], float zs, float as, int c8, int lane) {
    float z[8];
#pragma unroll
    for (int q = 0; q < 8; ++q) { float f[16]; row_decode<UF>(uu[q], f); float a0 = 0.f, a1 = 0.f;
#pragma unroll
        for (int k = 0; k < 8; ++k) { a0 += hf[2 * k] * f[2 * k]; a1 += hf[2 * k + 1] * f[2 * k + 1]; }
        z[q] = a0 + a1; }
    float r1[4], r2[2], r3;
#pragma unroll
    for (int k = 0; k < 4; ++k) { const bool hi1 = lane & 1; const float keep = hi1 ? z[2 * k + 1] : z[2 * k], send = hi1 ? z[2 * k] : z[2 * k + 1]; r1[k] = keep + __shfl_xor(send, 1); }
#pragma unroll
    for (int k = 0; k < 2; ++k) { const bool hi1 = lane & 2; const float keep = hi1 ? r1[2 * k + 1] : r1[2 * k], send = hi1 ? r1[2 * k] : r1[2 * k + 1]; r2[k] = keep + __shfl_xor(send, 2); }
    { const bool hi1 = lane & 4; const float keep = hi1 ? r2[1] : r2[0], send = hi1 ? r2[0] : r2[1]; r3 = keep + __shfl_xor(send, 4); }
    r3 += __shfl_xor(r3, 8); r3 += __shfl_xor(r3, 16); r3 += __shfl_xor(r3, 32);
    const float act = gelu_f(r3 * zs) * as;
#pragma unroll
    for (int q = 0; q < 8; ++q) { const float a = __builtin_bit_cast(float, __builtin_amdgcn_readlane(__builtin_bit_cast(int, act), c8 + q));
        float f[16]; row_decode<VF>(vv[q], f);
#pragma unroll
        for (int k = 0; k < 16; ++k) o[k] += a * f[k]; }
}

typedef _Float16 h2_t __attribute__((ext_vector_type(2)));
template <int CTRL> __device__ __forceinline__ float dppf(float v) { return __builtin_bit_cast(float, __builtin_amdgcn_update_dpp(0, __builtin_bit_cast(int, v), CTRL, 0xF, 0xF, true)); }
__device__ __forceinline__ void peer_chunk_compute4(const RowVec<4> (&uu)[8], const RowVec<4> (&vv)[8], const h2_t (&hh)[8], h2_t (&o2)[8], float zs, float as64, int c8, int lane) {
    float z[8];
#pragma unroll
    for (int q = 0; q < 8; ++q) { const unsigned w0 = uu[q].w.x, w1 = uu[q].w.y; float a0 = 0.f, a1 = 0.f;
        a0 = __builtin_amdgcn_fdot2(__builtin_amdgcn_cvt_scalef32_pk_f16_fp4(w0, 1.0f, 0), hh[0], a0, false); a1 = __builtin_amdgcn_fdot2(__builtin_amdgcn_cvt_scalef32_pk_f16_fp4(w1, 1.0f, 0), hh[4], a1, false);
        a0 = __builtin_amdgcn_fdot2(__builtin_amdgcn_cvt_scalef32_pk_f16_fp4(w0, 1.0f, 1), hh[1], a0, false); a1 = __builtin_amdgcn_fdot2(__builtin_amdgcn_cvt_scalef32_pk_f16_fp4(w1, 1.0f, 1), hh[5], a1, false);
        a0 = __builtin_amdgcn_fdot2(__builtin_amdgcn_cvt_scalef32_pk_f16_fp4(w0, 1.0f, 2), hh[2], a0, false); a1 = __builtin_amdgcn_fdot2(__builtin_amdgcn_cvt_scalef32_pk_f16_fp4(w1, 1.0f, 2), hh[6], a1, false);
        a0 = __builtin_amdgcn_fdot2(__builtin_amdgcn_cvt_scalef32_pk_f16_fp4(w0, 1.0f, 3), hh[3], a0, false); a1 = __builtin_amdgcn_fdot2(__builtin_amdgcn_cvt_scalef32_pk_f16_fp4(w1, 1.0f, 3), hh[7], a1, false);
        z[q] = a0 + a1; }
    float r1[4], r2[2], r3;
#pragma unroll
    for (int k = 0; k < 4; ++k) { const bool hi1 = lane & 1; const float keep = hi1 ? z[2 * k + 1] : z[2 * k], send = hi1 ? z[2 * k] : z[2 * k + 1]; r1[k] = keep + dppf<0xB1>(send); }
#pragma unroll
    for (int k = 0; k < 2; ++k) { const bool hi1 = lane & 2; const float keep = hi1 ? r1[2 * k + 1] : r1[2 * k], send = hi1 ? r1[2 * k] : r1[2 * k + 1]; r2[k] = keep + dppf<0x4E>(send); }
    { const bool hi1 = lane & 4; const float keep = hi1 ? r2[1] : r2[0], send = hi1 ? r2[0] : r2[1]; r3 = keep + dppf<0x124>(send); }
    r3 += dppf<0x128>(r3); r3 += __shfl_xor(r3, 16); r3 += __shfl_xor(r3, 32);
    const float act = gelu_f(r3 * zs) * as64;
#pragma unroll
    for (int q = 0; q < 8; ++q) { const float a = __builtin_bit_cast(float, __builtin_amdgcn_readlane(__builtin_bit_cast(int, act), c8 + q));
        const _Float16 ah = (_Float16)a; const h2_t a2 = {ah, ah}; const unsigned w0 = vv[q].w.x, w1 = vv[q].w.y;
        o2[0] = __builtin_amdgcn_cvt_scalef32_pk_f16_fp4(w0, 1.0f, 0) * a2 + o2[0]; o2[1] = __builtin_amdgcn_cvt_scalef32_pk_f16_fp4(w0, 1.0f, 1) * a2 + o2[1];
        o2[2] = __builtin_amdgcn_cvt_scalef32_pk_f16_fp4(w0, 1.0f, 2) * a2 + o2[2]; o2[3] = __builtin_amdgcn_cvt_scalef32_pk_f16_fp4(w0, 1.0f, 3) * a2 + o2[3];
        o2[4] = __builtin_amdgcn_cvt_scalef32_pk_f16_fp4(w1, 1.0f, 0) * a2 + o2[4]; o2[5] = __builtin_amdgcn_cvt_scalef32_pk_f16_fp4(w1, 1.0f, 1) * a2 + o2[5];
        o2[6] = __builtin_amdgcn_cvt_scalef32_pk_f16_fp4(w1, 1.0f, 2) * a2 + o2[6]; o2[7] = __builtin_amdgcn_cvt_scalef32_pk_f16_fp4(w1, 1.0f, 3) * a2 + o2[7]; }
}

struct Params { const float* in[19]; float* out; unsigned char* ws; int ph_lo, ph_hi; };

struct EpiProj {
    static constexpr bool PERM = true;
    bf16_t* P; float* LA; const float* gb;
    __device__ __forceinline__ void operator()(const f32x4 (&acc)[2][2][4][2], const pg8::Unit& u, int wr, int wc, int fr, int fq) const {
        const int row0 = u.pm * 256 + wr * 64 + fr;
        if (u.pn < 8) {
            const int col0 = u.pn * 256 + wc * 32 + 8 * fq;
#pragma unroll
            for (int ai = 0; ai < 2; ++ai)
#pragma unroll
                for (int m = 0; m < 4; ++m) { bf16_t* rowp = P + (size_t)(row0 + ai * 128 + m * 16) * NPROJ + col0;
#pragma unroll
                    for (int bj = 0; bj < 2; ++bj) { const f32x4 v0 = acc[ai][bj][m][0], v1 = acc[ai][bj][m][1];
                        u32x4 w; w.x = pg8::cvt_pk_bf16(v0[0], v0[1]); w.y = pg8::cvt_pk_bf16(v0[2], v0[3]); w.z = pg8::cvt_pk_bf16(v1[0], v1[1]); w.w = pg8::cvt_pk_bf16(v1[2], v1[3]);
                        *(u32x4*)(rowp + bj * 128) = w; } }
        } else {
            const int col0 = wc * 32 + 8 * fq;
            f32x4 bv[2][2];
#pragma unroll
            for (int bj = 0; bj < 2; ++bj)
#pragma unroll
                for (int n = 0; n < 2; ++n) bv[bj][n] = *(const f32x4*)(gb + col0 + bj * 128 + 4 * n);
#pragma unroll
            for (int ai = 0; ai < 2; ++ai)
#pragma unroll
                for (int m = 0; m < 4; ++m) { float* rowp = LA + (size_t)(row0 + ai * 128 + m * 16) * 256 + col0;
#pragma unroll
                    for (int bj = 0; bj < 2; ++bj)
#pragma unroll
                        for (int n = 0; n < 2; ++n) { const f32x4 v = acc[ai][bj][m][n] + bv[bj][n]; f32x4 o;
#pragma unroll
                            for (int j = 0; j < 4; ++j) o[j] = logsig_f(v[j]) * (1.0f / 16.0f);
                            *(f32x4*)(rowp + bj * 128 + 4 * n) = o; } }
        }
    }
};
struct EpiX1 {
    static constexpr bool PERM = false;
    const float* x; float* X1; const float* gate;
    __device__ __forceinline__ void operator()(const f32x4 (&acc)[2][2][4][2], const pg8::Unit& u, int wr, int wc, int fr, int fq) const {
        const int row0 = u.pm * 256 + wr * 64 + fr, col0 = u.pn * 256 + wc * 32 + 4 * fq;
        const float* gp = gate + (u.pm >= 32 ? 6144 : 0);
        f32x4 gv[2][2];
#pragma unroll
        for (int bj = 0; bj < 2; ++bj)
#pragma unroll
            for (int n = 0; n < 2; ++n) gv[bj][n] = *(const f32x4*)(gp + col0 + bj * 128 + n * 16);
#pragma unroll
        for (int ai = 0; ai < 2; ++ai)
#pragma unroll
            for (int m = 0; m < 4; ++m) { const size_t ro = (size_t)(row0 + ai * 128 + m * 16) * D + col0;
#pragma unroll
                for (int bj = 0; bj < 2; ++bj)
#pragma unroll
                    for (int n = 0; n < 2; ++n) { const f32x4 xv = *(const f32x4*)(x + ro + bj * 128 + n * 16);
                        *(f32x4*)(X1 + ro + bj * 128 + n * 16) = xv + gv[bj][n] * acc[ai][bj][m][n]; } }
    }
};
struct EpiQ {
    static constexpr bool PERM = true;
    bf16_t* Q;
    __device__ __forceinline__ void operator()(const f32x4 (&acc)[2][2][4][2], const pg8::Unit& u, int wr, int wc, int fr, int fq) const {
        const int row0 = u.pm * 256 + wr * 64 + fr, col0 = u.pn * 256 + wc * 32 + 8 * fq;
#pragma unroll
        for (int ai = 0; ai < 2; ++ai)
#pragma unroll
            for (int m = 0; m < 4; ++m) { bf16_t* rowp = Q + (size_t)(row0 + ai * 128 + m * 16) * 2048 + col0;
#pragma unroll
                for (int bj = 0; bj < 2; ++bj) { const f32x4 v0 = acc[ai][bj][m][0], v1 = acc[ai][bj][m][1];
                    u32x4 w; w.x = pg8::cvt_pk_bf16(v0[0], v0[1]); w.y = pg8::cvt_pk_bf16(v0[2], v0[3]); w.z = pg8::cvt_pk_bf16(v1[0], v1[1]); w.w = pg8::cvt_pk_bf16(v1[2], v1[3]);
                    *(u32x4*)(rowp + bj * 128) = w; } }
    }
};

__device__ __forceinline__ void transpose_item(const float* W, int ldw, int k0, int n0, bf16_t* WT, int ldt, int row0, LAS float* scr, int lane) {
#pragma unroll 8
    for (int i = 0; i < 32; ++i) { const int kk = 2 * i + (lane >> 5); scr[kk * 33 + (lane & 31)] = W[(size_t)(k0 + kk) * ldw + n0 + (lane & 31)]; }
    asm volatile("s_waitcnt lgkmcnt(0)" ::: "memory");
    const int c = lane & 7;
#pragma unroll
    for (int j = 0; j < 4; ++j) { const int n = (lane >> 3) + 8 * j; const LAS float* s = scr + (8 * c) * 33 + n;
        u32x4 o; o.x = pk2(s[0 * 33], s[1 * 33]); o.y = pk2(s[2 * 33], s[3 * 33]); o.z = pk2(s[4 * 33], s[5 * 33]); o.w = pk2(s[6 * 33], s[7 * 33]);
        *(u32x4*)(WT + (size_t)(row0 + n0 + n) * ldt + k0 + 8 * c) = o; }
    asm volatile("s_waitcnt lgkmcnt(0)" ::: "memory");
}

template <int NR> __device__ __forceinline__ void norm_mod_rows(const float* xbase, int m0, int mstride, const float* g, const float* MODp, int modoff, bf16_t* obase, int lane) {
    f32x4 v[NR][4]; float s[NR];
#pragma unroll
    for (int a = 0; a < NR; ++a) { const float* xrow = xbase + (size_t)(m0 + a * mstride) * D;
#pragma unroll
        for (int j = 0; j < 4; ++j) v[a][j] = *(const f32x4*)(xrow + 4 * lane + 256 * j); }
#pragma unroll
    for (int a = 0; a < NR; ++a) { s[a] = 0.f;
#pragma unroll
        for (int j = 0; j < 4; ++j) s[a] += (v[a][j].x * v[a][j].x + v[a][j].y * v[a][j].y) + (v[a][j].z * v[a][j].z + v[a][j].w * v[a][j].w); }
#pragma unroll
    for (int o = 1; o < 64; o <<= 1)
#pragma unroll
        for (int a = 0; a < NR; ++a) s[a] += __shfl_xor(s[a], o);
#pragma unroll
    for (int a = 0; a < NR; ++a) { const int m = m0 + a * mstride; const float rstd = 1.f / sqrtf(s[a] * (1.f / D) + 1e-6f);
        const float* shift = MODp + (m >= SEQ ? 6144 : 0) + modoff; const float* scale = shift + 1024; bf16_t* orow = obase + (size_t)m * D;
#pragma unroll
        for (int j = 0; j < 4; ++j) { const int c = 4 * lane + 256 * j;
            const f32x4 gg = *(const f32x4*)(g + c), sh = *(const f32x4*)(shift + c), sc = *(const f32x4*)(scale + c);
            const f32x4 y = v[a][j] * rstd * gg * (sc + 1.0f) + sh;
            u32x2 o; o.x = pk2(y.x, y.y); o.y = pk2(y.z, y.w);
            *(u32x2*)(orow + c) = o; } }
}

__constant__ unsigned char CAND_IJ[64] = {
    0x00,0x01,0x02,0x03,0x04,0x05,0x06,0x07,0x08,0x09,0x0a,0x0b,0x0c,0x0d,0x0e,0x0f,
    0x10,0x11,0x12,0x13,0x14,0x15,0x16,0x17,
    0x20,0x21,0x22,0x23,0x24,
    0x30,0x31,0x32,0x33,
    0x40,0x41,0x42,
    0x50,0x51, 0x60,0x61, 0x70,0x71,
    0x80,0x90,0xa0,0xb0,0xc0,0xd0,0xe0,0xf0,
    0,0,0,0,0,0,0,0,0,0,0,0,0,0};

__device__ __forceinline__ unsigned fkey(float f, unsigned idbits, unsigned idmask) {
    unsigned u = __builtin_bit_cast(unsigned, f); u = (u & 0x80000000u) ? ~u : (u | 0x80000000u);
    return (u & ~idmask) | idbits;
}
__device__ __forceinline__ float fkey_val(unsigned key, unsigned idmask) {
    unsigned u = key & ~idmask; u = (u & 0x80000000u) ? (u ^ 0x80000000u) : ~u;
    return __builtin_bit_cast(float, u);
}
template <int CTRL, int ROWMASK> __device__ __forceinline__ unsigned dpp_u(unsigned v) { return (unsigned)__builtin_amdgcn_update_dpp(0, (int)v, CTRL, ROWMASK, 0xF, true); }
template <int CTRL, int ROWMASK> __device__ __forceinline__ float dpp_f(float v) { return __builtin_bit_cast(float, __builtin_amdgcn_update_dpp(0, __builtin_bit_cast(int, v), CTRL, ROWMASK, 0xF, true)); }
__device__ __forceinline__ unsigned umax_(unsigned a, unsigned b) { return a > b ? a : b; }
__device__ __forceinline__ unsigned umin_(unsigned a, unsigned b) { return a < b ? a : b; }
template <int N> __device__ __forceinline__ unsigned ror_u(unsigned v) { return (unsigned)__builtin_amdgcn_update_dpp((int)v, (int)v, 0x120 + N, 0xF, 0xF, false); }
template <int N> __device__ __forceinline__ float ror_f(float v) { return __builtin_bit_cast(float, __builtin_amdgcn_update_dpp(__builtin_bit_cast(int, v), __builtin_bit_cast(int, v), 0x120 + N, 0xF, 0xF, false)); }
__device__ __forceinline__ unsigned row_allmax(unsigned m) { m = umax_(m, ror_u<1>(m)); m = umax_(m, ror_u<2>(m)); m = umax_(m, ror_u<4>(m)); m = umax_(m, ror_u<8>(m)); return m; }
__device__ __forceinline__ float row_allsum(float m) { m += ror_f<1>(m); m += ror_f<2>(m); m += ror_f<4>(m); m += ror_f<8>(m); return m; }

__global__ void __launch_bounds__(NTHR, 2) fwd_kernel(Params p) {
    extern __shared__ __attribute__((aligned(16))) unsigned char lds_raw[];
    LAS unsigned char* lds = (LAS unsigned char*)lds_raw;
    const int tid = threadIdx.x, lane = tid & 63, wave = __builtin_amdgcn_readfirstlane(tid >> 6);
    const int G = gridDim.x, bx = blockIdx.x;
    const int gw = bx * NWAVES + wave, NGW = G * NWAVES;
    unsigned char* ws = p.ws;
    unsigned* ctl = (unsigned*)(ws + WS_CTL);
    float* MOD = (float*)(ws + WS_MOD);
    float* DEC = (float*)(ws + WS_DEC);
    bf16_t* WIN = (bf16_t*)(ws + WS_WIN);
    bf16_t* WOUT = (bf16_t*)(ws + WS_WOUT);
    bf16_t* WQ = (bf16_t*)(ws + WS_WQ);
    bf16_t* KK = (bf16_t*)(ws + WS_KK);
    int* IDX = (int*)(ws + WS_IDX);
    float* GATE = (float*)(ws + WS_GATE);
    float* LOGA = (float*)(ws + WS_LOGA);
    float* KV = (float*)(ws + WS_KV);
    bf16_t* H = (bf16_t*)(ws + WS_H);
    unsigned char* U8 = ws + WS_U8;
    unsigned char* V8 = ws + WS_V8;
    float* SU = (float*)(ws + WS_SU);
    float* SV = (float*)(ws + WS_SV);
    bf16_t* PROJ = (bf16_t*)(ws + WS_PROJ);
    const float* x = p.in[0]; const float* cvec = p.in[1]; const float* ada_w = p.in[2]; const float* ada_b = p.in[3]; const float* norm1_g = p.in[4];
    const float* w_in = p.in[5]; const float* gate_w = p.in[6]; const float* gate_b = p.in[7]; const float* gla_norm_g = p.in[8];
    const float* pool_w = p.in[9]; const float* pool_scale = p.in[10]; const float* w_out = p.in[11]; const float* norm2_g = p.in[12];
    const float* peer_wq = p.in[13]; const float* peer_k1 = p.in[14]; const float* peer_k2 = p.in[15]; const float* peer_u = p.in[16]; const float* peer_v = p.in[17];
    const float* final_g = p.in[18];
    float* X1 = p.out;

    volatile LAS unsigned* MISC = (volatile LAS unsigned*)(lds + MISC_OFF);
    if (tid < 64) MISC[tid] = 0u;
    __syncthreads();
    XcdBarrier bar = xcd_barrier_post(ctl + CW_BAR, MISC + 8);
    const int lo = p.ph_lo, hi = p.ph_hi;
#define IN(k) (lo <= (k) && (k) < hi)
#define REP(k) for (int rep_ = 0; rep_ < 1 + ((DUPMASK >> (k)) & 1); ++rep_)
#define STAMP(i) do { if (TMASK && wave == 0) { unsigned long long t_; asm volatile("s_memrealtime %0\n\ts_waitcnt lgkmcnt(0)" : "=s"(t_) :: "memory"); if (tid == 0) ((volatile LAS unsigned long long*)(lds + MISC_OFF + 64))[i] = t_; } } while (0)
#define SEAM(k) do { if (IN(k) && IN((k) + 1)) xcd_barrier(bar); STAMP((k) + 1); } while (0)
    STAMP(0);

    if (IN(0)) REP(0) {
        {
            LAS float* sc = (LAS float*)lds;
            LAS f32x4* red = (LAS f32x4*)(lds + 8192);
            for (int i = tid; i < 2048; i += NTHR) sc[i] = silu_f(cvec[i]);
            __syncthreads();
            for (int cb = bx; cb < 256; cb += G) {
                if (tid < 384) {
                    const int f4 = tid % 6, rg = tid / 6;
                    f32x4 a0 = {0.f, 0.f, 0.f, 0.f}, a1 = {0.f, 0.f, 0.f, 0.f};
#pragma unroll 4
                    for (int i = 0; i < 16; ++i) { const int r = rg + 64 * i; const f32x4 w = *(const f32x4*)(ada_w + (size_t)r * 6144 + 24 * cb + 4 * f4);
                        a0 += w * sc[r]; a1 += w * sc[1024 + r]; }
                    red[(rg * 6 + f4) * 2 + 0] = a0; red[(rg * 6 + f4) * 2 + 1] = a1;
                }
                __syncthreads();
                if (tid < 48) { const int b = tid / 24, col = tid % 24; float s = 0.f;
                    for (int rg = 0; rg < 64; ++rg) s += red[(rg * 6 + (col >> 2)) * 2 + b][col & 3];
                    MOD[b * 6144 + 24 * cb + col] = s + ada_b[24 * cb + col]; }
                __syncthreads();
            }
        }
        for (int it = bx; it < 128; it += G) {
            const int g = it >> 5, nb = (it >> 1) & 15, cb = it & 1;
            LAS float* PW = (LAS float*)lds;
            LAS float* WO = (LAS float*)(lds + 32768);
            for (int i = tid; i < 64 * 128; i += NTHR) { const int c = i >> 7, j = i & 127; PW[i] = pool_w[(size_t)(g * 128 + cb * 64 + c) * 128 + j] * pool_scale[g * 128 + j]; }
            for (int i = tid; i < 128 * 64; i += NTHR) { const int j = i >> 6, n = i & 63; WO[i] = w_out[(size_t)(512 + g * 128 + j) * 1024 + nb * 64 + n]; }
            __syncthreads();
            const int n = tid & 63, cg = tid >> 6;
            float a[8];
#pragma unroll
            for (int q = 0; q < 8; ++q) a[q] = 0.f;
            for (int j = 0; j < 128; ++j) { const float wo = WO[j * 64 + n];
#pragma unroll
                for (int q = 0; q < 8; ++q) a[q] += PW[(cg * 8 + q) * 128 + j] * wo; }
            u32x4 o; o.x = pk2(a[0], a[1]); o.y = pk2(a[2], a[3]); o.z = pk2(a[4], a[5]); o.w = pk2(a[6], a[7]);
            *(u32x4*)(WOUT + (size_t)(nb * 64 + n) * 1024 + 512 + g * 128 + cb * 64 + cg * 8) = o;
            __syncthreads();
        }
        {
            LAS float* scr = (LAS float*)(lds + wave * 16384);
            constexpr int I_IN = 16 * 64, I_Q = 16 * 64, I_O = 8 * 32;
            for (int it = gw; it < I_IN + I_Q + I_O; it += NGW) {
                int r = it;
                if (r < I_IN) { transpose_item(w_in, INLD, (r >> 6) * 64, (r & 63) * 32, WIN, 1024, 0, scr, lane); continue; } r -= I_IN;
                if (r < I_Q) { transpose_item(peer_wq, 2048, (r >> 6) * 64, (r & 63) * 32, WQ, 1024, 0, scr, lane); continue; } r -= I_Q;
                transpose_item(w_out, 1024, (r >> 5) * 64, (r & 31) * 32, WOUT, 1024, 0, scr, lane);
            }
        }
        for (int o = bx * NTHR + tid; o < 256 * 1024; o += G * NTHR) { const int j = o >> 10, k = o & 1023; float s = 0.f;
#pragma unroll
            for (int r = 0; r < 16; ++r) s += w_in[(size_t)k * INLD + 2048 + r] * gate_w[r * 256 + j];
            WIN[(size_t)(2048 + j) * 1024 + k] = (bf16_t)f2bf(s); }
        for (int i = bx * NTHR + tid; i < 2 * 128 * 128; i += G * NTHR) KK[i] = (bf16_t)f2bf(i < 16384 ? peer_k1[i] : peer_k2[i - 16384]);
    }
    SEAM(0);

    if (IN(1)) REP(1) {
        for (int m = gw; m < M; m += 4 * NGW) norm_mod_rows<4>(x, m, NGW, norm1_g, MOD, 0, H, lane);
    }
    SEAM(1);

    if (IN(2)) REP(2) {
        pg8::Gemm g{H, WIN, M, NIN, D}; pg8::StaticOrder S; S.init(M, NIN, G, bx);
        EpiProj E{PROJ, LOGA, gate_b};
        pg8::gemm_phase<EpiProj, pg8::StaticOrder, true, true>(lds, g, S, E);
        const int cfirst = (G == 256) ? 64 : 0;
        if (bx >= cfirst)
        for (int r = (bx - cfirst) * NWAVES + wave; r < 2 * NEXP; r += (G - cfirst) * NWAVES) {
            const bool isv = r >= NEXP; const int row = isv ? r - NEXP : r;
            const float* src = (isv ? peer_v : peer_u) + (size_t)row * 1024 + 16 * lane;
            f32x4 v[4]; float am = 0.f;
#pragma unroll
            for (int q = 0; q < 4; ++q) { v[q] = *(const f32x4*)(src + 4 * q); am = fmaxf(am, fmaxf(fmaxf(fabsf(v[q].x), fabsf(v[q].y)), fmaxf(fabsf(v[q].z), fabsf(v[q].w)))); }
#pragma unroll
            for (int off = 1; off < 64; off <<= 1) am = fmaxf(am, __shfl_xor(am, off));
            const bool f4 = isv ? (VFMT == 4) : (UFMT == 4);
            const float top = f4 ? 6.0f : 384.0f;
            const float sc = am > 0.f ? am / top : 1.0f, inv = 1.0f / sc;
            if (f4) {
                unsigned w0 = 0u, w1 = 0u;
                w0 = __builtin_amdgcn_cvt_scalef32_pk_fp4_f32(w0, v[0].x * inv, v[0].y * inv, 1.0f, 0); w0 = __builtin_amdgcn_cvt_scalef32_pk_fp4_f32(w0, v[0].z * inv, v[0].w * inv, 1.0f, 1);
                w0 = __builtin_amdgcn_cvt_scalef32_pk_fp4_f32(w0, v[1].x * inv, v[1].y * inv, 1.0f, 2); w0 = __builtin_amdgcn_cvt_scalef32_pk_fp4_f32(w0, v[1].z * inv, v[1].w * inv, 1.0f, 3);
                w1 = __builtin_amdgcn_cvt_scalef32_pk_fp4_f32(w1, v[2].x * inv, v[2].y * inv, 1.0f, 0); w1 = __builtin_amdgcn_cvt_scalef32_pk_fp4_f32(w1, v[2].z * inv, v[2].w * inv, 1.0f, 1);
                w1 = __builtin_amdgcn_cvt_scalef32_pk_fp4_f32(w1, v[3].x * inv, v[3].y * inv, 1.0f, 2); w1 = __builtin_amdgcn_cvt_scalef32_pk_fp4_f32(w1, v[3].z * inv, v[3].w * inv, 1.0f, 3);
                u32x2 o; o.x = w0; o.y = w1;
                *(u32x2*)((isv ? V8 : U8) + (size_t)row * 512 + 8 * lane) = o;
            } else {
                u32x4 o; unsigned* op = (unsigned*)&o;
#pragma unroll
                for (int q = 0; q < 4; ++q) { int w = 0; w = __builtin_amdgcn_cvt_pk_fp8_f32(v[q].x * inv, v[q].y * inv, w, false); w = __builtin_amdgcn_cvt_pk_fp8_f32(v[q].z * inv, v[q].w * inv, w, true); op[q] = (unsigned)w; }
                *(u32x4*)((isv ? V8 : U8) + (size_t)row * 1024 + 16 * lane) = o;
            }
            if (lane == 0) (isv ? SV : SU)[row] = sc;
        }
    }
    SEAM(2);

    if (IN(3)) REP(3) {
        const int hb = tid >> 8, ht = tid & 255, hw = wave & 3, fr = lane & 15, fq = lane >> 4;
        LAS unsigned char* hbase = lds + hb * 49152;
        LAS float* LAT = (LAS float*)hbase;
        LAS float* SEG = (LAS float*)(hbase + 16640);
        LAS bf16_t* VT = (LAS bf16_t*)(hbase + 17664);
        LAS bf16_t* KT = (LAS bf16_t*)(hbase + 36096);
        for (int it = 0; it < (NUNIT + 2 * G - 1) / (2 * G); ++it) {
            const int u = (it * G + bx) * 2 + hb;
            const bool act = u < NUNIT;
            const int h = u & 3, t0 = (u >> 2) * 64;
            const int c = ht & 63, dc = ht >> 6;
            u32x4 kq0, kq1, vq[4];
            if (act) {
                const float* la = LOGA + (size_t)(t0 + c) * 256 + h * 64 + dc * 16;
                const bf16_t* kp = PROJ + (size_t)(t0 + c) * NPROJ + 256 + h * 64 + dc * 16;
                const bf16_t* vp = PROJ + (size_t)(t0 + c) * NPROJ + 512 + h * 128 + dc * 32;
                f32x4 lv[4];
#pragma unroll
                for (int q = 0; q < 4; ++q) lv[q] = *(const f32x4*)(la + 4 * q);
                kq0 = *(const u32x4*)kp; kq1 = *(const u32x4*)(kp + 8);
#pragma unroll
                for (int q = 0; q < 4; ++q) vq[q] = *(const u32x4*)(vp + 8 * q);
#pragma unroll
                for (int q = 0; q < 4; ++q)
#pragma unroll
                    for (int j = 0; j < 4; ++j) LAT[(dc * 16 + q * 4 + j) * 65 + c] = lv[q][j];
            }
            __syncthreads();
            float loc[16];
            { const int d = ht & 63, seg = ht >> 6; float run = 0.f;
#pragma unroll
                for (int r = 0; r < 16; ++r) { run += LAT[d * 65 + 16 * seg + r]; loc[r] = run; }
                SEG[seg * 64 + d] = run; }
            __syncthreads();
            { const int d = ht & 63, seg = ht >> 6; float pre = 0.f;
#pragma unroll
                for (int s2 = 0; s2 < 3; ++s2) pre += (s2 < seg) ? SEG[s2 * 64 + d] : 0.f;
#pragma unroll
                for (int r = 0; r < 16; ++r) LAT[d * 65 + 16 * seg + r] = pre + loc[r];
                if (act && seg == 3) DEC[u * 64 + d] = __expf(pre + loc[15]); }
            __syncthreads();
            if (act) {
                const unsigned kw[8] = {kq0.x, kq0.y, kq0.z, kq0.w, kq1.x, kq1.y, kq1.z, kq1.w};
#pragma unroll
                for (int q = 0; q < 8; ++q) { const int d = dc * 16 + 2 * q;
                    KT[d * 72 + c] = (bf16_t)f2bf(bflo(kw[q]) * __expf(LAT[d * 65 + 63] - LAT[d * 65 + c]));
                    KT[(d + 1) * 72 + c] = (bf16_t)f2bf(bfhi(kw[q]) * __expf(LAT[(d + 1) * 65 + 63] - LAT[(d + 1) * 65 + c])); }
#pragma unroll
                for (int q = 0; q < 4; ++q) { const unsigned vw[4] = {vq[q].x, vq[q].y, vq[q].z, vq[q].w};
#pragma unroll
                    for (int j = 0; j < 4; ++j) { const int v = dc * 32 + 8 * q + 2 * j; VT[v * 72 + c] = (bf16_t)(vw[j] & 0xffffu); VT[(v + 1) * 72 + c] = (bf16_t)(vw[j] >> 16); } }
            }
            __syncthreads();
            if (act) {
#pragma unroll
                for (int mt2 = 0; mt2 < 2; ++mt2) { const int mt = 2 * hw + mt2;
                    const bf16x8 a0 = *(const LAS bf16x8*)(VT + (16 * mt + fr) * 72 + 8 * fq), a1 = *(const LAS bf16x8*)(VT + (16 * mt + fr) * 72 + 32 + 8 * fq);
#pragma unroll
                    for (int nt = 0; nt < 4; ++nt) {
                        const bf16x8 b0 = *(const LAS bf16x8*)(KT + (16 * nt + fr) * 72 + 8 * fq), b1 = *(const LAS bf16x8*)(KT + (16 * nt + fr) * 72 + 32 + 8 * fq);
                        f32x4 acc = {0.f, 0.f, 0.f, 0.f};
                        acc = __builtin_amdgcn_mfma_f32_16x16x32_bf16(a0, b0, acc, 0, 0, 0); acc = __builtin_amdgcn_mfma_f32_16x16x32_bf16(a1, b1, acc, 0, 0, 0);
                        float* kvp = KV + (size_t)u * 8192 + (16 * mt + 4 * fq) * 64 + 16 * nt + fr;
#pragma unroll
                        for (int r = 0; r < 4; ++r) kvp[r * 64] = acc[r]; } }
            }
            __syncthreads();
        }
    }
    SEAM(3);

    if (IN(4)) REP(4) {
        const int nsb = (8 * 8192 + NTHR - 1) / NTHR;
        const bool dopool = (G > nsb) ? (bx >= nsb) : true;
        const int pbx = (G > nsb) ? bx - nsb : bx, pG = (G > nsb) ? G - nsb : G;
        if (dopool) {
        for (int it = pbx * NTHR + tid; it < (M / 8) * 64; it += pG * NTHR) {
            const int cv = it & 63, run = it >> 6, ch = cv * 8, gq = ch >> 7, w = 2 << gq;
            const int t0 = run * 8, pos0 = t0 & (SEQ - 1);
            const bf16_t* pp = PROJ + 1536 + ch;
            float s[8];
#pragma unroll
            for (int j = 0; j < 8; ++j) s[j] = 0.f;
            for (int q = 1; q <= w; ++q) if (pos0 - q >= 0) { const u32x4 v = *(const u32x4*)(pp + (size_t)(t0 - q) * NPROJ);
                s[0] += bflo(v.x); s[1] += bfhi(v.x); s[2] += bflo(v.y); s[3] += bfhi(v.y); s[4] += bflo(v.z); s[5] += bfhi(v.z); s[6] += bflo(v.w); s[7] += bfhi(v.w); }
            for (int r = 0; r < 8; ++r) {
                const int t = t0 + r, pos = pos0 + r;
                const u32x4 v = *(const u32x4*)(pp + (size_t)t * NPROJ);
                const float cur[8] = {bflo(v.x), bfhi(v.x), bflo(v.y), bfhi(v.y), bflo(v.z), bfhi(v.z), bflo(v.w), bfhi(v.w)};
#pragma unroll
                for (int j = 0; j < 8; ++j) s[j] += cur[j];
                if (pos >= w) { const u32x4 o = *(const u32x4*)(pp + (size_t)(t - w) * NPROJ);
                    s[0] -= bflo(o.x); s[1] -= bfhi(o.x); s[2] -= bflo(o.y); s[3] -= bfhi(o.y); s[4] -= bflo(o.z); s[5] -= bfhi(o.z); s[6] -= bflo(o.w); s[7] -= bfhi(o.w); }
                const float inv = 1.f / (float)((pos + 1) < w ? (pos + 1) : w);
                u32x4 ov; ov.x = pk2(s[0] * inv - cur[0], s[1] * inv - cur[1]); ov.y = pk2(s[2] * inv - cur[2], s[3] * inv - cur[3]);
                ov.z = pk2(s[4] * inv - cur[4], s[5] * inv - cur[5]); ov.w = pk2(s[6] * inv - cur[6], s[7] * inv - cur[7]);
                *(u32x4*)(H + (size_t)t * D + 512 + ch) = ov;
            }
        }
        }
        for (int sq = bx * NTHR + tid; sq < 8 * 8192; sq += G * NTHR) {
            const int bh = sq >> 13, e = sq & 8191, b = bh >> 2, h = bh & 3, d = e & 63;
            float st = 0.f;
            for (int n0 = 0; n0 < 128; n0 += 32) {
                float kv[32], dc[32];
#pragma unroll
                for (int q = 0; q < 32; ++q) { const int u = ((b * 128 + n0 + q) * 4 + h); kv[q] = KV[(size_t)u * 8192 + e]; dc[q] = DEC[u * 64 + d]; }
#pragma unroll
                for (int q = 0; q < 32; ++q) { const int u = ((b * 128 + n0 + q) * 4 + h); KV[(size_t)u * 8192 + e] = st; st = st * dc[q] + kv[q]; }
            }
        }
    }
    SEAM(4);

    if (IN(5)) REP(5) {
        LAS float* LAT = (LAS float*)lds;
        LAS float* SEG = (LAS float*)(lds + 16640);
        LAS bf16_t* A2 = (LAS bf16_t*)(lds + 18688);
        LAS bf16_t* KI = (LAS bf16_t*)(lds + 36096);
        LAS bf16_t* BT = (LAS bf16_t*)(lds + 45312);
        LAS float* OL = (LAS float*)(lds + 80128);
        const int fr = lane & 15, fq = lane >> 4;
        for (int u = bx; u < NUNIT; u += G) {
            const int h = u & 3, t0 = (u >> 2) * 64;
            const int i = tid & 63, dc = tid >> 6;
            const float* la = LOGA + (size_t)(t0 + i) * 256 + h * 64 + dc * 8;
            const bf16_t* qp = PROJ + (size_t)(t0 + i) * NPROJ + h * 64 + dc * 8;
            const bf16_t* vp = PROJ + (size_t)(t0 + i) * NPROJ + 512 + h * 128 + dc * 16;
            const float* sp = KV + (size_t)u * 8192;
            const f32x4 la0 = *(const f32x4*)la, la1 = *(const f32x4*)(la + 4);
            const u32x4 qv = *(const u32x4*)qp, kv = *(const u32x4*)(qp + 256), vv0 = *(const u32x4*)vp, vv1 = *(const u32x4*)(vp + 8);
            f32x4 sv[4];
#pragma unroll
            for (int q = 0; q < 4; ++q) sv[q] = *(const f32x4*)(sp + (q * NTHR + tid) * 4);
#pragma unroll
            for (int j = 0; j < 4; ++j) { LAT[(dc * 8 + j) * 65 + i] = la0[j]; LAT[(dc * 8 + 4 + j) * 65 + i] = la1[j]; }
            __syncthreads();
            float loc[8];
            { const int d = tid & 63, seg = tid >> 6; float run = 0.f;
#pragma unroll
                for (int r = 0; r < 8; ++r) { run += LAT[d * 65 + 8 * seg + r]; loc[r] = run; }
                SEG[seg * 64 + d] = run; }
            __syncthreads();
            { const int d = tid & 63, seg = tid >> 6; float pre = 0.f;
#pragma unroll
                for (int s2 = 0; s2 < 7; ++s2) pre += (s2 < seg) ? SEG[s2 * 64 + d] : 0.f;
#pragma unroll
                for (int r = 0; r < 8; ++r) LAT[d * 65 + 8 * seg + r] = pre + loc[r]; }
            __syncthreads();
            {
                const unsigned qw[4] = {qv.x, qv.y, qv.z, qv.w}, kw[4] = {kv.x, kv.y, kv.z, kv.w};
                u32x4 qo, ko; unsigned* qop = (unsigned*)&qo; unsigned* kop = (unsigned*)&ko;
#pragma unroll
                for (int q = 0; q < 4; ++q) { const int d = dc * 8 + 2 * q; const float b0 = LAT[d * 65 + i], b1 = LAT[(d + 1) * 65 + i];
                    qop[q] = pk2(bflo(qw[q]) * __expf(b0) * 0.125f, bfhi(qw[q]) * __expf(b1) * 0.125f);
                    kop[q] = pk2(bflo(kw[q]) * __expf(-b0), bfhi(kw[q]) * __expf(-b1)); }
                *(LAS u32x4*)(A2 + i * 136 + 64 + dc * 8) = qo;
                *(LAS u32x4*)(KI + i * 72 + dc * 8) = ko;
                const unsigned vw[8] = {vv0.x, vv0.y, vv0.z, vv0.w, vv1.x, vv1.y, vv1.z, vv1.w};
#pragma unroll
                for (int j = 0; j < 8; ++j) { const int v = dc * 16 + 2 * j; BT[v * 136 + i] = (bf16_t)(vw[j] & 0xffffu); BT[(v + 1) * 136 + i] = (bf16_t)(vw[j] >> 16); }
#pragma unroll
                for (int q = 0; q < 4; ++q) { const int e = (q * NTHR + tid) * 4, v = e >> 6, d = e & 63;
                    u32x2 so; so.x = pk2(sv[q].x, sv[q].y); so.y = pk2(sv[q].z, sv[q].w);
                    *(LAS u32x2*)(BT + v * 136 + 64 + d) = so; }
            }
            __syncthreads();
            {
                const int mt = wave & 3;
                const bf16x8 a0 = *(const LAS bf16x8*)(A2 + (16 * mt + fr) * 136 + 64 + 8 * fq), a1 = *(const LAS bf16x8*)(A2 + (16 * mt + fr) * 136 + 96 + 8 * fq);
#pragma unroll
                for (int n2 = 0; n2 < 2; ++n2) { const int nt = 2 * (wave >> 2) + n2;
                    const bf16x8 b0 = *(const LAS bf16x8*)(KI + (16 * nt + fr) * 72 + 8 * fq), b1 = *(const LAS bf16x8*)(KI + (16 * nt + fr) * 72 + 32 + 8 * fq);
                    f32x4 acc = {0.f, 0.f, 0.f, 0.f};
                    acc = __builtin_amdgcn_mfma_f32_16x16x32_bf16(a0, b0, acc, 0, 0, 0); acc = __builtin_amdgcn_mfma_f32_16x16x32_bf16(a1, b1, acc, 0, 0, 0);
                    const int jj = 16 * nt + fr;
#pragma unroll
                    for (int r = 0; r < 4; ++r) { const int ii = 16 * mt + 4 * fq + r; A2[ii * 136 + jj] = (bf16_t)f2bf(jj <= ii ? acc[r] : 0.f); } }
            }
            __syncthreads();
            {
                const int mt = wave & 3;
                bf16x8 af[4];
#pragma unroll
                for (int ks = 0; ks < 4; ++ks) af[ks] = *(const LAS bf16x8*)(A2 + (16 * mt + fr) * 136 + 32 * ks + 8 * fq);
#pragma unroll
                for (int n4 = 0; n4 < 4; ++n4) { const int nt = 4 * (wave >> 2) + n4;
                    f32x4 acc = {0.f, 0.f, 0.f, 0.f};
#pragma unroll
                    for (int ks = 0; ks < 4; ++ks) { const bf16x8 bb = *(const LAS bf16x8*)(BT + (16 * nt + fr) * 136 + 32 * ks + 8 * fq); acc = __builtin_amdgcn_mfma_f32_16x16x32_bf16(af[ks], bb, acc, 0, 0, 0); }
#pragma unroll
                    for (int r = 0; r < 4; ++r) OL[(16 * mt + 4 * fq + r) * 132 + 16 * nt + fr] = acc[r]; }
            }
            __syncthreads();
            {
                const int ti = tid >> 3, vc = tid & 7;
                f32x4 o[4]; float ss = 0.f;
#pragma unroll
                for (int q = 0; q < 4; ++q) { o[q] = *(const LAS f32x4*)(OL + ti * 132 + 16 * vc + 4 * q); ss += (o[q].x * o[q].x + o[q].y * o[q].y) + (o[q].z * o[q].z + o[q].w * o[q].w); }
                ss += __shfl_xor(ss, 1); ss += __shfl_xor(ss, 2); ss += __shfl_xor(ss, 4);
                const float rstd = 1.f / sqrtf(ss * (1.f / 128.f) + 1e-6f);
                const int t = t0 + ti;
                const bf16_t* gp = PROJ + (size_t)t * NPROJ + 1024 + h * 128 + 16 * vc;
                const u32x4 g0 = *(const u32x4*)gp, g1 = *(const u32x4*)(gp + 8);
                const unsigned gw8[8] = {g0.x, g0.y, g0.z, g0.w, g1.x, g1.y, g1.z, g1.w};
                unsigned ow[8];
#pragma unroll
                for (int q = 0; q < 4; ++q) { const f32x4 gn = *(const f32x4*)(gla_norm_g + 16 * vc + 4 * q);
                    const float y0 = o[q].x * rstd * gn.x * silu_f(bflo(gw8[2 * q])), y1 = o[q].y * rstd * gn.y * silu_f(bfhi(gw8[2 * q]));
                    const float y2 = o[q].z * rstd * gn.z * silu_f(bflo(gw8[2 * q + 1])), y3 = o[q].w * rstd * gn.w * silu_f(bfhi(gw8[2 * q + 1]));
                    ow[2 * q] = pk2(y0, y1); ow[2 * q + 1] = pk2(y2, y3); }
                bf16_t* hp2 = H + (size_t)t * D + h * 128 + 16 * vc;
                *(u32x4*)hp2 = (u32x4){ow[0], ow[1], ow[2], ow[3]}; *(u32x4*)(hp2 + 8) = (u32x4){ow[4], ow[5], ow[6], ow[7]};
            }
        }
    }
    SEAM(5);

    if (IN(6)) REP(6) {
        pg8::Gemm g{H, WOUT, M, D, D}; pg8::StaticOrder S; S.init(M, D, G, bx);
        EpiX1 E{x, X1, MOD + 2048};
        pg8::gemm_phase<EpiX1, pg8::StaticOrder, true, true>(lds, g, S, E);
    }
    SEAM(6);

    if (IN(7)) REP(7) {
        for (int m = gw; m < M; m += 4 * NGW) norm_mod_rows<4>(X1, m, NGW, norm2_g, MOD, 3072, H, lane);
    }
    SEAM(7);

    if (IN(8)) REP(8) {
        pg8::Gemm g{H, WQ, M, 2048, D}; pg8::StaticOrder S; S.init(M, 2048, G, bx);
        EpiQ E{PROJ};
        pg8::gemm_phase<EpiQ, pg8::StaticOrder, true, true>(lds, g, S, E);
    }
    SEAM(8);

    if (IN(9)) REP(9) {
        LAS bf16_t* KL = (LAS bf16_t*)lds;
        LAS unsigned char* CT = lds + 69632;
        for (int i = tid; i < 2 * 128 * 16; i += NTHR) { const int row = i >> 4, ck = i & 15; *(LAS u32x4*)(KL + row * 136 + ck * 8) = *(const u32x4*)(KK + row * 128 + ck * 8); }
        if (tid < 64) CT[tid] = CAND_IJ[tid];
        __syncthreads();
        const int fr = lane & 15, fq = lane >> 4, rb4 = (lane & 48) * 4;
        int cia[4], cja[4];
#pragma unroll
        for (int sl = 0; sl < 4; ++sl) { const unsigned ij = CAND_IJ[fr * 4 + sl]; cia[sl] = rb4 + 4 * (int)(ij >> 4); cja[sl] = rb4 + 4 * (int)(ij & 15); }
        const bf16_t* Q = PROJ;
        for (int wi = gw; wi < (M / 16) * 8; wi += NGW) {
            const int h = wi & 7, t0 = (wi >> 3) * 16;
            unsigned kk[8][8];
#pragma unroll
            for (int half = 0; half < 2; ++half) {
                const bf16_t* qp = Q + (size_t)(t0 + fr) * 2048 + h * 256 + half * 128 + fq * 8;
                bf16x8 af[4];
#pragma unroll
                for (int ks = 0; ks < 4; ++ks) af[ks] = *(const bf16x8*)(qp + ks * 32);
                int kboff = half * 128 * 136 + fr * 136 + fq * 8;
                asm volatile("" : "+v"(kboff));
                const LAS bf16_t* kb = KL + kboff;
#pragma unroll
                for (int nt = 0; nt < 8; ++nt) {
                    f32x4 c = {0.f, 0.f, 0.f, 0.f};
#pragma unroll
                    for (int ks = 0; ks < 4; ++ks) { const bf16x8 bf = *(const LAS bf16x8*)(kb + nt * 16 * 136 + ks * 32); c = __builtin_amdgcn_mfma_f32_16x16x32_bf16(af[ks], bf, c, 0, 0, 0); }
#pragma unroll
                    for (int r = 0; r < 4; ++r) kk[half * 4 + r][nt] = fkey(c[r], 127u - (unsigned)(nt * 16 + fr), 127u);
                }
            }
#define CE(a, b) do { const unsigned hi_ = umax_(kx[a], kx[b]), lo_ = umin_(kx[a], kx[b]); kx[a] = hi_; kx[b] = lo_; } while (0)
#pragma unroll
            for (int x = 0; x < 8; ++x) { unsigned (&kx)[8] = kk[x];
                CE(0, 1); CE(2, 3); CE(4, 5); CE(6, 7); CE(0, 2); CE(1, 3); CE(4, 6); CE(5, 7); CE(1, 2); CE(5, 6);
                CE(0, 4); CE(1, 5); CE(2, 6); CE(3, 7); CE(2, 4); CE(3, 5); CE(1, 2); CE(3, 4); CE(5, 6); }
            unsigned res[8];
#pragma unroll
            for (int x = 0; x < 8; ++x) res[x] = 0u;
#pragma unroll 1
            for (int rd = 0; rd < 16; ++rd)
#pragma unroll
                for (int x = 0; x < 8; ++x) { unsigned (&kx)[8] = kk[x];
                    const unsigned m = row_allmax(kx[0]); const bool own = kx[0] == m;
#pragma unroll
                    for (int j = 0; j < 7; ++j) kx[j] = own ? kx[j + 1] : kx[j];
                    kx[7] = own ? 0u : kx[7];
                    res[x] = (fr == rd) ? m : res[x]; }
            unsigned ck[4][4];
#pragma unroll
            for (int r = 0; r < 4; ++r)
#pragma unroll
                for (int sl = 0; sl < 4; ++sl) { const unsigned va = __builtin_amdgcn_ds_bpermute(cia[sl], res[r]), vb = __builtin_amdgcn_ds_bpermute(cja[sl], res[4 + r]);
                    const float sum = fkey_val(va, 127u) + fkey_val(vb, 127u);
                    ck[r][sl] = (fr * 4 + sl < 50) ? fkey(sum, 63u - (unsigned)(fr * 4 + sl), 63u) : 0u; }
#pragma unroll
            for (int r = 0; r < 4; ++r) { unsigned (&kx)[4] = ck[r]; CE(0, 1); CE(2, 3); CE(0, 2); CE(1, 3); CE(1, 2); }
#undef CE
            unsigned res3[4], mfirst[4];
#pragma unroll
            for (int r = 0; r < 4; ++r) { res3[r] = 0u; mfirst[r] = 0u; }
#pragma unroll 1
            for (int rd = 0; rd < 16; ++rd)
#pragma unroll
                for (int r = 0; r < 4; ++r) { unsigned (&kx)[4] = ck[r];
                    const unsigned m = row_allmax(kx[0]); const bool own = kx[0] == m;
                    kx[0] = own ? kx[1] : kx[0]; kx[1] = own ? kx[2] : kx[1]; kx[2] = own ? kx[3] : kx[2]; kx[3] = own ? 0u : kx[3];
                    res3[r] = (fr == rd) ? m : res3[r]; mfirst[r] = (rd == 0) ? m : mfirst[r]; }
#pragma unroll
            for (int r = 0; r < 4; ++r) {
                const unsigned cidx = 63u - (res3[r] & 63u);
                const unsigned ij = CT[cidx];
                const unsigned wa = __builtin_amdgcn_ds_bpermute(rb4 + 4 * (int)(ij >> 4), res[r]), wb = __builtin_amdgcn_ds_bpermute(rb4 + 4 * (int)(ij & 15), res[4 + r]);
                const int eid = (int)((127u - (wa & 127u)) * 128u + (127u - (wb & 127u)));
                const float ex = __expf(fkey_val(res3[r], 63u) - fkey_val(mfirst[r], 63u));
                const float tot = row_allsum(ex);
                const size_t o = (size_t)(t0 + 4 * fq + r) * 128 + h * 16 + fr;
                IDX[o] = eid; GATE[o] = ex / tot;
            }
        }
    }
    SEAM(9);

    if (IN(10)) REP(10) {
        for (int t = gw; t < M; t += NGW) {
            const bf16_t* hp = H + (size_t)t * D + 16 * lane;
            const u32x4 ha = *(const u32x4*)hp, hb = *(const u32x4*)(hp + 8);
            const unsigned hwv[8] = {ha.x, ha.y, ha.z, ha.w, hb.x, hb.y, hb.z, hb.w};
            h2_t hh[8], o2[8];
#pragma unroll
            for (int k = 0; k < 8; ++k) { hh[k] = (h2_t){(_Float16)bflo(hwv[k]), (_Float16)bfhi(hwv[k])}; o2[k] = (h2_t){(_Float16)0.f, (_Float16)0.f}; }
            const int id0 = IDX[(size_t)t * 128 + lane], id1 = IDX[(size_t)t * 128 + 64 + lane];
            const float zs0 = SU[id0], zs1 = SU[id1];
            const float as0 = GATE[(size_t)t * 128 + lane] * SV[id0] * 64.f, as1 = GATE[(size_t)t * 128 + 64 + lane] * SV[id1] * 64.f;
            RowVec<4> uA[8], uB[8], vA[8], vB[8];
            peer_chunk_load<4, 4>(uA, vA, U8, V8, id0, 0, lane);
#pragma unroll 1
            for (int c = 0; c < 16; c += 2) {
                const bool hi = c >= 8; const int idr = hi ? id1 : id0; const float zs = hi ? zs1 : zs0, as = hi ? as1 : as0;
                peer_chunk_load<4, 4>(uB, vB, U8, V8, idr, (8 * c + 8) & 63, lane);
                peer_chunk_compute4(uA, vA, hh, o2, zs, as, (8 * c) & 63, lane);
                if (c + 2 < 16) { const int idn = (c + 2 >= 8) ? id1 : id0; peer_chunk_load<4, 4>(uA, vA, U8, V8, idn, (8 * c + 16) & 63, lane); }
                peer_chunk_compute4(uB, vB, hh, o2, zs, as, (8 * c + 8) & 63, lane);
            }
            float o[16];
#pragma unroll
            for (int k = 0; k < 8; ++k) { o[2 * k] = (float)o2[k].x * (1.0f / 64.0f); o[2 * k + 1] = (float)o2[k].y * (1.0f / 64.0f); }
            const float* g2p = MOD + (t >= SEQ ? 6144 : 0) + 5120 + 16 * lane;
            float* xr = X1 + (size_t)t * D + 16 * lane;
            f32x4 xv[4]; float ss = 0.f;
#pragma unroll
            for (int q = 0; q < 4; ++q) { const f32x4 xx = *(const f32x4*)(xr + 4 * q), gg = *(const f32x4*)(g2p + 4 * q);
                const f32x4 ov = {o[q * 4 + 0], o[q * 4 + 1], o[q * 4 + 2], o[q * 4 + 3]};
                xv[q] = xx + gg * ov; ss += (xv[q].x * xv[q].x + xv[q].y * xv[q].y) + (xv[q].z * xv[q].z + xv[q].w * xv[q].w); }
            const float rstd = 1.f / sqrtf(wave_sum(ss) * (1.f / D) + 1e-6f);
#pragma unroll
            for (int q = 0; q < 4; ++q) { const f32x4 fg = *(const f32x4*)(final_g + 16 * lane + 4 * q);
                *(f32x4*)(xr + 4 * q) = xv[q] * rstd * fg; }
        }
    }
    if (TMASK) { xcd_barrier(bar); STAMP(11);
        if (bx == 0 && tid == 0) { volatile LAS unsigned long long* T = (volatile LAS unsigned long long*)(lds + MISC_OFF + 64); unsigned long long span = 0;
#pragma unroll
            for (int k = 0; k < 11; ++k) if ((TMASK >> k) & 1) span += T[k + 1] - T[k];
            unsigned long long t0, t1; asm volatile("s_memrealtime %0\n\ts_waitcnt lgkmcnt(0)" : "=s"(t0) :: "memory");
            do { __builtin_amdgcn_s_sleep(8); asm volatile("s_memrealtime %0\n\ts_waitcnt lgkmcnt(0)" : "=s"(t1) :: "memory"); } while (t1 - t0 < span); } }
#undef IN
#undef REP
#undef SEAM
}

extern "C" void kernel_launch(void* const* d_in, const int* in_sizes, int n_in, void* d_out, int out_size, void* d_ws, size_t ws_size, hipStream_t stream) {
    static int grid = 0;
    if (grid == 0) {
        if (n_in != 19 || out_size != M * D || ws_size < WS_END) { fprintf(stderr, "kernel_launch: unexpected shapes (n_in %d out %d ws %zu)\n", n_in, out_size, ws_size); grid = -1; return; }
        int dev = 0, cus = 0, per_cu = 0;
        (void)hipGetDevice(&dev); (void)hipDeviceGetAttribute(&cus, hipDeviceAttributeMultiprocessorCount, dev);
        (void)hipFuncSetAttribute((const void*)fwd_kernel, hipFuncAttributeMaxDynamicSharedMemorySize, LDS_BYTES);
        (void)hipOccupancyMaxActiveBlocksPerMultiprocessor(&per_cu, (const void*)fwd_kernel, NTHR, LDS_BYTES);
        (void)hipGetLastError();
        if (per_cu < 1) { fprintf(stderr, "kernel_launch: occupancy query says %d blocks/CU\n", per_cu); per_cu = 1; }
        grid = cus;
    }
    if (grid < 0) return;
    (void)hipMemsetAsync((char*)d_ws + WS_CTL, 0, CTL_ZERO_BYTES, stream);
    Params p{};
    for (int i = 0; i < 19; ++i) p.in[i] = (const float*)d_in[i];
    p.out = (float*)d_out; p.ws = (unsigned char*)d_ws; p.ph_lo = 0; p.ph_hi = 11;
    void* args[] = {&p};
    hipError_t e = hipLaunchCooperativeKernel((const void*)fwd_kernel, dim3(grid), dim3(NTHR), args, LDS_BYTES, stream);
    if (e != hipSuccess) fprintf(stderr, "kernel_launch: cooperative launch failed: %s (grid %d)\n", hipGetErrorString(e), grid);
}
```

```cpp
#include <hip/hip_runtime.h>
#include <cstdio>
#include <cstdint>

#define LAS __attribute__((address_space(3)))
#define GAS __attribute__((address_space(1)))
typedef unsigned short bf16_t;
typedef short bf16x8 __attribute__((ext_vector_type(8)));
typedef float f32x4 __attribute__((ext_vector_type(4)));
typedef float f32x2 __attribute__((ext_vector_type(2)));
typedef unsigned u32x4 __attribute__((ext_vector_type(4)));
typedef unsigned u32x2 __attribute__((ext_vector_type(2)));
typedef __bf16 bf16x2_t __attribute__((ext_vector_type(2)));

namespace pg8 {
#define PG8_LAS __attribute__((address_space(3)))
constexpr int BM = 256, BK = 64, HALF = 128, HTB = HALF * BK * 2, STAGE_BYTES = 8 * HTB, NXCD = 8, WGM = 8;
__host__ __device__ __forceinline__ int lds_byte(int r, int c) { const int st = (r >> 4) * 2 + (c >> 5), rr = r & 15, cc = c & 31, ob = rr * 64 + cc * 2; return st * 1024 + (ob ^ (((ob >> 9) & 1) << 5)); }
__host__ __device__ __forceinline__ void stage_rc(int b, int& R, int& C) { const int st = b / 1024, sb = b % 1024, swz = sb ^ (((sb >> 9) & 1) << 5); R = (st >> 1) * 16 + swz / 64; C = (st & 1) * 32 + (swz % 64) / 2; }
__host__ __device__ __forceinline__ int perm32(int rho) { const int n = rho >> 4, i = rho & 15; return 8 * (i >> 2) + 4 * n + (i & 3); }
struct Unit { int pm, pn; };
struct Gemm { const bf16_t* A; const bf16_t* Bt; int M, N, K; };
struct StaticOrder {
    int nM, nN, nwg, G, c;
    __host__ __device__ void init(int M, int N, int G_, int c_) { nM = M / BM; nN = N / BM; nwg = nM * nN; G = G_; c = c_; }
    __host__ __device__ bool next(int i, Unit& u) const {
        const long L = (long)i * G + c; if (L >= nwg) return false;
        int wgid = (int)L; { const int q = nwg / NXCD, r = nwg % NXCD, xcd = wgid % NXCD, off = wgid / NXCD; wgid = (xcd < r ? xcd * (q + 1) : r * (q + 1) + (xcd - r) * q) + off; }
        const int nig = WGM * nN, gid = wgid / nig, fm = gid * WGM, gsz = (nM - fm) < WGM ? (nM - fm) : WGM;
        u.pm = fm + ((wgid % nig) % gsz); u.pn = (wgid % nig) / gsz; return true;
    }
    __device__ __forceinline__ void a_ready(const Unit&) const {}
    __device__ __forceinline__ void done(const Unit&) const {}
};
__device__ __forceinline__ unsigned cvt_pk_bf16(float lo, float hi) { unsigned r; asm volatile("v_cvt_pk_bf16_f32 %0, %1, %2" : "=v"(r) : "v"(lo), "v"(hi)); return r; }

template <class Epi, class Sched, bool ALIGN_EPI = false, bool SP2 = false>
__device__ __forceinline__ void gemm_phase(PG8_LAS unsigned char* lds, const Gemm g, const Sched& S, const Epi& E) {
    const int tid = threadIdx.x, wid = __builtin_amdgcn_readfirstlane(tid >> 6), lane = tid & 63, wr = wid >> 2, wc = wid & 3, fr = lane & 15, fq = lane >> 4;
    const int K = g.K, nt = K / BK;
    unsigned voffA[2], voffB[2];
#pragma unroll
    for (int i = 0; i < 2; ++i) { int R, C; stage_rc(tid * 16 + i * 8192, R, C); const int Rb = Epi::PERM ? ((R & ~31) + perm32(R & 31)) : R;
        voffA[i] = (unsigned)(R * K + C) * 2u; voffB[i] = (unsigned)(Rb * K + C) * 2u; }
    const size_t kstep = (size_t)(BK * 2);
    const size_t hstep = (size_t)HALF * K * 2;
    const size_t tstep = 2 * hstep;
    const unsigned ldsw = (unsigned)wid * 1024u;
    const int aoff = lds_byte(wr * 64 + fr, fq * 8), boff = lds_byte(wc * 32 + fr, fq * 8);
#define PG8_SA(b, h) (((b) * 2 + (h)) * HTB)
#define PG8_SB(b, h) ((4 + (b) * 2 + (h)) * HTB)
#define PG8_STAGE(bufoff, gbase, voff) do { _Pragma("unroll") for (int _i = 0; _i < 2; ++_i) \
        __builtin_amdgcn_global_load_lds((const unsigned*)((const char*)(gbase) + (voff)[_i]), (PG8_LAS unsigned*)(lds + (bufoff) + ldsw + _i * 8192), 16, 0, 0); } while (0)
#define PG8_LDA(dst, b, h) do { _Pragma("unroll") for (int m = 0; m < 4; ++m) _Pragma("unroll") for (int k = 0; k < 2; ++k) dst[m][k] = *(const PG8_LAS bf16x8*)(lds + PG8_SA(b, h) + aoff + m * 2048 + k * 1024); } while (0)
#define PG8_LDB(dst, b, h) do { _Pragma("unroll") for (int n = 0; n < 2; ++n) _Pragma("unroll") for (int k = 0; k < 2; ++k) dst[n][k] = *(const PG8_LAS bf16x8*)(lds + PG8_SB(b, h) + boff + n * 2048 + k * 1024); } while (0)
#define PG8_MMA(ai, bj, At, Bt) do { __builtin_amdgcn_s_setprio(1); _Pragma("unroll") for (int m = 0; m < 4; ++m) _Pragma("unroll") for (int n = 0; n < 2; ++n) _Pragma("unroll") for (int k = 0; k < 2; ++k) \
        acc[ai][bj][m][n] = __builtin_amdgcn_mfma_f32_16x16x32_bf16(Bt[n][k], At[m][k], acc[ai][bj][m][n], 0, 0, 0); __builtin_amdgcn_s_setprio(0); } while (0)
#define PG8_WAIT_V(n) asm volatile("s_waitcnt vmcnt(" #n ")" ::: "memory")
#define PG8_WAIT_L(n) asm volatile("s_waitcnt lgkmcnt(" #n ")" ::: "memory")
#define PG8_BAR __builtin_amdgcn_s_barrier()
#define PG8_SCHED __builtin_amdgcn_sched_barrier(0)
    Unit cur, nxt; int ui = 0;
    if (!S.next(0, cur)) return;
    f32x4 acc[2][2][4][2];
#pragma unroll
    for (int a = 0; a < 2; ++a)
#pragma unroll
        for (int b = 0; b < 2; ++b)
#pragma unroll
            for (int m = 0; m < 4; ++m)
#pragma unroll
                for (int n = 0; n < 2; ++n) acc[a][b][m][n] = (f32x4){0.f, 0.f, 0.f, 0.f};
    bf16x8 At[4][2], B0[2][2], B1[2][2];
    const char* cA = (const char*)g.A + (size_t)cur.pm * tstep; const char* cB = (const char*)g.Bt + (size_t)cur.pn * tstep;
    S.a_ready(cur);
    if constexpr (SP2) {
        PG8_STAGE(PG8_SB(0, 0), cB, voffB); PG8_STAGE(PG8_SB(0, 1), cB + hstep, voffB); PG8_STAGE(PG8_SA(0, 0), cA, voffA); PG8_STAGE(PG8_SA(0, 1), cA + hstep, voffA);
        if (wr == 1) PG8_BAR;
        PG8_WAIT_V(2); PG8_BAR;
        PG8_STAGE(PG8_SB(1, 0), cB + kstep, voffB); PG8_STAGE(PG8_SA(1, 0), cA + kstep, voffA); PG8_STAGE(PG8_SB(1, 1), cB + hstep + kstep, voffB);
        PG8_WAIT_V(6); PG8_BAR;
    } else {
        PG8_STAGE(PG8_SB(0, 0), cB, voffB); PG8_STAGE(PG8_SA(0, 0), cA, voffA); PG8_STAGE(PG8_SB(0, 1), cB + hstep, voffB); PG8_STAGE(PG8_SA(0, 1), cA + hstep, voffA);
        if (wr == 1) PG8_BAR;
        PG8_WAIT_V(4); PG8_BAR;
        PG8_STAGE(PG8_SB(1, 0), cB + kstep, voffB); PG8_STAGE(PG8_SA(1, 0), cA + kstep, voffA); PG8_STAGE(PG8_SB(1, 1), cB + hstep + kstep, voffB);
        PG8_WAIT_V(6); PG8_BAR;
    }
    for (;;) {
        const bool has_next = S.next(ui + 1, nxt);
        const char* nA = has_next ? (const char*)g.A + (size_t)nxt.pm * tstep : cA; const char* nB = has_next ? (const char*)g.Bt + (size_t)nxt.pn * tstep : cB;
        for (int t = 0; t < nt; t += 2) {
            const bool last = (t == nt - 2);
            const char* a1 = cA + (size_t)(t + 1) * kstep;
            const char* a2 = last ? nA : cA + (size_t)(t + 2) * kstep; const char* b2 = last ? nB : cB + (size_t)(t + 2) * kstep;
            const char* a3 = a2 + kstep; const char* b3 = b2 + kstep;
            if (last && has_next) S.a_ready(nxt);
            if constexpr (SP2) {
            PG8_LDB(B0, 0, 0); PG8_LDB(B1, 0, 1); PG8_SCHED; PG8_LDA(At, 0, 0); PG8_STAGE(PG8_SA(1, 1), a1 + hstep, voffA);
            PG8_WAIT_V(8); PG8_WAIT_L(0); PG8_BAR; PG8_MMA(0, 0, At, B0); PG8_MMA(0, 1, At, B1); PG8_BAR; PG8_SCHED;
            PG8_LDA(At, 0, 1); PG8_STAGE(PG8_SB(0, 0), b2, voffB); PG8_STAGE(PG8_SB(0, 1), b2 + hstep, voffB); PG8_STAGE(PG8_SA(0, 0), a2, voffA);
            PG8_WAIT_V(8); PG8_WAIT_L(0); PG8_BAR; PG8_MMA(1, 0, At, B0); PG8_MMA(1, 1, At, B1); PG8_BAR; PG8_SCHED;
            PG8_LDB(B0, 1, 0); PG8_LDB(B1, 1, 1); PG8_SCHED; PG8_LDA(At, 1, 0); PG8_STAGE(PG8_SA(0, 1), a2 + hstep, voffA);
            PG8_WAIT_V(8); PG8_WAIT_L(0); PG8_BAR; PG8_MMA(0, 0, At, B0); PG8_MMA(0, 1, At, B1); PG8_BAR; PG8_SCHED;
            PG8_LDA(At, 1, 1); PG8_STAGE(PG8_SB(1, 0), b3, voffB); PG8_STAGE(PG8_SB(1, 1), b3 + hstep, voffB); PG8_STAGE(PG8_SA(1, 0), a3, voffA);
            PG8_WAIT_V(8); PG8_WAIT_L(0); PG8_BAR; PG8_MMA(1, 0, At, B0); PG8_MMA(1, 1, At, B1); PG8_BAR; PG8_SCHED;
            } else {
            PG8_LDB(B0, 0, 0); PG8_SCHED; PG8_LDA(At, 0, 0); PG8_STAGE(PG8_SA(1, 1), a1 + hstep, voffA);
            PG8_WAIT_L(8); PG8_BAR; PG8_WAIT_L(0); PG8_MMA(0, 0, At, B0); PG8_BAR; PG8_SCHED;
            PG8_LDB(B1, 0, 1); PG8_STAGE(PG8_SB(0, 0), b2, voffB);
            PG8_BAR; PG8_WAIT_L(0); PG8_MMA(0, 1, At, B1); PG8_BAR;
            PG8_LDA(At, 0, 1); PG8_STAGE(PG8_SA(0, 0), a2, voffA);
            PG8_BAR; PG8_WAIT_L(0); PG8_MMA(1, 0, At, B0); PG8_BAR; PG8_SCHED;
            PG8_STAGE(PG8_SB(0, 1), b2 + hstep, voffB);
            PG8_WAIT_V(6); PG8_BAR; PG8_MMA(1, 1, At, B1); PG8_BAR;
            PG8_LDB(B0, 1, 0); PG8_SCHED; PG8_LDA(At, 1, 0); PG8_STAGE(PG8_SA(0, 1), a2 + hstep, voffA);
            PG8_WAIT_L(8); PG8_BAR; PG8_WAIT_L(0); PG8_MMA(0, 0, At, B0); PG8_BAR; PG8_SCHED;
            PG8_LDB(B1, 1, 1); PG8_STAGE(PG8_SB(1, 0), b3, voffB);
            PG8_BAR; PG8_WAIT_L(0); PG8_MMA(0, 1, At, B1); PG8_BAR;
            PG8_LDA(At, 1, 1); PG8_STAGE(PG8_SA(1, 0), a3, voffA);
            PG8_BAR; PG8_WAIT_L(0); PG8_MMA(1, 0, At, B0); PG8_BAR; PG8_SCHED;
            PG8_STAGE(PG8_SB(1, 1), b3 + hstep, voffB);
            PG8_WAIT_V(6); PG8_BAR; PG8_MMA(1, 1, At, B1); PG8_BAR;
            }
        }
        if constexpr (ALIGN_EPI) { if (wr == 0) PG8_BAR; }
        E(acc, cur, wr, wc, fr, fq); S.done(cur);
        if (!has_next) break;
#pragma unroll
        for (int a = 0; a < 2; ++a)
#pragma unroll
            for (int b = 0; b < 2; ++b)
#pragma unroll
                for (int m = 0; m < 4; ++m)
#pragma unroll
                    for (int n = 0; n < 2; ++n) acc[a][b][m][n] = (f32x4){0.f, 0.f, 0.f, 0.f};
        cur = nxt; cA = nA; cB = nB; ++ui;
        if constexpr (ALIGN_EPI) { if (wr == 1) PG8_BAR; }
    }
    PG8_WAIT_V(0);
    if constexpr (!ALIGN_EPI) { if (wr == 0) PG8_BAR; }
    PG8_BAR;
#undef PG8_SA
#undef PG8_SB
#undef PG8_STAGE
#undef PG8_LDA
#undef PG8_LDB
#undef PG8_MMA
#undef PG8_WAIT_V
#undef PG8_WAIT_L
#undef PG8_BAR
#undef PG8_SCHED
}
}

#ifndef DUPMASK
#define DUPMASK 0
#endif
#ifndef TMASK
#define TMASK 0
#endif
#ifndef UFMT
#define UFMT 4
#endif
#ifndef VFMT
#define VFMT 4
#endif
constexpr int NB = 2, SEQ = 8192, D = 1024, M = NB * SEQ;
constexpr int NPROJ = 2048, NIN = 2048, INLD = 2064;
constexpr int NUNIT = 1024;
constexpr int NEXP = 16384;
constexpr size_t MiB = 1u << 20;
constexpr size_t WS_CTL = 0, CTL_ZERO_BYTES = 64 * 1024;
constexpr size_t WS_MOD = 1 * MiB;
constexpr size_t WS_DEC = 1 * MiB + 512 * 1024;
constexpr size_t WS_WIN = 2 * MiB;
constexpr size_t WS_WOUT = 7 * MiB;
constexpr size_t WS_WQ = 9 * MiB;
constexpr size_t WS_KK = 13 * MiB;
constexpr size_t WS_IDX = 14 * MiB;
constexpr size_t WS_GATE = 22 * MiB;
constexpr size_t WS_LOGA = 30 * MiB;
constexpr size_t WS_KV = 46 * MiB;
constexpr size_t WS_H = 78 * MiB;
constexpr size_t WS_U8 = 110 * MiB;
constexpr size_t WS_V8 = 126 * MiB;
constexpr size_t WS_SU = 142 * MiB;
constexpr size_t WS_SV = 142 * MiB + 65536;
constexpr size_t WS_PROJ = 174 * MiB;
constexpr size_t WS_END = 238 * MiB;
constexpr int CW_BAR = 1024;
constexpr int NWAVES = 8, NTHR = 512;
constexpr int LDS_BYTES = 147456, MISC_OFF = 147456 - 256;

#define XB_TMO      128
#define XB_XCNT(j)  (256  + 64 * (j))
#define XB_XSUB(j)  (1280 + 64 * (j))
#define XB_XGEN(j)  (2304 + 64 * (j))
#define XB_TOP      3328
#define XB_TOPGEN   3392
#define XCD_BAR_WORDS 3456
#define XB_SPIN_CAP (1u << 20)
__device__ __forceinline__ unsigned xb_ld(unsigned* p)              { return __hip_atomic_load(p, __ATOMIC_RELAXED, __HIP_MEMORY_SCOPE_AGENT); }
__device__ __forceinline__ unsigned xb_add(unsigned* p, unsigned v) { return __hip_atomic_fetch_add(p, v, __ATOMIC_RELAXED, __HIP_MEMORY_SCOPE_AGENT); }
__device__ __forceinline__ unsigned xb_xcc_id() { return (unsigned)__builtin_amdgcn_s_getreg((3 << 11) | 20) & 0xFu; }
#define XB_SPIN(cond, bar) do { unsigned _sp = 0; while (cond) { __builtin_amdgcn_s_sleep(1); \
    if ((++_sp & 255u) == 0u) { if (xb_ld(&(bar)[XB_TMO])) break; if (_sp > XB_SPIN_CAP) { atomicAdd(&(bar)[XB_TMO], 1u); break; } } } } while (0)
struct XcdBarrier { unsigned* bar; unsigned x; volatile LAS unsigned* st; };
__device__ __forceinline__ XcdBarrier xcd_barrier_post(unsigned* bar, volatile LAS unsigned* st) {
    XcdBarrier b; b.bar = bar; b.x = xb_xcc_id(); b.st = st;
    if (threadIdx.x == 0) (void)xb_add(&bar[XB_XCNT(b.x)], 1u);
    return b;
}
__device__ __forceinline__ void xcd_barrier_complete(unsigned* bar, unsigned x, unsigned& nloc, unsigned& nx) {
    const unsigned G = gridDim.x * gridDim.y * gridDim.z;
    unsigned sum, cnt, mine, sp = 0u;
    for (;;) {
        sum = 0u; cnt = 0u; mine = 0u;
#pragma unroll
        for (unsigned j = 0; j < 16; ++j) { const unsigned c = xb_ld(&bar[XB_XCNT(j)]); sum += c; cnt += (c > 0u) ? 1u : 0u; mine = (j == x) ? c : mine; }
        if (sum == G) break;
        __builtin_amdgcn_s_sleep(1);
        if ((++sp & 255u) == 0u) { if (xb_ld(&bar[XB_TMO])) break; if (sp > XB_SPIN_CAP) { atomicAdd(&bar[XB_TMO], 1u); break; } }
    }
    nloc = mine > 0u ? mine : 1u; nx = cnt > 0u ? cnt : 1u;
}
__device__ __forceinline__ void xcd_barrier(const XcdBarrier& b) {
    asm volatile("s_waitcnt vmcnt(0)" ::: "memory");
    __syncthreads();
    if (threadIdx.x == 0) {
        unsigned* bar = b.bar;
        __builtin_amdgcn_s_waitcnt(0);
        unsigned nloc = b.st[0], nx = b.st[1];
        if (nloc == 0u) { xcd_barrier_complete(bar, b.x, nloc, nx); b.st[0] = nloc; b.st[1] = nx; }
        const unsigned old = xb_add(&bar[XB_XSUB(b.x)], 1u);
        const unsigned gen = old / nloc;
        if (old + 1u == (gen + 1u) * nloc) {
            __builtin_amdgcn_fence(__ATOMIC_RELEASE, "agent");
            asm volatile("s_waitcnt vmcnt(0)" ::: "memory");
            const unsigned og = xb_add(&bar[XB_TOP], 1u);
            const unsigned tg = og / nx;
            if (og + 1u == (tg + 1u) * nx) xb_add(&bar[XB_TOPGEN], 1u);
            else XB_SPIN(xb_ld(&bar[XB_TOPGEN]) == tg, bar);
            __builtin_amdgcn_fence(__ATOMIC_ACQUIRE, "agent");
            xb_add(&bar[XB_XGEN(b.x)], 1u);
            asm volatile("s_waitcnt vmcnt(0)" ::: "memory");
        } else {
            XB_SPIN(xb_ld(&bar[XB_XGEN(b.x)]) == gen, bar);
            __builtin_amdgcn_fence(__ATOMIC_ACQUIRE, "agent");
            asm volatile("s_waitcnt vmcnt(0)" ::: "memory");
        }
    }
    __syncthreads();
}

__device__ __forceinline__ unsigned f2bf(float f) { unsigned u = __builtin_bit_cast(unsigned, f); return (u + 0x7fffu + ((u >> 16) & 1u)) >> 16; }
__device__ __forceinline__ unsigned pk2(float lo, float hi) { return f2bf(lo) | (f2bf(hi) << 16); }
__device__ __forceinline__ float bflo(unsigned w) { return __builtin_bit_cast(float, w << 16); }
__device__ __forceinline__ float bfhi(unsigned w) { return __builtin_bit_cast(float, w & 0xffff0000u); }
__device__ __forceinline__ float wave_sum(float v) {
#pragma unroll
    for (int o = 1; o < 64; o <<= 1) v += __shfl_xor(v, o);
    return v;
}
__device__ __forceinline__ float silu_f(float x) { return x / (1.f + __expf(-x)); }
__device__ __forceinline__ float logsig_f(float x) { return fminf(x, 0.f) - log1pf(__expf(-fabsf(x))); }
__device__ __forceinline__ float gelu_f(float x) { return 0.5f * x * (1.f + erff(x * 0.70710678118654752f)); }

template <int FMT> struct RowVec { u32x4 w; };
template <> struct RowVec<4> { u32x2 w; };
template <int FMT> __device__ __forceinline__ RowVec<FMT> row_load(const unsigned char* tab, int eid, int lane) {
    RowVec<FMT> r;
    if constexpr (FMT == 4) r.w = *(const u32x2*)(tab + (size_t)eid * 512 + 8 * lane); else r.w = *(const u32x4*)(tab + (size_t)eid * 1024 + 16 * lane);
    return r;
}
template <int FMT> __device__ __forceinline__ void row_decode(const RowVec<FMT>& r, float (&f)[16]) {
    if constexpr (FMT == 4) {
        const unsigned w[2] = {r.w.x, r.w.y};
#pragma unroll
        for (int k = 0; k < 2; ++k) {
            const f32x2 p0 = __builtin_amdgcn_cvt_scalef32_pk_f32_fp4(w[k], 1.0f, 0), p1 = __builtin_amdgcn_cvt_scalef32_pk_f32_fp4(w[k], 1.0f, 1);
            const f32x2 p2 = __builtin_amdgcn_cvt_scalef32_pk_f32_fp4(w[k], 1.0f, 2), p3 = __builtin_amdgcn_cvt_scalef32_pk_f32_fp4(w[k], 1.0f, 3);
            f[8 * k] = p0.x; f[8 * k + 1] = p0.y; f[8 * k + 2] = p1.x; f[8 * k + 3] = p1.y; f[8 * k + 4] = p2.x; f[8 * k + 5] = p2.y; f[8 * k + 6] = p3.x; f[8 * k + 7] = p3.y; }
    } else {
        const unsigned w[4] = {r.w.x, r.w.y, r.w.z, r.w.w};
#pragma unroll
        for (int k = 0; k < 4; ++k) { const f32x2 lo = __builtin_amdgcn_cvt_pk_f32_fp8((int)w[k], false), hi = __builtin_amdgcn_cvt_pk_f32_fp8((int)w[k], true);
            f[4 * k] = lo.x; f[4 * k + 1] = lo.y; f[4 * k + 2] = hi.x; f[4 * k + 3] = hi.y; }
    }
}

template <int UF, int VF> __device__ __forceinline__ void peer_chunk_load(RowVec<UF> (&uu)[8], RowVec<VF> (&vv)[8], const unsigned char* U8, const unsigned char* V8, int idr, int c8, int lane) {
#pragma unroll
    for (int q = 0; q < 8; ++q) { const int eid = __builtin_amdgcn_readlane(idr, c8 + q); uu[q] = row_load<UF>(U8, eid, lane); vv[q] = row_load<VF>(V8, eid, lane); }
}
template <int UF, int VF> __device__ __forceinline__ void peer_chunk_compute(const RowVec<UF> (&uu)[8], const RowVec<VF> (&vv)[8], const float (&hf)[16], float (&o)[16], float zs, float as, int c8, int lane) {
    float z[8];
#pragma unroll
    for (int q = 0; q < 8; ++q) { float f[16]; row_decode<UF>(uu[q], f); float a0 = 0.f, a1 = 0.f;
#pragma unroll
        for (int k = 0; k < 8; ++k) { a0 += hf[2 * k] * f[2 * k]; a1 += hf[2 * k + 1] * f[2 * k + 1]; }
        z[q] = a0 + a1; }
    float r1[4], r2[2], r3;
#pragma unroll
    for (int k = 0; k < 4; ++k) { const bool hi1 = lane & 1; const float keep = hi1 ? z[2 * k + 1] : z[2 * k], send = hi1 ? z[2 * k] : z[2 * k + 1]; r1[k] = keep + __shfl_xor(send, 1); }
#pragma unroll
    for (int k = 0; k < 2; ++k) { const bool hi1 = lane & 2; const float keep = hi1 ? r1[2 * k + 1] : r1[2 * k], send = hi1 ? r1[2 * k] : r1[2 * k + 1]; r2[k] = keep + __shfl_xor(send, 2); }
    { const bool hi1 = lane & 4; const float keep = hi1 ? r2[1] : r2[0], send = hi1 ? r2[0] : r2[1]; r3 = keep + __shfl_xor(send, 4); }
    r3 += __shfl_xor(r3, 8); r3 += __shfl_xor(r3, 16); r3 += __shfl_xor(r3, 32);
    const float act = gelu_f(r3 * zs) * as;
#pragma unroll
    for (int q = 0; q < 8; ++q) { const float a = __builtin_bit_cast(float, __builtin_amdgcn_readlane(__builtin_bit_cast(int, act), c8 + q));
        float f[16]; row_decode<VF>(vv[q], f);
#pragma unroll
        for (int k = 0; k < 16; ++k) o[k] += a * f[k]; }
}

typedef _Float16 h2_t __attribute__((ext_vector_type(2)));
template <int CTRL> __device__ __forceinline__ float dppf(float v) { return __builtin_bit_cast(float, __builtin_amdgcn_update_dpp(0, __builtin_bit_cast(int, v), CTRL, 0xF, 0xF, true)); }
__device__ __forceinline__ void peer_chunk_compute4(const RowVec<4> (&uu)[8], const RowVec<4> (&vv)[8], const int (&hq)[4], h2_t (&o2)[8], float zs, float as64, int c8, int lane) {
    float z[8];
#pragma unroll
    for (int q = 0; q < 8; ++q) { const int w0 = (int)uu[q].w.x, w1 = (int)uu[q].w.y;
        int ah = __builtin_amdgcn_sdot8(w0, hq[0], 0, false); ah = __builtin_amdgcn_sdot8(w1, hq[1], ah, false);
        int al = __builtin_amdgcn_sdot8(w0, hq[2], 0, false); al = __builtin_amdgcn_sdot8(w1, hq[3], al, false);
        z[q] = (float)(ah * 16 + al); }
    float r1[4], r2[2], r3;
#pragma unroll
    for (int k = 0; k < 4; ++k) { const bool hi1 = lane & 1; const float keep = hi1 ? z[2 * k + 1] : z[2 * k], send = hi1 ? z[2 * k] : z[2 * k + 1]; r1[k] = keep + dppf<0xB1>(send); }
#pragma unroll
    for (int k = 0; k < 2; ++k) { const bool hi1 = lane & 2; const float keep = hi1 ? r1[2 * k + 1] : r1[2 * k], send = hi1 ? r1[2 * k] : r1[2 * k + 1]; r2[k] = keep + dppf<0x4E>(send); }
    { const bool hi1 = lane & 4; const float keep = hi1 ? r2[1] : r2[0], send = hi1 ? r2[0] : r2[1]; r3 = keep + dppf<0x124>(send); }
    r3 += dppf<0x128>(r3); r3 += __shfl_xor(r3, 16); r3 += __shfl_xor(r3, 32);
    const float act = gelu_f(r3 * zs) * as64;
#pragma unroll
    for (int q = 0; q < 8; ++q) { const float a = __builtin_bit_cast(float, __builtin_amdgcn_readlane(__builtin_bit_cast(int, act), c8 + q));
        const _Float16 ah = (_Float16)a; const h2_t a2 = {ah, ah}; const unsigned w0 = vv[q].w.x, w1 = vv[q].w.y;
        o2[0] = __builtin_amdgcn_cvt_scalef32_pk_f16_fp4(w0, 1.0f, 0) * a2 + o2[0]; o2[1] = __builtin_amdgcn_cvt_scalef32_pk_f16_fp4(w0, 1.0f, 1) * a2 + o2[1];
        o2[2] = __builtin_amdgcn_cvt_scalef32_pk_f16_fp4(w0, 1.0f, 2) * a2 + o2[2]; o2[3] = __builtin_amdgcn_cvt_scalef32_pk_f16_fp4(w0, 1.0f, 3) * a2 + o2[3];
        o2[4] = __builtin_amdgcn_cvt_scalef32_pk_f16_fp4(w1, 1.0f, 0) * a2 + o2[4]; o2[5] = __builtin_amdgcn_cvt_scalef32_pk_f16_fp4(w1, 1.0f, 1) * a2 + o2[5];
        o2[6] = __builtin_amdgcn_cvt_scalef32_pk_f16_fp4(w1, 1.0f, 2) * a2 + o2[6]; o2[7] = __builtin_amdgcn_cvt_scalef32_pk_f16_fp4(w1, 1.0f, 3) * a2 + o2[7]; }
}

struct Params { const float* in[19]; float* out; unsigned char* ws; int ph_lo, ph_hi; };

struct EpiProj {
    static constexpr bool PERM = true;
    bf16_t* P; float* LA; const float* gb;
    __device__ __forceinline__ void operator()(const f32x4 (&acc)[2][2][4][2], const pg8::Unit& u, int wr, int wc, int fr, int fq) const {
        const int row0 = u.pm * 256 + wr * 64 + fr;
        if (u.pn < 8) {
            const int col0 = u.pn * 256 + wc * 32 + 8 * fq;
#pragma unroll
            for (int ai = 0; ai < 2; ++ai)
#pragma unroll
                for (int m = 0; m < 4; ++m) { bf16_t* rowp = P + (size_t)(row0 + ai * 128 + m * 16) * NPROJ + col0;
#pragma unroll
                    for (int bj = 0; bj < 2; ++bj) { const f32x4 v0 = acc[ai][bj][m][0], v1 = acc[ai][bj][m][1];
                        u32x4 w; w.x = pg8::cvt_pk_bf16(v0[0], v0[1]); w.y = pg8::cvt_pk_bf16(v0[2], v0[3]); w.z = pg8::cvt_pk_bf16(v1[0], v1[1]); w.w = pg8::cvt_pk_bf16(v1[2], v1[3]);
                        *(u32x4*)(rowp + bj * 128) = w; } }
        } else {
            const int col0 = wc * 32 + 8 * fq;
            f32x4 bv[2][2];
#pragma unroll
            for (int bj = 0; bj < 2; ++bj)
#pragma unroll
                for (int n = 0; n < 2; ++n) bv[bj][n] = *(const f32x4*)(gb + col0 + bj * 128 + 4 * n);
#pragma unroll
            for (int ai = 0; ai < 2; ++ai)
#pragma unroll
                for (int m = 0; m < 4; ++m) { float* rowp = LA + (size_t)(row0 + ai * 128 + m * 16) * 256 + col0;
#pragma unroll
                    for (int bj = 0; bj < 2; ++bj)
#pragma unroll
                        for (int n = 0; n < 2; ++n) { const f32x4 v = acc[ai][bj][m][n] + bv[bj][n]; f32x4 o;
#pragma unroll
                            for (int j = 0; j < 4; ++j) o[j] = logsig_f(v[j]) * (1.0f / 16.0f);
                            *(f32x4*)(rowp + bj * 128 + 4 * n) = o; } }
        }
    }
};
struct EpiX1 {
    static constexpr bool PERM = false;
    const float* x; float* X1; const float* gate;
    __device__ __forceinline__ void operator()(const f32x4 (&acc)[2][2][4][2], const pg8::Unit& u, int wr, int wc, int fr, int fq) const {
        const int row0 = u.pm * 256 + wr * 64 + fr, col0 = u.pn * 256 + wc * 32 + 4 * fq;
        const float* gp = gate + (u.pm >= 32 ? 6144 : 0);
        f32x4 gv[2][2];
#pragma unroll
        for (int bj = 0; bj < 2; ++bj)
#pragma unroll
            for (int n = 0; n < 2; ++n) gv[bj][n] = *(const f32x4*)(gp + col0 + bj * 128 + n * 16);
#pragma unroll
        for (int ai = 0; ai < 2; ++ai)
#pragma unroll
            for (int m = 0; m < 4; ++m) { const size_t ro = (size_t)(row0 + ai * 128 + m * 16) * D + col0;
#pragma unroll
                for (int bj = 0; bj < 2; ++bj)
#pragma unroll
                    for (int n = 0; n < 2; ++n) { const f32x4 xv = *(const f32x4*)(x + ro + bj * 128 + n * 16);
                        *(f32x4*)(X1 + ro + bj * 128 + n * 16) = xv + gv[bj][n] * acc[ai][bj][m][n]; } }
    }
};
struct EpiQ {
    static constexpr bool PERM = true;
    bf16_t* Q;
    __device__ __forceinline__ void operator()(const f32x4 (&acc)[2][2][4][2], const pg8::Unit& u, int wr, int wc, int fr, int fq) const {
        const int row0 = u.pm * 256 + wr * 64 + fr, col0 = u.pn * 256 + wc * 32 + 8 * fq;
#pragma unroll
        for (int ai = 0; ai < 2; ++ai)
#pragma unroll
            for (int m = 0; m < 4; ++m) { bf16_t* rowp = Q + (size_t)(row0 + ai * 128 + m * 16) * 2048 + col0;
#pragma unroll
                for (int bj = 0; bj < 2; ++bj) { const f32x4 v0 = acc[ai][bj][m][0], v1 = acc[ai][bj][m][1];
                    u32x4 w; w.x = pg8::cvt_pk_bf16(v0[0], v0[1]); w.y = pg8::cvt_pk_bf16(v0[2], v0[3]); w.z = pg8::cvt_pk_bf16(v1[0], v1[1]); w.w = pg8::cvt_pk_bf16(v1[2], v1[3]);
                    *(u32x4*)(rowp + bj * 128) = w; } }
    }
};

__device__ __forceinline__ void transpose_item(const float* W, int ldw, int k0, int n0, bf16_t* WT, int ldt, int row0, LAS float* scr, int lane) {
#pragma unroll 8
    for (int i = 0; i < 32; ++i) { const int kk = 2 * i + (lane >> 5); scr[kk * 33 + (lane & 31)] = W[(size_t)(k0 + kk) * ldw + n0 + (lane & 31)]; }
    asm volatile("s_waitcnt lgkmcnt(0)" ::: "memory");
    const int c = lane & 7;
#pragma unroll
    for (int j = 0; j < 4; ++j) { const int n = (lane >> 3) + 8 * j; const LAS float* s = scr + (8 * c) * 33 + n;
        u32x4 o; o.x = pk2(s[0 * 33], s[1 * 33]); o.y = pk2(s[2 * 33], s[3 * 33]); o.z = pk2(s[4 * 33], s[5 * 33]); o.w = pk2(s[6 * 33], s[7 * 33]);
        *(u32x4*)(WT + (size_t)(row0 + n0 + n) * ldt + k0 + 8 * c) = o; }
    asm volatile("s_waitcnt lgkmcnt(0)" ::: "memory");
}

template <int NR> __device__ __forceinline__ void norm_mod_rows(const float* xbase, int m0, int mstride, const float* g, const float* MODp, int modoff, bf16_t* obase, int lane) {
    f32x4 v[NR][4]; float s[NR];
#pragma unroll
    for (int a = 0; a < NR; ++a) { const float* xrow = xbase + (size_t)(m0 + a * mstride) * D;
#pragma unroll
        for (int j = 0; j < 4; ++j) v[a][j] = *(const f32x4*)(xrow + 4 * lane + 256 * j); }
#pragma unroll
    for (int a = 0; a < NR; ++a) { s[a] = 0.f;
#pragma unroll
        for (int j = 0; j < 4; ++j) s[a] += (v[a][j].x * v[a][j].x + v[a][j].y * v[a][j].y) + (v[a][j].z * v[a][j].z + v[a][j].w * v[a][j].w); }
#pragma unroll
    for (int o = 1; o < 64; o <<= 1)
#pragma unroll
        for (int a = 0; a < NR; ++a) s[a] += __shfl_xor(s[a], o);
#pragma unroll
    for (int a = 0; a < NR; ++a) { const int m = m0 + a * mstride; const float rstd = 1.f / sqrtf(s[a] * (1.f / D) + 1e-6f);
        const float* shift = MODp + (m >= SEQ ? 6144 : 0) + modoff; const float* scale = shift + 1024; bf16_t* orow = obase + (size_t)m * D;
#pragma unroll
        for (int j = 0; j < 4; ++j) { const int c = 4 * lane + 256 * j;
            const f32x4 gg = *(const f32x4*)(g + c), sh = *(const f32x4*)(shift + c), sc = *(const f32x4*)(scale + c);
            const f32x4 y = v[a][j] * rstd * gg * (sc + 1.0f) + sh;
            u32x2 o; o.x = pk2(y.x, y.y); o.y = pk2(y.z, y.w);
            *(u32x2*)(orow + c) = o; } }
}

__constant__ unsigned char CAND_IJ[64] = {
    0x00,0x01,0x02,0x03,0x04,0x05,0x06,0x07,0x08,0x09,0x0a,0x0b,0x0c,0x0d,0x0e,0x0f,
    0x10,0x11,0x12,0x13,0x14,0x15,0x16,0x17,
    0x20,0x21,0x22,0x23,0x24,
    0x30,0x31,0x32,0x33,
    0x40,0x41,0x42,
    0x50,0x51, 0x60,0x61, 0x70,0x71,
    0x80,0x90,0xa0,0xb0,0xc0,0xd0,0xe0,0xf0,
    0,0,0,0,0,0,0,0,0,0,0,0,0,0};

__device__ __forceinline__ unsigned fkey(float f, unsigned idbits, unsigned idmask) {
    unsigned u = __builtin_bit_cast(unsigned, f); u = (u & 0x80000000u) ? ~u : (u | 0x80000000u);
    return (u & ~idmask) | idbits;
}
__device__ __forceinline__ float fkey_val(unsigned key, unsigned idmask) {
    unsigned u = key & ~idmask; u = (u & 0x80000000u) ? (u ^ 0x80000000u) : ~u;
    return __builtin_bit_cast(float, u);
}
template <int CTRL, int ROWMASK> __device__ __forceinline__ unsigned dpp_u(unsigned v) { return (unsigned)__builtin_amdgcn_update_dpp(0, (int)v, CTRL, ROWMASK, 0xF, true); }
template <int CTRL, int ROWMASK> __device__ __forceinline__ float dpp_f(float v) { return __builtin_bit_cast(float, __builtin_amdgcn_update_dpp(0, __builtin_bit_cast(int, v), CTRL, ROWMASK, 0xF, true)); }
__device__ __forceinline__ unsigned umax_(unsigned a, unsigned b) { return a > b ? a : b; }
__device__ __forceinline__ unsigned umin_(unsigned a, unsigned b) { return a < b ? a : b; }
template <int N> __device__ __forceinline__ unsigned ror_u(unsigned v) { return (unsigned)__builtin_amdgcn_update_dpp(0, (int)v, 0x120 + N, 0xF, 0xF, true); }
template <int N> __device__ __forceinline__ float ror_f(float v) { return __builtin_bit_cast(float, __builtin_amdgcn_update_dpp(0, __builtin_bit_cast(int, v), 0x120 + N, 0xF, 0xF, true)); }
__device__ __forceinline__ unsigned row_allmax(unsigned m) { m = umax_(m, ror_u<1>(m)); m = umax_(m, ror_u<2>(m)); m = umax_(m, ror_u<4>(m)); m = umax_(m, ror_u<8>(m)); return m; }
__device__ __forceinline__ float row_allsum(float m) { m += ror_f<1>(m); m += ror_f<2>(m); m += ror_f<4>(m); m += ror_f<8>(m); return m; }

__global__ void __launch_bounds__(NTHR, 2) fwd_kernel(Params p) {
    extern __shared__ __attribute__((aligned(16))) unsigned char lds_raw[];
    LAS unsigned char* lds = (LAS unsigned char*)lds_raw;
    const int tid = threadIdx.x, lane = tid & 63, wave = __builtin_amdgcn_readfirstlane(tid >> 6);
    const int G = gridDim.x, bx = blockIdx.x;
    const int gw = bx * NWAVES + wave, NGW = G * NWAVES;
    unsigned char* ws = p.ws;
    unsigned* ctl = (unsigned*)(ws + WS_CTL);
    float* MOD = (float*)(ws + WS_MOD);
    float* DEC = (float*)(ws + WS_DEC);
    bf16_t* WIN = (bf16_t*)(ws + WS_WIN);
    bf16_t* WOUT = (bf16_t*)(ws + WS_WOUT);
    bf16_t* WQ = (bf16_t*)(ws + WS_WQ);
    bf16_t* KK = (bf16_t*)(ws + WS_KK);
    int* IDX = (int*)(ws + WS_IDX);
    float* GATE = (float*)(ws + WS_GATE);
    float* LOGA = (float*)(ws + WS_LOGA);
    float* KV = (float*)(ws + WS_KV);
    bf16_t* H = (bf16_t*)(ws + WS_H);
    unsigned char* U8 = ws + WS_U8;
    unsigned char* V8 = ws + WS_V8;
    float* SU = (float*)(ws + WS_SU);
    float* SV = (float*)(ws + WS_SV);
    bf16_t* PROJ = (bf16_t*)(ws + WS_PROJ);
    const float* x = p.in[0]; const float* cvec = p.in[1]; const float* ada_w = p.in[2]; const float* ada_b = p.in[3]; const float* norm1_g = p.in[4];
    const float* w_in = p.in[5]; const float* gate_w = p.in[6]; const float* gate_b = p.in[7]; const float* gla_norm_g = p.in[8];
    const float* pool_w = p.in[9]; const float* pool_scale = p.in[10]; const float* w_out = p.in[11]; const float* norm2_g = p.in[12];
    const float* peer_wq = p.in[13]; const float* peer_k1 = p.in[14]; const float* peer_k2 = p.in[15]; const float* peer_u = p.in[16]; const float* peer_v = p.in[17];
    const float* final_g = p.in[18];
    float* X1 = p.out;

    volatile LAS unsigned* MISC = (volatile LAS unsigned*)(lds + MISC_OFF);
    if (tid < 64) MISC[tid] = 0u;
    __syncthreads();
    XcdBarrier bar = xcd_barrier_post(ctl + CW_BAR, MISC + 8);
    const int lo = p.ph_lo, hi = p.ph_hi;
#define IN(k) (lo <= (k) && (k) < hi)
#define REP(k) for (int rep_ = 0; rep_ < 1 + ((DUPMASK >> (k)) & 1); ++rep_)
#define STAMP(i) do { if (TMASK && wave == 0) { unsigned long long t_; asm volatile("s_memrealtime %0\n\ts_waitcnt lgkmcnt(0)" : "=s"(t_) :: "memory"); if (tid == 0) ((volatile LAS unsigned long long*)(lds + MISC_OFF + 64))[i] = t_; } } while (0)
#define SEAM(k) do { if (IN(k) && IN((k) + 1)) xcd_barrier(bar); STAMP((k) + 1); } while (0)
    STAMP(0);

    if (IN(0)) REP(0) {
        {
            LAS float* sc = (LAS float*)lds;
            LAS f32x4* red = (LAS f32x4*)(lds + 8192);
            for (int i = tid; i < 2048; i += NTHR) sc[i] = silu_f(cvec[i]);
            __syncthreads();
            for (int cb = bx; cb < 256; cb += G) {
                if (tid < 384) {
                    const int f4 = tid % 6, rg = tid / 6;
                    f32x4 a0 = {0.f, 0.f, 0.f, 0.f}, a1 = {0.f, 0.f, 0.f, 0.f};
#pragma unroll 4
                    for (int i = 0; i < 16; ++i) { const int r = rg + 64 * i; const f32x4 w = *(const f32x4*)(ada_w + (size_t)r * 6144 + 24 * cb + 4 * f4);
                        a0 += w * sc[r]; a1 += w * sc[1024 + r]; }
                    red[(rg * 6 + f4) * 2 + 0] = a0; red[(rg * 6 + f4) * 2 + 1] = a1;
                }
                __syncthreads();
                if (tid < 48) { const int b = tid / 24, col = tid % 24; float s = 0.f;
                    for (int rg = 0; rg < 64; ++rg) s += red[(rg * 6 + (col >> 2)) * 2 + b][col & 3];
                    MOD[b * 6144 + 24 * cb + col] = s + ada_b[24 * cb + col]; }
                __syncthreads();
            }
        }
        for (int it = bx; it < 128; it += G) {
            const int g = it >> 5, nb = (it >> 1) & 15, cb = it & 1;
            LAS float* PW = (LAS float*)lds;
            LAS float* WO = (LAS float*)(lds + 32768);
            for (int i = tid; i < 64 * 128; i += NTHR) { const int c = i >> 7, j = i & 127; PW[i] = pool_w[(size_t)(g * 128 + cb * 64 + c) * 128 + j] * pool_scale[g * 128 + j]; }
            for (int i = tid; i < 128 * 64; i += NTHR) { const int j = i >> 6, n = i & 63; WO[i] = w_out[(size_t)(512 + g * 128 + j) * 1024 + nb * 64 + n]; }
            __syncthreads();
            const int n = tid & 63, cg = tid >> 6;
            float a[8];
#pragma unroll
            for (int q = 0; q < 8; ++q) a[q] = 0.f;
            for (int j = 0; j < 128; ++j) { const float wo = WO[j * 64 + n];
#pragma unroll
                for (int q = 0; q < 8; ++q) a[q] += PW[(cg * 8 + q) * 128 + j] * wo; }
            u32x4 o; o.x = pk2(a[0], a[1]); o.y = pk2(a[2], a[3]); o.z = pk2(a[4], a[5]); o.w = pk2(a[6], a[7]);
            *(u32x4*)(WOUT + (size_t)(nb * 64 + n) * 1024 + 512 + g * 128 + cb * 64 + cg * 8) = o;
            __syncthreads();
        }
        {
            LAS float* scr = (LAS float*)(lds + wave * 16384);
            constexpr int I_IN = 16 * 64, I_Q = 16 * 64, I_O = 8 * 32;
            for (int it = gw; it < I_IN + I_Q + I_O; it += NGW) {
                int r = it;
                if (r < I_IN) { transpose_item(w_in, INLD, (r >> 6) * 64, (r & 63) * 32, WIN, 1024, 0, scr, lane); continue; } r -= I_IN;
                if (r < I_Q) { transpose_item(peer_wq, 2048, (r >> 6) * 64, (r & 63) * 32, WQ, 1024, 0, scr, lane); continue; } r -= I_Q;
                transpose_item(w_out, 1024, (r >> 5) * 64, (r & 31) * 32, WOUT, 1024, 0, scr, lane);
            }
        }
        for (int i = bx * NTHR + tid; i < 2 * 128 * 128; i += G * NTHR) KK[i] = (bf16_t)f2bf(i < 16384 ? peer_k1[i] : peer_k2[i - 16384]);
    }
    SEAM(0);

    if (IN(1)) REP(1) {
        LAS u32x4* WAPL = (LAS u32x4*)lds;
        LAS float* GWL = (LAS float*)(lds + 32768);
        for (int i = tid; i < 16 * 256; i += NTHR) GWL[i] = gate_w[i];
        {
            const int q = wave >> 1, jb = 2 * (wave & 1);
            unsigned wp[2][8];
#pragma unroll
            for (int p8 = 0; p8 < 8; ++p8) { const int k0 = 4 * lane + 256 * (p8 >> 1) + 2 * (p8 & 1);
                const float* w0 = w_in + (size_t)k0 * INLD + 2048 + 4 * q; const float* w1 = w0 + INLD;
                const f32x4 a = *(const f32x4*)w0, b = *(const f32x4*)w1;
                wp[0][p8] = jb ? pk2(a[2], b[2]) : pk2(a[0], b[0]); wp[1][p8] = jb ? pk2(a[3], b[3]) : pk2(a[1], b[1]); }
#pragma unroll
            for (int j = 0; j < 2; ++j) { const int r = 4 * q + jb + j;
                WAPL[(r * 2 + 0) * 64 + lane] = (u32x4){wp[j][0], wp[j][1], wp[j][2], wp[j][3]}; WAPL[(r * 2 + 1) * 64 + lane] = (u32x4){wp[j][4], wp[j][5], wp[j][6], wp[j][7]}; }
        }
        const f32x4 gb4 = *(const f32x4*)(gate_b + 4 * lane);
        __syncthreads();
        for (int m = gw; m < M; m += NGW) {
            f32x4 v[4]; float ssq = 0.f;
            { const float* xrow = x + (size_t)m * D;
#pragma unroll
                for (int j = 0; j < 4; ++j) { v[j] = *(const f32x4*)(xrow + 4 * lane + 256 * j); ssq += (v[j].x * v[j].x + v[j].y * v[j].y) + (v[j].z * v[j].z + v[j].w * v[j].w); } }
#pragma unroll
            for (int o = 1; o < 64; o <<= 1) ssq += __shfl_xor(ssq, o);
            { const float rstd = 1.f / sqrtf(ssq * (1.f / D) + 1e-6f);
                const float* shift = MOD + (m >= SEQ ? 6144 : 0); const float* scale = shift + 1024; bf16_t* orow = H + (size_t)m * D;
                unsigned yp[8];
#pragma unroll
                for (int j = 0; j < 4; ++j) { const int c = 4 * lane + 256 * j;
                    const f32x4 gg = *(const f32x4*)(norm1_g + c), sh = *(const f32x4*)(shift + c), sc = *(const f32x4*)(scale + c);
                    const f32x4 y = v[j] * rstd * gg * (sc + 1.0f) + sh;
                    yp[2 * j] = pk2(y.x, y.y); yp[2 * j + 1] = pk2(y.z, y.w);
                    u32x2 o; o.x = yp[2 * j]; o.y = yp[2 * j + 1];
                    *(u32x2*)(orow + c) = o; }
                float part[16];
                int wlo = lane; asm volatile("" : "+v"(wlo));
#pragma unroll
                for (int r = 0; r < 16; ++r) { const u32x4 wa = WAPL[(r * 2 + 0) * 64 + wlo], wb = WAPL[(r * 2 + 1) * 64 + wlo]; const unsigned wr[8] = {wa.x, wa.y, wa.z, wa.w, wb.x, wb.y, wb.z, wb.w};
                    float acc = 0.f;
#pragma unroll
                    for (int p8 = 0; p8 < 8; ++p8) acc = __builtin_amdgcn_fdot2_f32_bf16(__builtin_bit_cast(bf16x2_t, yp[p8]), __builtin_bit_cast(bf16x2_t, wr[p8]), acc, false);
                    part[r] = acc;
                    if ((r & 3) == 3) asm volatile("" ::: "memory"); }
                float r1[8], r2[4], r3[2], r4;
#pragma unroll
                for (int k = 0; k < 8; ++k) { const bool hi1 = lane & 1; const float keep = hi1 ? part[2 * k + 1] : part[2 * k], send = hi1 ? part[2 * k] : part[2 * k + 1]; r1[k] = keep + dppf<0xB1>(send); }
#pragma unroll
                for (int k = 0; k < 4; ++k) { const bool hi1 = lane & 2; const float keep = hi1 ? r1[2 * k + 1] : r1[2 * k], send = hi1 ? r1[2 * k] : r1[2 * k + 1]; r2[k] = keep + dppf<0x4E>(send); }
#pragma unroll
                for (int k = 0; k < 2; ++k) { const bool hi1 = lane & 4; const float keep = hi1 ? r2[2 * k + 1] : r2[2 * k], send = hi1 ? r2[2 * k] : r2[2 * k + 1]; r3[k] = keep + dppf<0x124>(send); }
                { const bool hi1 = lane & 8; const float keep = hi1 ? r3[1] : r3[0], send = hi1 ? r3[0] : r3[1]; r4 = keep + dppf<0x128>(send); }
                r4 += __shfl_xor(r4, 16); r4 += __shfl_xor(r4, 32);
                f32x4 lg = gb4;
                int gwo = 4 * lane; asm volatile("" : "+v"(gwo));
#pragma unroll
                for (int r = 0; r < 16; ++r) { const float ar = __builtin_bit_cast(float, __builtin_amdgcn_readlane(__builtin_bit_cast(int, r4), r)); lg += *(const LAS f32x4*)(GWL + r * 256 + gwo) * ar; }
                f32x4 lo;
#pragma unroll
                for (int j = 0; j < 4; ++j) lo[j] = logsig_f(lg[j]) * (1.0f / 16.0f);
                *(f32x4*)(LOGA + (size_t)m * 256 + 4 * lane) = lo;
                asm volatile("" ::: "memory");
            }
        }
    }
    SEAM(1);

    if (IN(2)) REP(2) {
        pg8::Gemm g{H, WIN, M, NIN, D}; pg8::StaticOrder S; S.init(M, NIN, G, bx);
        EpiQ E{PROJ};
        pg8::gemm_phase<EpiQ, pg8::StaticOrder, true, true>(lds, g, S, E);
        for (int r0 = gw; r0 < 2 * NEXP; r0 += 4 * NGW) {
            f32x4 v[4][4];
#pragma unroll
            for (int a = 0; a < 4; ++a) { const int r = r0 + a * NGW; if (r < 2 * NEXP) { const bool isv = r >= NEXP; const int row = isv ? r - NEXP : r;
                const float* src = (isv ? peer_v : peer_u) + (size_t)row * 1024 + 16 * lane;
#pragma unroll
                for (int q = 0; q < 4; ++q) v[a][q] = *(const f32x4*)(src + 4 * q); } }
#pragma unroll
            for (int a = 0; a < 4; ++a) { const int r = r0 + a * NGW; if (r < 2 * NEXP) { const bool isv = r >= NEXP; const int row = isv ? r - NEXP : r;
                float am = 0.f, sq = 0.f;
#pragma unroll
                for (int q = 0; q < 4; ++q) { am = fmaxf(am, fmaxf(fmaxf(fabsf(v[a][q].x), fabsf(v[a][q].y)), fmaxf(fabsf(v[a][q].z), fabsf(v[a][q].w))));
                    sq += (v[a][q].x * v[a][q].x + v[a][q].y * v[a][q].y) + (v[a][q].z * v[a][q].z + v[a][q].w * v[a][q].w); }
#pragma unroll
                for (int off = 1; off < 64; off <<= 1) { am = fmaxf(am, __shfl_xor(am, off)); sq += __shfl_xor(sq, off); }
                unsigned w0 = 0u, w1 = 0u; float sc;
                if (!isv) {
                    const float rms = sqrtf(sq * (1.0f / 1024.0f));
                    sc = rms > 0.f ? rms * (1.0f / 3.0f) : 1.0f; const float inv = 1.0f / sc;
#pragma unroll
                    for (int q = 0; q < 4; ++q)
#pragma unroll
                        for (int j = 0; j < 4; ++j) { const int qi = (int)fminf(fmaxf(rintf(v[a][q][j] * inv), -8.f), 7.f); const unsigned nib = (unsigned)qi & 15u; const int e = 4 * q + j;
                            if (e < 8) w0 |= nib << (4 * e); else w1 |= nib << (4 * (e - 8)); }
                } else {
                    sc = am > 0.f ? am * (1.0f / 6.0f) : 1.0f; const float inv = 1.0f / sc;
                    w0 = __builtin_amdgcn_cvt_scalef32_pk_fp4_f32(w0, v[a][0].x * inv, v[a][0].y * inv, 1.0f, 0); w0 = __builtin_amdgcn_cvt_scalef32_pk_fp4_f32(w0, v[a][0].z * inv, v[a][0].w * inv, 1.0f, 1);
                    w0 = __builtin_amdgcn_cvt_scalef32_pk_fp4_f32(w0, v[a][1].x * inv, v[a][1].y * inv, 1.0f, 2); w0 = __builtin_amdgcn_cvt_scalef32_pk_fp4_f32(w0, v[a][1].z * inv, v[a][1].w * inv, 1.0f, 3);
                    w1 = __builtin_amdgcn_cvt_scalef32_pk_fp4_f32(w1, v[a][2].x * inv, v[a][2].y * inv, 1.0f, 0); w1 = __builtin_amdgcn_cvt_scalef32_pk_fp4_f32(w1, v[a][2].z * inv, v[a][2].w * inv, 1.0f, 1);
                    w1 = __builtin_amdgcn_cvt_scalef32_pk_fp4_f32(w1, v[a][3].x * inv, v[a][3].y * inv, 1.0f, 2); w1 = __builtin_amdgcn_cvt_scalef32_pk_fp4_f32(w1, v[a][3].z * inv, v[a][3].w * inv, 1.0f, 3);
                }
                u32x2 o; o.x = w0; o.y = w1;
                *(u32x2*)((isv ? V8 : U8) + (size_t)row * 512 + 8 * lane) = o;
                if (lane == 0) (isv ? SV : SU)[row] = sc; } }
        }
    }
    SEAM(2);

    if (IN(3)) REP(3) {
        const int hb = tid >> 8, ht = tid & 255, hw = wave & 3, fr = lane & 15, fq = lane >> 4;
        LAS unsigned char* hbase = lds + hb * 49152;
        LAS float* LAT = (LAS float*)hbase;
        LAS float* SEG = (LAS float*)(hbase + 16640);
        LAS bf16_t* VT = (LAS bf16_t*)(hbase + 17664);
        LAS bf16_t* KT = (LAS bf16_t*)(hbase + 36096);
        for (int it = 0; it < (NUNIT + 2 * G - 1) / (2 * G); ++it) {
            const int u = (it * G + bx) * 2 + hb;
            const bool act = u < NUNIT;
            const int h = u & 3, t0 = (u >> 2) * 64;
            const int c = ht & 63, dc = ht >> 6;
            u32x4 kq0, kq1, vq[4];
            if (act) {
                const float* la = LOGA + (size_t)(t0 + c) * 256 + h * 64 + dc * 16;
                const bf16_t* kp = PROJ + (size_t)(t0 + c) * NPROJ + 256 + h * 64 + dc * 16;
                const bf16_t* vp = PROJ + (size_t)(t0 + c) * NPROJ + 512 + h * 128 + dc * 32;
                f32x4 lv[4];
#pragma unroll
                for (int q = 0; q < 4; ++q) lv[q] = *(const f32x4*)(la + 4 * q);
                kq0 = *(const u32x4*)kp; kq1 = *(const u32x4*)(kp + 8);
#pragma unroll
                for (int q = 0; q < 4; ++q) vq[q] = *(const u32x4*)(vp + 8 * q);
#pragma unroll
                for (int q = 0; q < 4; ++q)
#pragma unroll
                    for (int j = 0; j < 4; ++j) LAT[(dc * 16 + q * 4 + j) * 65 + c] = lv[q][j];
            }
            __syncthreads();
            float loc[16];
            { const int d = ht & 63, seg = ht >> 6; float run = 0.f;
#pragma unroll
                for (int r = 0; r < 16; ++r) { run += LAT[d * 65 + 16 * seg + r]; loc[r] = run; }
                SEG[seg * 64 + d] = run; }
            __syncthreads();
            { const int d = ht & 63, seg = ht >> 6; float pre = 0.f;
#pragma unroll
                for (int s2 = 0; s2 < 3; ++s2) pre += (s2 < seg) ? SEG[s2 * 64 + d] : 0.f;
#pragma unroll
                for (int r = 0; r < 16; ++r) LAT[d * 65 + 16 * seg + r] = pre + loc[r];
                if (act && seg == 3) DEC[u * 64 + d] = __expf(pre + loc[15]); }
            __syncthreads();
            if (act) {
                const unsigned kw[8] = {kq0.x, kq0.y, kq0.z, kq0.w, kq1.x, kq1.y, kq1.z, kq1.w};
#pragma unroll
                for (int q = 0; q < 8; ++q) { const int d = dc * 16 + 2 * q;
                    KT[d * 72 + c] = (bf16_t)f2bf(bflo(kw[q]) * __expf(LAT[d * 65 + 63] - LAT[d * 65 + c]));
                    KT[(d + 1) * 72 + c] = (bf16_t)f2bf(bfhi(kw[q]) * __expf(LAT[(d + 1) * 65 + 63] - LAT[(d + 1) * 65 + c])); }
#pragma unroll
                for (int q = 0; q < 4; ++q) { const unsigned vw[4] = {vq[q].x, vq[q].y, vq[q].z, vq[q].w};
#pragma unroll
                    for (int j = 0; j < 4; ++j) { const int v = dc * 32 + 8 * q + 2 * j; VT[v * 72 + c] = (bf16_t)(vw[j] & 0xffffu); VT[(v + 1) * 72 + c] = (bf16_t)(vw[j] >> 16); } }
            }
            __syncthreads();
            if (act) {
#pragma unroll
                for (int mt2 = 0; mt2 < 2; ++mt2) { const int mt = 2 * hw + mt2;
                    const bf16x8 a0 = *(const LAS bf16x8*)(VT + (16 * mt + fr) * 72 + 8 * fq), a1 = *(const LAS bf16x8*)(VT + (16 * mt + fr) * 72 + 32 + 8 * fq);
#pragma unroll
                    for (int nt = 0; nt < 4; ++nt) {
                        const bf16x8 b0 = *(const LAS bf16x8*)(KT + (16 * nt + fr) * 72 + 8 * fq), b1 = *(const LAS bf16x8*)(KT + (16 * nt + fr) * 72 + 32 + 8 * fq);
                        f32x4 acc = {0.f, 0.f, 0.f, 0.f};
                        acc = __builtin_amdgcn_mfma_f32_16x16x32_bf16(a0, b0, acc, 0, 0, 0); acc = __builtin_amdgcn_mfma_f32_16x16x32_bf16(a1, b1, acc, 0, 0, 0);
                        float* kvp = KV + (size_t)u * 8192 + (16 * mt + 4 * fq) * 64 + 16 * nt + fr;
#pragma unroll
                        for (int r = 0; r < 4; ++r) kvp[r * 64] = acc[r]; } }
            }
            __syncthreads();
        }
    }
    SEAM(3);

    if (IN(4)) REP(4) {
        const int nsb = (8 * 8192 + NTHR - 1) / NTHR;
        const bool dopool = (G > nsb) ? (bx >= nsb) : true;
        const int pbx = (G > nsb) ? bx - nsb : bx, pG = (G > nsb) ? G - nsb : G;
        if (dopool) {
        for (int it = pbx * NTHR + tid; it < (M / 8) * 64; it += pG * NTHR) {
            const int cv = it & 63, run = it >> 6, ch = cv * 8, gq = ch >> 7, w = 2 << gq;
            const int t0 = run * 8, pos0 = t0 & (SEQ - 1);
            const bf16_t* pp = PROJ + 1536 + ch;
            float s[8];
#pragma unroll
            for (int j = 0; j < 8; ++j) s[j] = 0.f;
            for (int q = 1; q <= w; ++q) if (pos0 - q >= 0) { const u32x4 v = *(const u32x4*)(pp + (size_t)(t0 - q) * NPROJ);
                s[0] += bflo(v.x); s[1] += bfhi(v.x); s[2] += bflo(v.y); s[3] += bfhi(v.y); s[4] += bflo(v.z); s[5] += bfhi(v.z); s[6] += bflo(v.w); s[7] += bfhi(v.w); }
            for (int r = 0; r < 8; ++r) {
                const int t = t0 + r, pos = pos0 + r;
                const u32x4 v = *(const u32x4*)(pp + (size_t)t * NPROJ);
                const float cur[8] = {bflo(v.x), bfhi(v.x), bflo(v.y), bfhi(v.y), bflo(v.z), bfhi(v.z), bflo(v.w), bfhi(v.w)};
#pragma unroll
                for (int j = 0; j < 8; ++j) s[j] += cur[j];
                if (pos >= w) { const u32x4 o = *(const u32x4*)(pp + (size_t)(t - w) * NPROJ);
                    s[0] -= bflo(o.x); s[1] -= bfhi(o.x); s[2] -= bflo(o.y); s[3] -= bfhi(o.y); s[4] -= bflo(o.z); s[5] -= bfhi(o.z); s[6] -= bflo(o.w); s[7] -= bfhi(o.w); }
                const float inv = 1.f / (float)((pos + 1) < w ? (pos + 1) : w);
                u32x4 ov; ov.x = pk2(s[0] * inv - cur[0], s[1] * inv - cur[1]); ov.y = pk2(s[2] * inv - cur[2], s[3] * inv - cur[3]);
                ov.z = pk2(s[4] * inv - cur[4], s[5] * inv - cur[5]); ov.w = pk2(s[6] * inv - cur[6], s[7] * inv - cur[7]);
                *(u32x4*)(H + (size_t)t * D + 512 + ch) = ov;
            }
        }
        }
        for (int sq = bx * NTHR + tid; sq < 8 * 8192; sq += G * NTHR) {
            const int bh = sq >> 13, e = sq & 8191, b = bh >> 2, h = bh & 3, d = e & 63;
            float st = 0.f;
            for (int n0 = 0; n0 < 128; n0 += 32) {
                float kv[32], dc[32];
#pragma unroll
                for (int q = 0; q < 32; ++q) { const int u = ((b * 128 + n0 + q) * 4 + h); kv[q] = KV[(size_t)u * 8192 + e]; dc[q] = DEC[u * 64 + d]; }
#pragma unroll
                for (int q = 0; q < 32; ++q) { const int u = ((b * 128 + n0 + q) * 4 + h); KV[(size_t)u * 8192 + e] = st; st = st * dc[q] + kv[q]; }
            }
        }
    }
    SEAM(4);

    if (IN(5)) REP(5) {
        LAS float* LAT = (LAS float*)lds;
        LAS float* SEG = (LAS float*)(lds + 16640);
        LAS bf16_t* A2 = (LAS bf16_t*)(lds + 18688);
        LAS bf16_t* KI = (LAS bf16_t*)(lds + 36096);
        LAS bf16_t* BT = (LAS bf16_t*)(lds + 45312);
        LAS float* OL = (LAS float*)(lds + 80128);
        const int fr = lane & 15, fq = lane >> 4;
        for (int u = bx; u < NUNIT; u += G) {
            const int h = u & 3, t0 = (u >> 2) * 64;
            const int i = tid & 63, dc = tid >> 6;
            const float* la = LOGA + (size_t)(t0 + i) * 256 + h * 64 + dc * 8;
            const bf16_t* qp = PROJ + (size_t)(t0 + i) * NPROJ + h * 64 + dc * 8;
            const bf16_t* vp = PROJ + (size_t)(t0 + i) * NPROJ + 512 + h * 128 + dc * 16;
            const float* sp = KV + (size_t)u * 8192;
            const f32x4 la0 = *(const f32x4*)la, la1 = *(const f32x4*)(la + 4);
            const u32x4 qv = *(const u32x4*)qp, kv = *(const u32x4*)(qp + 256), vv0 = *(const u32x4*)vp, vv1 = *(const u32x4*)(vp + 8);
            f32x4 sv[4];
#pragma unroll
            for (int q = 0; q < 4; ++q) sv[q] = *(const f32x4*)(sp + (q * NTHR + tid) * 4);
#pragma unroll
            for (int j = 0; j < 4; ++j) { LAT[(dc * 8 + j) * 65 + i] = la0[j]; LAT[(dc * 8 + 4 + j) * 65 + i] = la1[j]; }
            __syncthreads();
            float loc[8];
            { const int d = tid & 63, seg = tid >> 6; float run = 0.f;
#pragma unroll
                for (int r = 0; r < 8; ++r) { run += LAT[d * 65 + 8 * seg + r]; loc[r] = run; }
                SEG[seg * 64 + d] = run; }
            __syncthreads();
            { const int d = tid & 63, seg = tid >> 6; float pre = 0.f;
#pragma unroll
                for (int s2 = 0; s2 < 7; ++s2) pre += (s2 < seg) ? SEG[s2 * 64 + d] : 0.f;
#pragma unroll
                for (int r = 0; r < 8; ++r) LAT[d * 65 + 8 * seg + r] = pre + loc[r]; }
            __syncthreads();
            {
                const unsigned qw[4] = {qv.x, qv.y, qv.z, qv.w}, kw[4] = {kv.x, kv.y, kv.z, kv.w};
                u32x4 qo, ko; unsigned* qop = (unsigned*)&qo; unsigned* kop = (unsigned*)&ko;
#pragma unroll
                for (int q = 0; q < 4; ++q) { const int d = dc * 8 + 2 * q; const float b0 = LAT[d * 65 + i], b1 = LAT[(d + 1) * 65 + i];
                    qop[q] = pk2(bflo(qw[q]) * __expf(b0) * 0.125f, bfhi(qw[q]) * __expf(b1) * 0.125f);
                    kop[q] = pk2(bflo(kw[q]) * __expf(-b0), bfhi(kw[q]) * __expf(-b1)); }
                *(LAS u32x4*)(A2 + i * 136 + 64 + dc * 8) = qo;
                *(LAS u32x4*)(KI + i * 72 + dc * 8) = ko;
                const unsigned vw[8] = {vv0.x, vv0.y, vv0.z, vv0.w, vv1.x, vv1.y, vv1.z, vv1.w};
#pragma unroll
                for (int j = 0; j < 8; ++j) { const int v = dc * 16 + 2 * j; BT[v * 136 + i] = (bf16_t)(vw[j] & 0xffffu); BT[(v + 1) * 136 + i] = (bf16_t)(vw[j] >> 16); }
#pragma unroll
                for (int q = 0; q < 4; ++q) { const int e = (q * NTHR + tid) * 4, v = e >> 6, d = e & 63;
                    u32x2 so; so.x = pk2(sv[q].x, sv[q].y); so.y = pk2(sv[q].z, sv[q].w);
                    *(LAS u32x2*)(BT + v * 136 + 64 + d) = so; }
            }
            __syncthreads();
            {
                const int mt = wave & 3;
                const bf16x8 a0 = *(const LAS bf16x8*)(A2 + (16 * mt + fr) * 136 + 64 + 8 * fq), a1 = *(const LAS bf16x8*)(A2 + (16 * mt + fr) * 136 + 96 + 8 * fq);
#pragma unroll
                for (int n2 = 0; n2 < 2; ++n2) { const int nt = 2 * (wave >> 2) + n2;
                    const bf16x8 b0 = *(const LAS bf16x8*)(KI + (16 * nt + fr) * 72 + 8 * fq), b1 = *(const LAS bf16x8*)(KI + (16 * nt + fr) * 72 + 32 + 8 * fq);
                    f32x4 acc = {0.f, 0.f, 0.f, 0.f};
                    acc = __builtin_amdgcn_mfma_f32_16x16x32_bf16(a0, b0, acc, 0, 0, 0); acc = __builtin_amdgcn_mfma_f32_16x16x32_bf16(a1, b1, acc, 0, 0, 0);
                    const int jj = 16 * nt + fr;
#pragma unroll
                    for (int r = 0; r < 4; ++r) { const int ii = 16 * mt + 4 * fq + r; A2[ii * 136 + jj] = (bf16_t)f2bf(jj <= ii ? acc[r] : 0.f); } }
            }
            __syncthreads();
            {
                const int mt = wave & 3;
                bf16x8 af[4];
#pragma unroll
                for (int ks = 0; ks < 4; ++ks) af[ks] = *(const LAS bf16x8*)(A2 + (16 * mt + fr) * 136 + 32 * ks + 8 * fq);
#pragma unroll
                for (int n4 = 0; n4 < 4; ++n4) { const int nt = 4 * (wave >> 2) + n4;
                    f32x4 acc = {0.f, 0.f, 0.f, 0.f};
#pragma unroll
                    for (int ks = 0; ks < 4; ++ks) { const bf16x8 bb = *(const LAS bf16x8*)(BT + (16 * nt + fr) * 136 + 32 * ks + 8 * fq); acc = __builtin_amdgcn_mfma_f32_16x16x32_bf16(af[ks], bb, acc, 0, 0, 0); }
#pragma unroll
                    for (int r = 0; r < 4; ++r) OL[(16 * mt + 4 * fq + r) * 132 + 16 * nt + fr] = acc[r]; }
            }
            __syncthreads();
            {
                const int ti = tid >> 3, vc = tid & 7;
                f32x4 o[4]; float ss = 0.f;
#pragma unroll
                for (int q = 0; q < 4; ++q) { o[q] = *(const LAS f32x4*)(OL + ti * 132 + 16 * vc + 4 * q); ss += (o[q].x * o[q].x + o[q].y * o[q].y) + (o[q].z * o[q].z + o[q].w * o[q].w); }
                ss += __shfl_xor(ss, 1); ss += __shfl_xor(ss, 2); ss += __shfl_xor(ss, 4);
                const float rstd = 1.f / sqrtf(ss * (1.f / 128.f) + 1e-6f);
                const int t = t0 + ti;
                const bf16_t* gp = PROJ + (size_t)t * NPROJ + 1024 + h * 128 + 16 * vc;
                const u32x4 g0 = *(const u32x4*)gp, g1 = *(const u32x4*)(gp + 8);
                const unsigned gw8[8] = {g0.x, g0.y, g0.z, g0.w, g1.x, g1.y, g1.z, g1.w};
                unsigned ow[8];
#pragma unroll
                for (int q = 0; q < 4; ++q) { const f32x4 gn = *(const f32x4*)(gla_norm_g + 16 * vc + 4 * q);
                    const float y0 = o[q].x * rstd * gn.x * silu_f(bflo(gw8[2 * q])), y1 = o[q].y * rstd * gn.y * silu_f(bfhi(gw8[2 * q]));
                    const float y2 = o[q].z * rstd * gn.z * silu_f(bflo(gw8[2 * q + 1])), y3 = o[q].w * rstd * gn.w * silu_f(bfhi(gw8[2 * q + 1]));
                    ow[2 * q] = pk2(y0, y1); ow[2 * q + 1] = pk2(y2, y3); }
                bf16_t* hp2 = H + (size_t)t * D + h * 128 + 16 * vc;
                *(u32x4*)hp2 = (u32x4){ow[0], ow[1], ow[2], ow[3]}; *(u32x4*)(hp2 + 8) = (u32x4){ow[4], ow[5], ow[6], ow[7]};
            }
        }
    }
    SEAM(5);

    if (IN(6)) REP(6) {
        pg8::Gemm g{H, WOUT, M, D, D}; pg8::StaticOrder S; S.init(M, D, G, bx);
        EpiX1 E{x, X1, MOD + 2048};
        pg8::gemm_phase<EpiX1, pg8::StaticOrder, true, true>(lds, g, S, E);
    }
    SEAM(6);

    if (IN(7)) REP(7) {
        for (int m = gw; m < M; m += 4 * NGW) norm_mod_rows<4>(X1, m, NGW, norm2_g, MOD, 3072, H, lane);
    }
    SEAM(7);

    if (IN(8)) REP(8) {
        pg8::Gemm g{H, WQ, M, 2048, D}; pg8::StaticOrder S; S.init(M, 2048, G, bx);
        EpiQ E{PROJ};
        pg8::gemm_phase<EpiQ, pg8::StaticOrder, true, true>(lds, g, S, E);
    }
    SEAM(8);

    if (IN(9)) REP(9) {
        LAS bf16_t* KL = (LAS bf16_t*)lds;
        LAS unsigned char* CT = lds + 69632;
        for (int i = tid; i < 2 * 128 * 16; i += NTHR) { const int row = i >> 4, ck = i & 15; *(LAS u32x4*)(KL + row * 136 + ck * 8) = *(const u32x4*)(KK + row * 128 + ck * 8); }
        if (tid < 64) CT[tid] = CAND_IJ[tid];
        __syncthreads();
        const int fr = lane & 15, fq = lane >> 4, rb4 = (lane & 48) * 4;
        int cia[4], cja[4];
#pragma unroll
        for (int sl = 0; sl < 4; ++sl) { const unsigned ij = CAND_IJ[fr * 4 + sl]; cia[sl] = rb4 + 4 * (int)(ij >> 4); cja[sl] = rb4 + 4 * (int)(ij & 15); }
        const bf16_t* Q = PROJ;
        for (int wi = gw; wi < (M / 16) * 8; wi += NGW) {
            const int h = wi & 7, t0 = (wi >> 3) * 16;
            unsigned kk[8][8];
#pragma unroll
            for (int half = 0; half < 2; ++half) {
                const bf16_t* qp = Q + (size_t)(t0 + fr) * 2048 + h * 256 + half * 128 + fq * 8;
                bf16x8 af[4];
#pragma unroll
                for (int ks = 0; ks < 4; ++ks) af[ks] = *(const bf16x8*)(qp + ks * 32);
                int kboff = half * 128 * 136 + fr * 136 + fq * 8;
                asm volatile("" : "+v"(kboff));
                const LAS bf16_t* kb = KL + kboff;
#pragma unroll
                for (int nt = 0; nt < 8; ++nt) {
                    f32x4 c = {0.f, 0.f, 0.f, 0.f};
#pragma unroll
                    for (int ks = 0; ks < 4; ++ks) { const bf16x8 bf = *(const LAS bf16x8*)(kb + nt * 16 * 136 + ks * 32); c = __builtin_amdgcn_mfma_f32_16x16x32_bf16(af[ks], bf, c, 0, 0, 0); }
#pragma unroll
                    for (int r = 0; r < 4; ++r) kk[half * 4 + r][nt] = fkey(c[r], 127u - (unsigned)(nt * 16 + fr), 127u);
                }
            }
#define CE(a, b) do { const unsigned hi_ = umax_(kx[a], kx[b]), lo_ = umin_(kx[a], kx[b]); kx[a] = hi_; kx[b] = lo_; } while (0)
#pragma unroll
            for (int x = 0; x < 8; ++x) { unsigned (&kx)[8] = kk[x];
                CE(0, 1); CE(2, 3); CE(4, 5); CE(6, 7); CE(0, 2); CE(1, 3); CE(4, 6); CE(5, 7); CE(1, 2); CE(5, 6);
                CE(0, 4); CE(1, 5); CE(2, 6); CE(3, 7); CE(2, 4); CE(3, 5); CE(1, 2); CE(3, 4); CE(5, 6); }
            unsigned res[8];
#pragma unroll
            for (int x = 0; x < 8; ++x) res[x] = 0u;
#pragma unroll 1
            for (int rd = 0; rd < 16; ++rd)
#pragma unroll
                for (int x = 0; x < 8; ++x) { unsigned (&kx)[8] = kk[x];
                    const unsigned m = row_allmax(kx[0]); const bool own = kx[0] == m;
#pragma unroll
                    for (int j = 0; j < 7; ++j) kx[j] = own ? kx[j + 1] : kx[j];
                    kx[7] = own ? 0u : kx[7];
                    res[x] = (fr == rd) ? m : res[x]; }
            unsigned ck[4][4];
#pragma unroll
            for (int r = 0; r < 4; ++r)
#pragma unroll
                for (int sl = 0; sl < 4; ++sl) { const unsigned va = __builtin_amdgcn_ds_bpermute(cia[sl], res[r]), vb = __builtin_amdgcn_ds_bpermute(cja[sl], res[4 + r]);
                    const float sum = fkey_val(va, 127u) + fkey_val(vb, 127u);
                    ck[r][sl] = (fr * 4 + sl < 50) ? fkey(sum, 63u - (unsigned)(fr * 4 + sl), 63u) : 0u; }
#pragma unroll
            for (int r = 0; r < 4; ++r) { unsigned (&kx)[4] = ck[r]; CE(0, 1); CE(2, 3); CE(0, 2); CE(1, 3); CE(1, 2); }
#undef CE
            unsigned res3[4], mfirst[4];
#pragma unroll
            for (int r = 0; r < 4; ++r) { res3[r] = 0u; mfirst[r] = 0u; }
#pragma unroll 1
            for (int rd = 0; rd < 16; ++rd)
#pragma unroll
                for (int r = 0; r < 4; ++r) { unsigned (&kx)[4] = ck[r];
                    const unsigned m = row_allmax(kx[0]); const bool own = kx[0] == m;
                    kx[0] = own ? kx[1] : kx[0]; kx[1] = own ? kx[2] : kx[1]; kx[2] = own ? kx[3] : kx[2]; kx[3] = own ? 0u : kx[3];
                    res3[r] = (fr == rd) ? m : res3[r]; mfirst[r] = (rd == 0) ? m : mfirst[r]; }
#pragma unroll
            for (int r = 0; r < 4; ++r) {
                const unsigned cidx = 63u - (res3[r] & 63u);
                const unsigned ij = CT[cidx];
                const unsigned wa = __builtin_amdgcn_ds_bpermute(rb4 + 4 * (int)(ij >> 4), res[r]), wb = __builtin_amdgcn_ds_bpermute(rb4 + 4 * (int)(ij & 15), res[4 + r]);
                const int eid = (int)((127u - (wa & 127u)) * 128u + (127u - (wb & 127u)));
                const float ex = __expf(fkey_val(res3[r], 63u) - fkey_val(mfirst[r], 63u));
                const float tot = row_allsum(ex);
                const size_t o = (size_t)(t0 + 4 * fq + r) * 128 + h * 16 + fr;
                IDX[o] = eid; GATE[o] = ex / tot;
            }
        }
    }
    SEAM(9);

    if (IN(10)) REP(10) {
        struct TokMeta { int id0, id1; float zs0, zs1, as0, as1; u32x4 ha, hb; };
#define P10_META(mm, tt) do { const size_t t_ = (size_t)(tt); (mm).id0 = IDX[t_ * 128 + lane]; (mm).id1 = IDX[t_ * 128 + 64 + lane]; \
            (mm).zs0 = SU[(mm).id0]; (mm).zs1 = SU[(mm).id1]; (mm).as0 = GATE[t_ * 128 + lane] * SV[(mm).id0] * 64.f; (mm).as1 = GATE[t_ * 128 + 64 + lane] * SV[(mm).id1] * 64.f; \
            const bf16_t* hp_ = H + t_ * D + 16 * lane; (mm).ha = *(const u32x4*)hp_; (mm).hb = *(const u32x4*)(hp_ + 8); } while (0)
#define P10_LOAD(ub, vb, mm, cc) peer_chunk_load<4, 4>(ub, vb, U8, V8, ((cc) & 8) ? (mm).id1 : (mm).id0, (8 * (cc)) & 63, lane)
#define P10_COMP(ub, vb, cc) peer_chunk_compute4(ub, vb, hh, o2, (((cc) & 8) ? cur.zs1 : cur.zs0) * hscale, ((cc) & 8) ? cur.as1 : cur.as0, (8 * (cc)) & 63, lane)
        int t = gw;
        if (t < M) {
            TokMeta cur, nxt;
            P10_META(cur, t);
            { const int tn = (t + NGW < M) ? t + NGW : t; P10_META(nxt, tn); }
            RowVec<4> u0[8], u1[8], u2[8], u3[8], v0[8], v1[8], v2[8], v3[8];
            P10_LOAD(u0, v0, cur, 0); P10_LOAD(u1, v1, cur, 1); P10_LOAD(u2, v2, cur, 2);
            for (; t < M; t += NGW) {
                h2_t o2[8]; int hh[4]; float hscale;
                {
                    const unsigned hwv[8] = {cur.ha.x, cur.ha.y, cur.ha.z, cur.ha.w, cur.hb.x, cur.hb.y, cur.hb.z, cur.hb.w};
                    float hf[16], am = 0.f;
#pragma unroll
                    for (int k = 0; k < 8; ++k) { hf[2 * k] = bflo(hwv[k]); hf[2 * k + 1] = bfhi(hwv[k]); am = fmaxf(am, fmaxf(fabsf(hf[2 * k]), fabsf(hf[2 * k + 1]))); o2[k] = (h2_t){(_Float16)0.f, (_Float16)0.f}; }
#pragma unroll
                    for (int off = 1; off < 64; off <<= 1) am = fmaxf(am, __shfl_xor(am, off));
                    hscale = am > 0.f ? am * (1.0f / 119.0f) : 1.0f; const float hinv = 1.0f / hscale;
                    unsigned ph0 = 0u, ph1 = 0u, pl0 = 0u, pl1 = 0u;
#pragma unroll
                    for (int e = 0; e < 16; ++e) { const int hi8 = (int)rintf(hf[e] * hinv); const int lo = ((hi8 + 8) & 15) - 8, hi = (hi8 - lo) >> 4;
                        if (e < 8) { ph0 |= ((unsigned)hi & 15u) << (4 * e); pl0 |= ((unsigned)lo & 15u) << (4 * e); } else { ph1 |= ((unsigned)hi & 15u) << (4 * (e - 8)); pl1 |= ((unsigned)lo & 15u) << (4 * (e - 8)); } }
                    hh[0] = (int)ph0; hh[1] = (int)ph1; hh[2] = (int)pl0; hh[3] = (int)pl1;
                }
#pragma unroll 1
                for (int g4 = 0; g4 < 12; g4 += 4) {
                    P10_LOAD(u3, v3, cur, g4 + 3); P10_COMP(u0, v0, g4);
                    P10_LOAD(u0, v0, cur, g4 + 4); P10_COMP(u1, v1, g4 + 1);
                    P10_LOAD(u1, v1, cur, g4 + 5); P10_COMP(u2, v2, g4 + 2);
                    P10_LOAD(u2, v2, cur, g4 + 6); P10_COMP(u3, v3, g4 + 3);
                }
                const float* g2p = MOD + (t >= SEQ ? 6144 : 0) + 5120 + 16 * lane;
                float* xr = X1 + (size_t)t * D + 16 * lane;
                f32x4 xv[4];
#pragma unroll
                for (int q = 0; q < 4; ++q) xv[q] = *(const f32x4*)(xr + 4 * q);
                P10_LOAD(u3, v3, cur, 15); P10_COMP(u0, v0, 12);
                P10_LOAD(u0, v0, nxt, 0); P10_COMP(u1, v1, 13);
                P10_LOAD(u1, v1, nxt, 1); P10_COMP(u2, v2, 14);
                P10_LOAD(u2, v2, nxt, 2); P10_COMP(u3, v3, 15);
                float ss = 0.f;
#pragma unroll
                for (int q = 0; q < 4; ++q) { const f32x4 ov = {(float)o2[2 * q].x, (float)o2[2 * q].y, (float)o2[2 * q + 1].x, (float)o2[2 * q + 1].y};
                    const f32x4 gg = *(const f32x4*)(g2p + 4 * q);
                    xv[q] = xv[q] + gg * (ov * (1.0f / 64.0f)); ss += (xv[q].x * xv[q].x + xv[q].y * xv[q].y) + (xv[q].z * xv[q].z + xv[q].w * xv[q].w); }
                const float rstd = 1.f / sqrtf(wave_sum(ss) * (1.f / D) + 1e-6f);
#pragma unroll
                for (int q = 0; q < 4; ++q) { const f32x4 fg = *(const f32x4*)(final_g + 16 * lane + 4 * q);
                    *(f32x4*)(xr + 4 * q) = xv[q] * rstd * fg; }
                cur = nxt;
                { const int tn = (t + 2 * NGW < M) ? t + 2 * NGW : ((t + NGW < M) ? t + NGW : t); P10_META(nxt, tn); }
            }
        }
#undef P10_META
#undef P10_LOAD
#undef P10_COMP
    }
    if (TMASK) { xcd_barrier(bar); STAMP(11);
        if (bx == 0 && tid == 0) { volatile LAS unsigned long long* T = (volatile LAS unsigned long long*)(lds + MISC_OFF + 64); unsigned long long span = 0;
#pragma unroll
            for (int k = 0; k < 11; ++k) if ((TMASK >> k) & 1) span += T[k + 1] - T[k];
            unsigned long long t0, t1; asm volatile("s_memrealtime %0\n\ts_waitcnt lgkmcnt(0)" : "=s"(t0) :: "memory");
            do { __builtin_amdgcn_s_sleep(8); asm volatile("s_memrealtime %0\n\ts_waitcnt lgkmcnt(0)" : "=s"(t1) :: "memory"); } while (t1 - t0 < span); } }
#undef IN
#undef REP
#undef SEAM
}

extern "C" void kernel_launch(void* const* d_in, const int* in_sizes, int n_in, void* d_out, int out_size, void* d_ws, size_t ws_size, hipStream_t stream) {
    static int grid = 0;
    if (grid == 0) {
        if (n_in != 19 || out_size != M * D || ws_size < WS_END) { fprintf(stderr, "kernel_launch: unexpected shapes (n_in %d out %d ws %zu)\n", n_in, out_size, ws_size); grid = -1; return; }
        int dev = 0, cus = 0, per_cu = 0;
        (void)hipGetDevice(&dev); (void)hipDeviceGetAttribute(&cus, hipDeviceAttributeMultiprocessorCount, dev);
        (void)hipFuncSetAttribute((const void*)fwd_kernel, hipFuncAttributeMaxDynamicSharedMemorySize, LDS_BYTES);
        (void)hipOccupancyMaxActiveBlocksPerMultiprocessor(&per_cu, (const void*)fwd_kernel, NTHR, LDS_BYTES);
        (void)hipGetLastError();
        if (per_cu < 1) { fprintf(stderr, "kernel_launch: occupancy query says %d blocks/CU\n", per_cu); per_cu = 1; }
        grid = cus;
    }
    if (grid < 0) return;
    (void)hipMemsetAsync((char*)d_ws + WS_CTL, 0, CTL_ZERO_BYTES, stream);
    Params p{};
    for (int i = 0; i < 19; ++i) p.in[i] = (const float*)d_in[i];
    p.out = (float*)d_out; p.ws = (unsigned char*)d_ws; p.ph_lo = 0; p.ph_hi = 11;
    void* args[] = {&p};
    hipError_t e = hipLaunchCooperativeKernel((const void*)fwd_kernel, dim3(grid), dim3(NTHR), args, LDS_BYTES, stream);
    if (e != hipSuccess) fprintf(stderr, "kernel_launch: cooperative launch failed: %s (grid %d)\n", hipGetErrorString(e), grid);
}
```

```cpp
#include <hip/hip_runtime.h>
#include <cstdio>
#include <cstdint>

#define LAS __attribute__((address_space(3)))
#define GAS __attribute__((address_space(1)))
typedef unsigned short bf16_t;
typedef short bf16x8 __attribute__((ext_vector_type(8)));
typedef float f32x4 __attribute__((ext_vector_type(4)));
typedef float f32x2 __attribute__((ext_vector_type(2)));
typedef unsigned u32x4 __attribute__((ext_vector_type(4)));
typedef unsigned u32x2 __attribute__((ext_vector_type(2)));
typedef __bf16 bf16x2_t __attribute__((ext_vector_type(2)));

namespace pg8 {
#define PG8_LAS __attribute__((address_space(3)))
constexpr int BM = 256, BK = 64, HALF = 128, HTB = HALF * BK * 2, STAGE_BYTES = 8 * HTB, NXCD = 8, WGM = 8;
__host__ __device__ __forceinline__ int lds_byte(int r, int c) { const int st = (r >> 4) * 2 + (c >> 5), rr = r & 15, cc = c & 31, ob = rr * 64 + cc * 2; return st * 1024 + (ob ^ (((ob >> 9) & 1) << 5)); }
__host__ __device__ __forceinline__ void stage_rc(int b, int& R, int& C) { const int st = b / 1024, sb = b % 1024, swz = sb ^ (((sb >> 9) & 1) << 5); R = (st >> 1) * 16 + swz / 64; C = (st & 1) * 32 + (swz % 64) / 2; }
__host__ __device__ __forceinline__ int perm32(int rho) { const int n = rho >> 4, i = rho & 15; return 8 * (i >> 2) + 4 * n + (i & 3); }
struct Unit { int pm, pn; };
struct Gemm { const bf16_t* A; const bf16_t* Bt; int M, N, K; };
struct StaticOrder {
    int nM, nN, nwg, G, c;
    __host__ __device__ void init(int M, int N, int G_, int c_) { nM = M / BM; nN = N / BM; nwg = nM * nN; G = G_; c = c_; }
    __host__ __device__ bool next(int i, Unit& u) const {
        const long L = (long)i * G + c; if (L >= nwg) return false;
        int wgid = (int)L; { const int q = nwg / NXCD, r = nwg % NXCD, xcd = wgid % NXCD, off = wgid / NXCD; wgid = (xcd < r ? xcd * (q + 1) : r * (q + 1) + (xcd - r) * q) + off; }
        const int nig = WGM * nN, gid = wgid / nig, fm = gid * WGM, gsz = (nM - fm) < WGM ? (nM - fm) : WGM;
        u.pm = fm + ((wgid % nig) % gsz); u.pn = (wgid % nig) / gsz; return true;
    }
    __device__ __forceinline__ void a_ready(const Unit&) const {}
    __device__ __forceinline__ void done(const Unit&) const {}
};
__device__ __forceinline__ unsigned cvt_pk_bf16(float lo, float hi) { unsigned r; asm volatile("v_cvt_pk_bf16_f32 %0, %1, %2" : "=v"(r) : "v"(lo), "v"(hi)); return r; }

template <class Epi, class Sched, bool ALIGN_EPI = false, bool SP2 = false>
__device__ __forceinline__ void gemm_phase(PG8_LAS unsigned char* lds, const Gemm g, const Sched& S, const Epi& E) {
    const int tid = threadIdx.x, wid = __builtin_amdgcn_readfirstlane(tid >> 6), lane = tid & 63, wr = wid >> 2, wc = wid & 3, fr = lane & 15, fq = lane >> 4;
    const int K = g.K, nt = K / BK;
    unsigned voffA[2], voffB[2];
#pragma unroll
    for (int i = 0; i < 2; ++i) { int R, C; stage_rc(tid * 16 + i * 8192, R, C); const int Rb = Epi::PERM ? ((R & ~31) + perm32(R & 31)) : R;
        voffA[i] = (unsigned)(R * K + C) * 2u; voffB[i] = (unsigned)(Rb * K + C) * 2u; }
    const size_t kstep = (size_t)(BK * 2);
    const size_t hstep = (size_t)HALF * K * 2;
    const size_t tstep = 2 * hstep;
    const unsigned ldsw = (unsigned)wid * 1024u;
    const int aoff = lds_byte(wr * 64 + fr, fq * 8), boff = lds_byte(wc * 32 + fr, fq * 8);
#define PG8_SA(b, h) (((b) * 2 + (h)) * HTB)
#define PG8_SB(b, h) ((4 + (b) * 2 + (h)) * HTB)
#define PG8_STAGE(bufoff, gbase, voff) do { _Pragma("unroll") for (int _i = 0; _i < 2; ++_i) \
        __builtin_amdgcn_global_load_lds((const unsigned*)((const char*)(gbase) + (voff)[_i]), (PG8_LAS unsigned*)(lds + (bufoff) + ldsw + _i * 8192), 16, 0, 0); } while (0)
#define PG8_LDA(dst, b, h) do { _Pragma("unroll") for (int m = 0; m < 4; ++m) _Pragma("unroll") for (int k = 0; k < 2; ++k) dst[m][k] = *(const PG8_LAS bf16x8*)(lds + PG8_SA(b, h) + aoff + m * 2048 + k * 1024); } while (0)
#define PG8_LDB(dst, b, h) do { _Pragma("unroll") for (int n = 0; n < 2; ++n) _Pragma("unroll") for (int k = 0; k < 2; ++k) dst[n][k] = *(const PG8_LAS bf16x8*)(lds + PG8_SB(b, h) + boff + n * 2048 + k * 1024); } while (0)
#define PG8_MMA(ai, bj, At, Bt) do { __builtin_amdgcn_s_setprio(1); _Pragma("unroll") for (int m = 0; m < 4; ++m) _Pragma("unroll") for (int n = 0; n < 2; ++n) _Pragma("unroll") for (int k = 0; k < 2; ++k) \
        acc[ai][bj][m][n] = __builtin_amdgcn_mfma_f32_16x16x32_bf16(Bt[n][k], At[m][k], acc[ai][bj][m][n], 0, 0, 0); __builtin_amdgcn_s_setprio(0); } while (0)
#define PG8_WAIT_V(n) asm volatile("s_waitcnt vmcnt(" #n ")" ::: "memory")
#define PG8_WAIT_L(n) asm volatile("s_waitcnt lgkmcnt(" #n ")" ::: "memory")
#define PG8_BAR __builtin_amdgcn_s_barrier()
#define PG8_SCHED __builtin_amdgcn_sched_barrier(0)
    Unit cur, nxt; int ui = 0;
    if (!S.next(0, cur)) return;
    f32x4 acc[2][2][4][2];
#pragma unroll
    for (int a = 0; a < 2; ++a)
#pragma unroll
        for (int b = 0; b < 2; ++b)
#pragma unroll
            for (int m = 0; m < 4; ++m)
#pragma unroll
                for (int n = 0; n < 2; ++n) acc[a][b][m][n] = (f32x4){0.f, 0.f, 0.f, 0.f};
    bf16x8 At[4][2], B0[2][2], B1[2][2];
    const char* cA = (const char*)g.A + (size_t)cur.pm * tstep; const char* cB = (const char*)g.Bt + (size_t)cur.pn * tstep;
    S.a_ready(cur);
    if constexpr (SP2) {
        PG8_STAGE(PG8_SB(0, 0), cB, voffB); PG8_STAGE(PG8_SB(0, 1), cB + hstep, voffB); PG8_STAGE(PG8_SA(0, 0), cA, voffA); PG8_STAGE(PG8_SA(0, 1), cA + hstep, voffA);
        if (wr == 1) PG8_BAR;
        PG8_WAIT_V(2); PG8_BAR;
        PG8_STAGE(PG8_SB(1, 0), cB + kstep, voffB); PG8_STAGE(PG8_SA(1, 0), cA + kstep, voffA); PG8_STAGE(PG8_SB(1, 1), cB + hstep + kstep, voffB);
        PG8_WAIT_V(6); PG8_BAR;
    } else {
        PG8_STAGE(PG8_SB(0, 0), cB, voffB); PG8_STAGE(PG8_SA(0, 0), cA, voffA); PG8_STAGE(PG8_SB(0, 1), cB + hstep, voffB); PG8_STAGE(PG8_SA(0, 1), cA + hstep, voffA);
        if (wr == 1) PG8_BAR;
        PG8_WAIT_V(4); PG8_BAR;
        PG8_STAGE(PG8_SB(1, 0), cB + kstep, voffB); PG8_STAGE(PG8_SA(1, 0), cA + kstep, voffA); PG8_STAGE(PG8_SB(1, 1), cB + hstep + kstep, voffB);
        PG8_WAIT_V(6); PG8_BAR;
    }
    for (;;) {
        const bool has_next = S.next(ui + 1, nxt);
        const char* nA = has_next ? (const char*)g.A + (size_t)nxt.pm * tstep : cA; const char* nB = has_next ? (const char*)g.Bt + (size_t)nxt.pn * tstep : cB;
        for (int t = 0; t < nt; t += 2) {
            const bool last = (t == nt - 2);
            const char* a1 = cA + (size_t)(t + 1) * kstep;
            const char* a2 = last ? nA : cA + (size_t)(t + 2) * kstep; const char* b2 = last ? nB : cB + (size_t)(t + 2) * kstep;
            const char* a3 = a2 + kstep; const char* b3 = b2 + kstep;
            if (last && has_next) S.a_ready(nxt);
            if constexpr (SP2) {
            PG8_LDB(B0, 0, 0); PG8_LDB(B1, 0, 1); PG8_SCHED; PG8_LDA(At, 0, 0); PG8_STAGE(PG8_SA(1, 1), a1 + hstep, voffA);
            PG8_WAIT_V(8); PG8_WAIT_L(0); PG8_BAR; PG8_MMA(0, 0, At, B0); PG8_MMA(0, 1, At, B1); PG8_BAR; PG8_SCHED;
            PG8_LDA(At, 0, 1); PG8_STAGE(PG8_SB(0, 0), b2, voffB); PG8_STAGE(PG8_SB(0, 1), b2 + hstep, voffB); PG8_STAGE(PG8_SA(0, 0), a2, voffA);
            PG8_WAIT_V(8); PG8_WAIT_L(0); PG8_BAR; PG8_MMA(1, 0, At, B0); PG8_MMA(1, 1, At, B1); PG8_BAR; PG8_SCHED;
            PG8_LDB(B0, 1, 0); PG8_LDB(B1, 1, 1); PG8_SCHED; PG8_LDA(At, 1, 0); PG8_STAGE(PG8_SA(0, 1), a2 + hstep, voffA);
            PG8_WAIT_V(8); PG8_WAIT_L(0); PG8_BAR; PG8_MMA(0, 0, At, B0); PG8_MMA(0, 1, At, B1); PG8_BAR; PG8_SCHED;
            PG8_LDA(At, 1, 1); PG8_STAGE(PG8_SB(1, 0), b3, voffB); PG8_STAGE(PG8_SB(1, 1), b3 + hstep, voffB); PG8_STAGE(PG8_SA(1, 0), a3, voffA);
            PG8_WAIT_V(8); PG8_WAIT_L(0); PG8_BAR; PG8_MMA(1, 0, At, B0); PG8_MMA(1, 1, At, B1); PG8_BAR; PG8_SCHED;
            } else {
            PG8_LDB(B0, 0, 0); PG8_SCHED; PG8_LDA(At, 0, 0); PG8_STAGE(PG8_SA(1, 1), a1 + hstep, voffA);
            PG8_WAIT_L(8); PG8_BAR; PG8_WAIT_L(0); PG8_MMA(0, 0, At, B0); PG8_BAR; PG8_SCHED;
            PG8_LDB(B1, 0, 1); PG8_STAGE(PG8_SB(0, 0), b2, voffB);
            PG8_BAR; PG8_WAIT_L(0); PG8_MMA(0, 1, At, B1); PG8_BAR;
            PG8_LDA(At, 0, 1); PG8_STAGE(PG8_SA(0, 0), a2, voffA);
            PG8_BAR; PG8_WAIT_L(0); PG8_MMA(1, 0, At, B0); PG8_BAR; PG8_SCHED;
            PG8_STAGE(PG8_SB(0, 1), b2 + hstep, voffB);
            PG8_WAIT_V(6); PG8_BAR; PG8_MMA(1, 1, At, B1); PG8_BAR;
            PG8_LDB(B0, 1, 0); PG8_SCHED; PG8_LDA(At, 1, 0); PG8_STAGE(PG8_SA(0, 1), a2 + hstep, voffA);
            PG8_WAIT_L(8); PG8_BAR; PG8_WAIT_L(0); PG8_MMA(0, 0, At, B0); PG8_BAR; PG8_SCHED;
            PG8_LDB(B1, 1, 1); PG8_STAGE(PG8_SB(1, 0), b3, voffB);
            PG8_BAR; PG8_WAIT_L(0); PG8_MMA(0, 1, At, B1); PG8_BAR;
            PG8_LDA(At, 1, 1); PG8_STAGE(PG8_SA(1, 0), a3, voffA);
            PG8_BAR; PG8_WAIT_L(0); PG8_MMA(1, 0, At, B0); PG8_BAR; PG8_SCHED;
            PG8_STAGE(PG8_SB(1, 1), b3 + hstep, voffB);
            PG8_WAIT_V(6); PG8_BAR; PG8_MMA(1, 1, At, B1); PG8_BAR;
            }
        }
        if constexpr (ALIGN_EPI) { if (wr == 0) PG8_BAR; }
        E(acc, cur, wr, wc, fr, fq); S.done(cur);
        if (!has_next) break;
#pragma unroll
        for (int a = 0; a < 2; ++a)
#pragma unroll
            for (int b = 0; b < 2; ++b)
#pragma unroll
                for (int m = 0; m < 4; ++m)
#pragma unroll
                    for (int n = 0; n < 2; ++n) acc[a][b][m][n] = (f32x4){0.f, 0.f, 0.f, 0.f};
        cur = nxt; cA = nA; cB = nB; ++ui;
        if constexpr (ALIGN_EPI) { if (wr == 1) PG8_BAR; }
    }
    PG8_WAIT_V(0);
    if constexpr (!ALIGN_EPI) { if (wr == 0) PG8_BAR; }
    PG8_BAR;
#undef PG8_SA
#undef PG8_SB
#undef PG8_STAGE
#undef PG8_LDA
#undef PG8_LDB
#undef PG8_MMA
#undef PG8_WAIT_V
#undef PG8_WAIT_L
#undef PG8_BAR
#undef PG8_SCHED
}
}

#ifndef DUPMASK
#define DUPMASK 0
#endif
#ifndef TMASK
#define TMASK 0
#endif
#ifndef UFMT
#define UFMT 4
#endif
#ifndef VFMT
#define VFMT 4
#endif
constexpr int NB = 2, SEQ = 8192, D = 1024, M = NB * SEQ;
constexpr int NPROJ = 2048, NIN = 2048, INLD = 2064;
constexpr int NUNIT = 1024;
constexpr int NEXP = 16384;
constexpr size_t MiB = 1u << 20;
constexpr size_t WS_CTL = 0, CTL_ZERO_BYTES = 64 * 1024;
constexpr size_t WS_MOD = 1 * MiB;
constexpr size_t WS_DEC = 1 * MiB + 512 * 1024;
constexpr size_t WS_WIN = 2 * MiB;
constexpr size_t WS_WOUT = 7 * MiB;
constexpr size_t WS_WQ = 9 * MiB;
constexpr size_t WS_KK = 13 * MiB;
constexpr size_t WS_IDX = 14 * MiB;
constexpr size_t WS_GATE = 22 * MiB;
constexpr size_t WS_LOGA = 30 * MiB;
constexpr size_t WS_KV = 46 * MiB;
constexpr size_t WS_H = 78 * MiB;
constexpr size_t WS_U8 = 110 * MiB;
constexpr size_t WS_V8 = 126 * MiB;
constexpr size_t WS_SU = 142 * MiB;
constexpr size_t WS_SV = 142 * MiB + 65536;
constexpr size_t WS_PROJ = 174 * MiB;
constexpr size_t WS_END = 238 * MiB;
constexpr int CW_BAR = 1024;
constexpr int NWAVES = 8, NTHR = 512;
constexpr int LDS_BYTES = 147456, MISC_OFF = 147456 - 256;

#define XB_TMO      128
#define XB_XCNT(j)  (256  + 64 * (j))
#define XB_XSUB(j)  (1280 + 64 * (j))
#define XB_XGEN(j)  (2304 + 64 * (j))
#define XB_TOP      3328
#define XB_TOPGEN   3392
#define XCD_BAR_WORDS 3456
#define XB_SPIN_CAP (1u << 20)
__device__ __forceinline__ unsigned xb_ld(unsigned* p)              { return __hip_atomic_load(p, __ATOMIC_RELAXED, __HIP_MEMORY_SCOPE_AGENT); }
__device__ __forceinline__ unsigned xb_add(unsigned* p, unsigned v) { return __hip_atomic_fetch_add(p, v, __ATOMIC_RELAXED, __HIP_MEMORY_SCOPE_AGENT); }
__device__ __forceinline__ unsigned xb_xcc_id() { return (unsigned)__builtin_amdgcn_s_getreg((3 << 11) | 20) & 0xFu; }
#define XB_SPIN(cond, bar) do { unsigned _sp = 0; while (cond) { __builtin_amdgcn_s_sleep(1); \
    if ((++_sp & 255u) == 0u) { if (xb_ld(&(bar)[XB_TMO])) break; if (_sp > XB_SPIN_CAP) { atomicAdd(&(bar)[XB_TMO], 1u); break; } } } } while (0)
struct XcdBarrier { unsigned* bar; unsigned x; volatile LAS unsigned* st; };
__device__ __forceinline__ XcdBarrier xcd_barrier_post(unsigned* bar, volatile LAS unsigned* st) {
    XcdBarrier b; b.bar = bar; b.x = xb_xcc_id(); b.st = st;
    if (threadIdx.x == 0) (void)xb_add(&bar[XB_XCNT(b.x)], 1u);
    return b;
}
__device__ __forceinline__ void xcd_barrier_complete(unsigned* bar, unsigned x, unsigned& nloc, unsigned& nx) {
    const unsigned G = gridDim.x * gridDim.y * gridDim.z;
    unsigned sum, cnt, mine, sp = 0u;
    for (;;) {
        sum = 0u; cnt = 0u; mine = 0u;
#pragma unroll
        for (unsigned j = 0; j < 16; ++j) { const unsigned c = xb_ld(&bar[XB_XCNT(j)]); sum += c; cnt += (c > 0u) ? 1u : 0u; mine = (j == x) ? c : mine; }
        if (sum == G) break;
        __builtin_amdgcn_s_sleep(1);
        if ((++sp & 255u) == 0u) { if (xb_ld(&bar[XB_TMO])) break; if (sp > XB_SPIN_CAP) { atomicAdd(&bar[XB_TMO], 1u); break; } }
    }
    nloc = mine > 0u ? mine : 1u; nx = cnt > 0u ? cnt : 1u;
}
__device__ __forceinline__ void xcd_barrier(const XcdBarrier& b) {
    asm volatile("s_waitcnt vmcnt(0)" ::: "memory");
    __syncthreads();
    if (threadIdx.x == 0) {
        unsigned* bar = b.bar;
        __builtin_amdgcn_s_waitcnt(0);
        unsigned nloc = b.st[0], nx = b.st[1];
        if (nloc == 0u) { xcd_barrier_complete(bar, b.x, nloc, nx); b.st[0] = nloc; b.st[1] = nx; }
        const unsigned old = xb_add(&bar[XB_XSUB(b.x)], 1u);
        const unsigned gen = old / nloc;
        if (old + 1u == (gen + 1u) * nloc) {
            __builtin_amdgcn_fence(__ATOMIC_RELEASE, "agent");
            asm volatile("s_waitcnt vmcnt(0)" ::: "memory");
            const unsigned og = xb_add(&bar[XB_TOP], 1u);
            const unsigned tg = og / nx;
            if (og + 1u == (tg + 1u) * nx) xb_add(&bar[XB_TOPGEN], 1u);
            else XB_SPIN(xb_ld(&bar[XB_TOPGEN]) == tg, bar);
            __builtin_amdgcn_fence(__ATOMIC_ACQUIRE, "agent");
            xb_add(&bar[XB_XGEN(b.x)], 1u);
            asm volatile("s_waitcnt vmcnt(0)" ::: "memory");
        } else {
            XB_SPIN(xb_ld(&bar[XB_XGEN(b.x)]) == gen, bar);
            __builtin_amdgcn_fence(__ATOMIC_ACQUIRE, "agent");
            asm volatile("s_waitcnt vmcnt(0)" ::: "memory");
        }
    }
    __syncthreads();
}

__device__ __forceinline__ unsigned f2bf(float f) { unsigned u = __builtin_bit_cast(unsigned, f); return (u + 0x7fffu + ((u >> 16) & 1u)) >> 16; }
__device__ __forceinline__ unsigned pk2(float lo, float hi) { return f2bf(lo) | (f2bf(hi) << 16); }
__device__ __forceinline__ float bflo(unsigned w) { return __builtin_bit_cast(float, w << 16); }
__device__ __forceinline__ float bfhi(unsigned w) { return __builtin_bit_cast(float, w & 0xffff0000u); }
__device__ __forceinline__ float wave_sum(float v) {
#pragma unroll
    for (int o = 1; o < 64; o <<= 1) v += __shfl_xor(v, o);
    return v;
}
__device__ __forceinline__ float silu_f(float x) { return x / (1.f + __expf(-x)); }
__device__ __forceinline__ float logsig_f(float x) { return fminf(x, 0.f) - log1pf(__expf(-fabsf(x))); }
__device__ __forceinline__ float gelu_f(float x) { return 0.5f * x * (1.f + erff(x * 0.70710678118654752f)); }

template <int FMT> struct RowVec { u32x4 w; };
template <> struct RowVec<4> { u32x2 w; };
template <int FMT> __device__ __forceinline__ RowVec<FMT> row_load(const unsigned char* tab, int eid, int lane) {
    RowVec<FMT> r;
    if constexpr (FMT == 4) r.w = *(const u32x2*)(tab + (size_t)eid * 512 + 8 * lane); else r.w = *(const u32x4*)(tab + (size_t)eid * 1024 + 16 * lane);
    return r;
}
template <int FMT> __device__ __forceinline__ void row_decode(const RowVec<FMT>& r, float (&f)[16]) {
    if constexpr (FMT == 4) {
        const unsigned w[2] = {r.w.x, r.w.y};
#pragma unroll
        for (int k = 0; k < 2; ++k) {
            const f32x2 p0 = __builtin_amdgcn_cvt_scalef32_pk_f32_fp4(w[k], 1.0f, 0), p1 = __builtin_amdgcn_cvt_scalef32_pk_f32_fp4(w[k], 1.0f, 1);
            const f32x2 p2 = __builtin_amdgcn_cvt_scalef32_pk_f32_fp4(w[k], 1.0f, 2), p3 = __builtin_amdgcn_cvt_scalef32_pk_f32_fp4(w[k], 1.0f, 3);
            f[8 * k] = p0.x; f[8 * k + 1] = p0.y; f[8 * k + 2] = p1.x; f[8 * k + 3] = p1.y; f[8 * k + 4] = p2.x; f[8 * k + 5] = p2.y; f[8 * k + 6] = p3.x; f[8 * k + 7] = p3.y; }
    } else {
        const unsigned w[4] = {r.w.x, r.w.y, r.w.z, r.w.w};
#pragma unroll
        for (int k = 0; k < 4; ++k) { const f32x2 lo = __builtin_amdgcn_cvt_pk_f32_fp8((int)w[k], false), hi = __builtin_amdgcn_cvt_pk_f32_fp8((int)w[k], true);
            f[4 * k] = lo.x; f[4 * k + 1] = lo.y; f[4 * k + 2] = hi.x; f[4 * k + 3] = hi.y; }
    }
}

template <int UF, int VF> __device__ __forceinline__ void peer_chunk_load(RowVec<UF> (&uu)[8], RowVec<VF> (&vv)[8], const unsigned char* U8, const unsigned char* V8, int idr, int c8, int lane) {
#pragma unroll
    for (int q = 0; q < 8; ++q) { const int eid = __builtin_amdgcn_readlane(idr, c8 + q); uu[q] = row_load<UF>(U8, eid, lane); vv[q] = row_load<VF>(V8, eid, lane); }
}
template <int UF, int VF> __device__ __forceinline__ void peer_chunk_compute(const RowVec<UF> (&uu)[8], const RowVec<VF> (&vv)[8], const float (&hf)[16], float (&o)[16], float zs, float as, int c8, int lane) {
    float z[8];
#pragma unroll
    for (int q = 0; q < 8; ++q) { float f[16]; row_decode<UF>(uu[q], f); float a0 = 0.f, a1 = 0.f;
#pragma unroll
        for (int k = 0; k < 8; ++k) { a0 += hf[2 * k] * f[2 * k]; a1 += hf[2 * k + 1] * f[2 * k + 1]; }
        z[q] = a0 + a1; }
    float r1[4], r2[2], r3;
#pragma unroll
    for (int k = 0; k < 4; ++k) { const bool hi1 = lane & 1; const float keep = hi1 ? z[2 * k + 1] : z[2 * k], send = hi1 ? z[2 * k] : z[2 * k + 1]; r1[k] = keep + __shfl_xor(send, 1); }
#pragma unroll
    for (int k = 0; k < 2; ++k) { const bool hi1 = lane & 2; const float keep = hi1 ? r1[2 * k + 1] : r1[2 * k], send = hi1 ? r1[2 * k] : r1[2 * k + 1]; r2[k] = keep + __shfl_xor(send, 2); }
    { const bool hi1 = lane & 4; const float keep = hi1 ? r2[1] : r2[0], send = hi1 ? r2[0] : r2[1]; r3 = keep + __shfl_xor(send, 4); }
    r3 += __shfl_xor(r3, 8); r3 += __shfl_xor(r3, 16); r3 += __shfl_xor(r3, 32);
    const float act = gelu_f(r3 * zs) * as;
#pragma unroll
    for (int q = 0; q < 8; ++q) { const float a = __builtin_bit_cast(float, __builtin_amdgcn_readlane(__builtin_bit_cast(int, act), c8 + q));
        float f[16]; row_decode<VF>(vv[q], f);
#pragma unroll
        for (int k = 0; k < 16; ++k) o[k] += a * f[k]; }
}

typedef _Float16 h2_t __attribute__((ext_vector_type(2)));
template <int CTRL> __device__ __forceinline__ float dppf(float v) { return __builtin_bit_cast(float, __builtin_amdgcn_update_dpp(0, __builtin_bit_cast(int, v), CTRL, 0xF, 0xF, true)); }
__device__ __forceinline__ void peer_chunk_compute4(const RowVec<4> (&uu)[8], const RowVec<4> (&vv)[8], const int (&hq)[4], h2_t (&o2)[8], float zs, float as64, int c8, int lane) {
    float z[8];
#pragma unroll
    for (int q = 0; q < 8; ++q) { const int w0 = (int)uu[q].w.x, w1 = (int)uu[q].w.y;
        int ah = __builtin_amdgcn_sdot8(w0, hq[0], 0, false); ah = __builtin_amdgcn_sdot8(w1, hq[1], ah, false);
        int al = __builtin_amdgcn_sdot8(w0, hq[2], 0, false); al = __builtin_amdgcn_sdot8(w1, hq[3], al, false);
        z[q] = (float)(ah * 16 + al); }
    float r1[4], r2[2], r3;
#pragma unroll
    for (int k = 0; k < 4; ++k) { const bool hi1 = lane & 1; const float keep = hi1 ? z[2 * k + 1] : z[2 * k], send = hi1 ? z[2 * k] : z[2 * k + 1]; r1[k] = keep + dppf<0xB1>(send); }
#pragma unroll
    for (int k = 0; k < 2; ++k) { const bool hi1 = lane & 2; const float keep = hi1 ? r1[2 * k + 1] : r1[2 * k], send = hi1 ? r1[2 * k] : r1[2 * k + 1]; r2[k] = keep + dppf<0x4E>(send); }
    { const bool hi1 = lane & 4; const float keep = hi1 ? r2[1] : r2[0], send = hi1 ? r2[0] : r2[1]; r3 = keep + dppf<0x124>(send); }
    r3 += dppf<0x128>(r3); r3 += __shfl_xor(r3, 16); r3 += __shfl_xor(r3, 32);
    const float act = gelu_f(r3 * zs) * as64;
#pragma unroll
    for (int q = 0; q < 8; ++q) { const float a = __builtin_bit_cast(float, __builtin_amdgcn_readlane(__builtin_bit_cast(int, act), c8 + q));
        const _Float16 ah = (_Float16)a; const h2_t a2 = {ah, ah}; const unsigned w0 = vv[q].w.x, w1 = vv[q].w.y;
        o2[0] = __builtin_amdgcn_cvt_scalef32_pk_f16_fp4(w0, 1.0f, 0) * a2 + o2[0]; o2[1] = __builtin_amdgcn_cvt_scalef32_pk_f16_fp4(w0, 1.0f, 1) * a2 + o2[1];
        o2[2] = __builtin_amdgcn_cvt_scalef32_pk_f16_fp4(w0, 1.0f, 2) * a2 + o2[2]; o2[3] = __builtin_amdgcn_cvt_scalef32_pk_f16_fp4(w0, 1.0f, 3) * a2 + o2[3];
        o2[4] = __builtin_amdgcn_cvt_scalef32_pk_f16_fp4(w1, 1.0f, 0) * a2 + o2[4]; o2[5] = __builtin_amdgcn_cvt_scalef32_pk_f16_fp4(w1, 1.0f, 1) * a2 + o2[5];
        o2[6] = __builtin_amdgcn_cvt_scalef32_pk_f16_fp4(w1, 1.0f, 2) * a2 + o2[6]; o2[7] = __builtin_amdgcn_cvt_scalef32_pk_f16_fp4(w1, 1.0f, 3) * a2 + o2[7]; }
}

struct Params { const float* in[19]; float* out; unsigned char* ws; int ph_lo, ph_hi; };

struct EpiProj {
    static constexpr bool PERM = true;
    bf16_t* P; float* LA; const float* gb;
    __device__ __forceinline__ void operator()(const f32x4 (&acc)[2][2][4][2], const pg8::Unit& u, int wr, int wc, int fr, int fq) const {
        const int row0 = u.pm * 256 + wr * 64 + fr;
        if (u.pn < 8) {
            const int col0 = u.pn * 256 + wc * 32 + 8 * fq;
#pragma unroll
            for (int ai = 0; ai < 2; ++ai)
#pragma unroll
                for (int m = 0; m < 4; ++m) { bf16_t* rowp = P + (size_t)(row0 + ai * 128 + m * 16) * NPROJ + col0;
#pragma unroll
                    for (int bj = 0; bj < 2; ++bj) { const f32x4 v0 = acc[ai][bj][m][0], v1 = acc[ai][bj][m][1];
                        u32x4 w; w.x = pg8::cvt_pk_bf16(v0[0], v0[1]); w.y = pg8::cvt_pk_bf16(v0[2], v0[3]); w.z = pg8::cvt_pk_bf16(v1[0], v1[1]); w.w = pg8::cvt_pk_bf16(v1[2], v1[3]);
                        *(u32x4*)(rowp + bj * 128) = w; } }
        } else {
            const int col0 = wc * 32 + 8 * fq;
            f32x4 bv[2][2];
#pragma unroll
            for (int bj = 0; bj < 2; ++bj)
#pragma unroll
                for (int n = 0; n < 2; ++n) bv[bj][n] = *(const f32x4*)(gb + col0 + bj * 128 + 4 * n);
#pragma unroll
            for (int ai = 0; ai < 2; ++ai)
#pragma unroll
                for (int m = 0; m < 4; ++m) { float* rowp = LA + (size_t)(row0 + ai * 128 + m * 16) * 256 + col0;
#pragma unroll
                    for (int bj = 0; bj < 2; ++bj)
#pragma unroll
                        for (int n = 0; n < 2; ++n) { const f32x4 v = acc[ai][bj][m][n] + bv[bj][n]; f32x4 o;
#pragma unroll
                            for (int j = 0; j < 4; ++j) o[j] = logsig_f(v[j]) * (1.0f / 16.0f);
                            *(f32x4*)(rowp + bj * 128 + 4 * n) = o; } }
        }
    }
};
struct EpiX1 {
    static constexpr bool PERM = false;
    const float* x; float* X1; const float* gate;
    __device__ __forceinline__ void operator()(const f32x4 (&acc)[2][2][4][2], const pg8::Unit& u, int wr, int wc, int fr, int fq) const {
        const int row0 = u.pm * 256 + wr * 64 + fr, col0 = u.pn * 256 + wc * 32 + 4 * fq;
        const float* gp = gate + (u.pm >= 32 ? 6144 : 0);
        f32x4 gv[2][2];
#pragma unroll
        for (int bj = 0; bj < 2; ++bj)
#pragma unroll
            for (int n = 0; n < 2; ++n) gv[bj][n] = *(const f32x4*)(gp + col0 + bj * 128 + n * 16);
#pragma unroll
        for (int ai = 0; ai < 2; ++ai)
#pragma unroll
            for (int m = 0; m < 4; ++m) { const size_t ro = (size_t)(row0 + ai * 128 + m * 16) * D + col0;
#pragma unroll
                for (int bj = 0; bj < 2; ++bj)
#pragma unroll
                    for (int n = 0; n < 2; ++n) { const f32x4 xv = *(const f32x4*)(x + ro + bj * 128 + n * 16);
                        *(f32x4*)(X1 + ro + bj * 128 + n * 16) = xv + gv[bj][n] * acc[ai][bj][m][n]; } }
    }
};
struct EpiQ {
    static constexpr bool PERM = true;
    bf16_t* Q;
    __device__ __forceinline__ void operator()(const f32x4 (&acc)[2][2][4][2], const pg8::Unit& u, int wr, int wc, int fr, int fq) const {
        const int row0 = u.pm * 256 + wr * 64 + fr, col0 = u.pn * 256 + wc * 32 + 8 * fq;
#pragma unroll
        for (int ai = 0; ai < 2; ++ai)
#pragma unroll
            for (int m = 0; m < 4; ++m) { bf16_t* rowp = Q + (size_t)(row0 + ai * 128 + m * 16) * 2048 + col0;
#pragma unroll
                for (int bj = 0; bj < 2; ++bj) { const f32x4 v0 = acc[ai][bj][m][0], v1 = acc[ai][bj][m][1];
                    u32x4 w; w.x = pg8::cvt_pk_bf16(v0[0], v0[1]); w.y = pg8::cvt_pk_bf16(v0[2], v0[3]); w.z = pg8::cvt_pk_bf16(v1[0], v1[1]); w.w = pg8::cvt_pk_bf16(v1[2], v1[3]);
                    *(u32x4*)(rowp + bj * 128) = w; } }
    }
};

__device__ __forceinline__ void transpose_item(const float* W, int ldw, int k0, int n0, bf16_t* WT, int ldt, int row0, LAS float* scr, int lane) {
#pragma unroll 8
    for (int i = 0; i < 32; ++i) { const int kk = 2 * i + (lane >> 5); scr[kk * 33 + (lane & 31)] = W[(size_t)(k0 + kk) * ldw + n0 + (lane & 31)]; }
    asm volatile("s_waitcnt lgkmcnt(0)" ::: "memory");
    const int c = lane & 7;
#pragma unroll
    for (int j = 0; j < 4; ++j) { const int n = (lane >> 3) + 8 * j; const LAS float* s = scr + (8 * c) * 33 + n;
        u32x4 o; o.x = pk2(s[0 * 33], s[1 * 33]); o.y = pk2(s[2 * 33], s[3 * 33]); o.z = pk2(s[4 * 33], s[5 * 33]); o.w = pk2(s[6 * 33], s[7 * 33]);
        *(u32x4*)(WT + (size_t)(row0 + n0 + n) * ldt + k0 + 8 * c) = o; }
    asm volatile("s_waitcnt lgkmcnt(0)" ::: "memory");
}

template <int NR> __device__ __forceinline__ void norm_mod_rows(const float* xbase, int m0, int mstride, const float* g, const float* MODp, int modoff, bf16_t* obase, int lane) {
    f32x4 v[NR][4]; float s[NR];
#pragma unroll
    for (int a = 0; a < NR; ++a) { const float* xrow = xbase + (size_t)(m0 + a * mstride) * D;
#pragma unroll
        for (int j = 0; j < 4; ++j) v[a][j] = *(const f32x4*)(xrow + 4 * lane + 256 * j); }
#pragma unroll
    for (int a = 0; a < NR; ++a) { s[a] = 0.f;
#pragma unroll
        for (int j = 0; j < 4; ++j) s[a] += (v[a][j].x * v[a][j].x + v[a][j].y * v[a][j].y) + (v[a][j].z * v[a][j].z + v[a][j].w * v[a][j].w); }
#pragma unroll
    for (int o = 1; o < 64; o <<= 1)
#pragma unroll
        for (int a = 0; a < NR; ++a) s[a] += __shfl_xor(s[a], o);
#pragma unroll
    for (int a = 0; a < NR; ++a) { const int m = m0 + a * mstride; const float rstd = 1.f / sqrtf(s[a] * (1.f / D) + 1e-6f);
        const float* shift = MODp + (m >= SEQ ? 6144 : 0) + modoff; const float* scale = shift + 1024; bf16_t* orow = obase + (size_t)m * D;
#pragma unroll
        for (int j = 0; j < 4; ++j) { const int c = 4 * lane + 256 * j;
            const f32x4 gg = *(const f32x4*)(g + c), sh = *(const f32x4*)(shift + c), sc = *(const f32x4*)(scale + c);
            const f32x4 y = v[a][j] * rstd * gg * (sc + 1.0f) + sh;
            u32x2 o; o.x = pk2(y.x, y.y); o.y = pk2(y.z, y.w);
            *(u32x2*)(orow + c) = o; } }
}

__constant__ unsigned char CAND_IJ[64] = {
    0x00,0x01,0x02,0x03,0x04,0x05,0x06,0x07,0x08,0x09,0x0a,0x0b,0x0c,0x0d,0x0e,0x0f,
    0x10,0x11,0x12,0x13,0x14,0x15,0x16,0x17,
    0x20,0x21,0x22,0x23,0x24,
    0x30,0x31,0x32,0x33,
    0x40,0x41,0x42,
    0x50,0x51, 0x60,0x61, 0x70,0x71,
    0x80,0x90,0xa0,0xb0,0xc0,0xd0,0xe0,0xf0,
    0,0,0,0,0,0,0,0,0,0,0,0,0,0};

__device__ __forceinline__ unsigned fkey(float f, unsigned idbits, unsigned idmask) {
    unsigned u = __builtin_bit_cast(unsigned, f); u = (u & 0x80000000u) ? ~u : (u | 0x80000000u);
    return (u & ~idmask) | idbits;
}
__device__ __forceinline__ float fkey_val(unsigned key, unsigned idmask) {
    unsigned u = key & ~idmask; u = (u & 0x80000000u) ? (u ^ 0x80000000u) : ~u;
    return __builtin_bit_cast(float, u);
}
template <int CTRL, int ROWMASK> __device__ __forceinline__ unsigned dpp_u(unsigned v) { return (unsigned)__builtin_amdgcn_update_dpp(0, (int)v, CTRL, ROWMASK, 0xF, true); }
template <int CTRL, int ROWMASK> __device__ __forceinline__ float dpp_f(float v) { return __builtin_bit_cast(float, __builtin_amdgcn_update_dpp(0, __builtin_bit_cast(int, v), CTRL, ROWMASK, 0xF, true)); }
__device__ __forceinline__ unsigned umax_(unsigned a, unsigned b) { return a > b ? a : b; }
__device__ __forceinline__ unsigned umin_(unsigned a, unsigned b) { return a < b ? a : b; }
template <int N> __device__ __forceinline__ unsigned ror_u(unsigned v) { return (unsigned)__builtin_amdgcn_update_dpp(0, (int)v, 0x120 + N, 0xF, 0xF, true); }
template <int N> __device__ __forceinline__ float ror_f(float v) { return __builtin_bit_cast(float, __builtin_amdgcn_update_dpp(0, __builtin_bit_cast(int, v), 0x120 + N, 0xF, 0xF, true)); }
__device__ __forceinline__ unsigned row_allmax(unsigned m) { m = umax_(m, ror_u<1>(m)); m = umax_(m, ror_u<2>(m)); m = umax_(m, ror_u<4>(m)); m = umax_(m, ror_u<8>(m)); return m; }
__device__ __forceinline__ float row_allsum(float m) { m += ror_f<1>(m); m += ror_f<2>(m); m += ror_f<4>(m); m += ror_f<8>(m); return m; }

__global__ void __launch_bounds__(NTHR, 2) fwd_kernel(Params p) {
    extern __shared__ __attribute__((aligned(16))) unsigned char lds_raw[];
    LAS unsigned char* lds = (LAS unsigned char*)lds_raw;
    const int tid = threadIdx.x, lane = tid & 63, wave = __builtin_amdgcn_readfirstlane(tid >> 6);
    const int G = gridDim.x, bx = blockIdx.x;
    const int gw = bx * NWAVES + wave, NGW = G * NWAVES;
    unsigned char* ws = p.ws;
    unsigned* ctl = (unsigned*)(ws + WS_CTL);
    float* MOD = (float*)(ws + WS_MOD);
    float* DEC = (float*)(ws + WS_DEC);
    bf16_t* WIN = (bf16_t*)(ws + WS_WIN);
    bf16_t* WOUT = (bf16_t*)(ws + WS_WOUT);
    bf16_t* WQ = (bf16_t*)(ws + WS_WQ);
    bf16_t* KK = (bf16_t*)(ws + WS_KK);
    int* IDX = (int*)(ws + WS_IDX);
    float* GATE = (float*)(ws + WS_GATE);
    float* LOGA = (float*)(ws + WS_LOGA);
    float* KV = (float*)(ws + WS_KV);
    bf16_t* H = (bf16_t*)(ws + WS_H);
    unsigned char* U8 = ws + WS_U8;
    unsigned char* V8 = ws + WS_V8;
    float* SU = (float*)(ws + WS_SU);
    float* SV = (float*)(ws + WS_SV);
    bf16_t* PROJ = (bf16_t*)(ws + WS_PROJ);
    const float* x = p.in[0]; const float* cvec = p.in[1]; const float* ada_w = p.in[2]; const float* ada_b = p.in[3]; const float* norm1_g = p.in[4];
    const float* w_in = p.in[5]; const float* gate_w = p.in[6]; const float* gate_b = p.in[7]; const float* gla_norm_g = p.in[8];
    const float* pool_w = p.in[9]; const float* pool_scale = p.in[10]; const float* w_out = p.in[11]; const float* norm2_g = p.in[12];
    const float* peer_wq = p.in[13]; const float* peer_k1 = p.in[14]; const float* peer_k2 = p.in[15]; const float* peer_u = p.in[16]; const float* peer_v = p.in[17];
    const float* final_g = p.in[18];
    float* X1 = p.out;

    volatile LAS unsigned* MISC = (volatile LAS unsigned*)(lds + MISC_OFF);
    if (tid < 64) MISC[tid] = 0u;
    __syncthreads();
    XcdBarrier bar = xcd_barrier_post(ctl + CW_BAR, MISC + 8);
    const int lo = p.ph_lo, hi = p.ph_hi;
#define IN(k) (lo <= (k) && (k) < hi)
#define REP(k) for (int rep_ = 0; rep_ < 1 + ((DUPMASK >> (k)) & 1); ++rep_)
#define STAMP(i) do { if (TMASK && wave == 0) { unsigned long long t_; asm volatile("s_memrealtime %0\n\ts_waitcnt lgkmcnt(0)" : "=s"(t_) :: "memory"); if (tid == 0) ((volatile LAS unsigned long long*)(lds + MISC_OFF + 64))[i] = t_; } } while (0)
#define SEAM(k) do { if (IN(k) && IN((k) + 1)) xcd_barrier(bar); STAMP((k) + 1); } while (0)
    STAMP(0);

    if (IN(0)) REP(0) {
        {
            LAS float* sc = (LAS float*)lds;
            LAS f32x4* red = (LAS f32x4*)(lds + 8192);
            for (int i = tid; i < 2048; i += NTHR) sc[i] = silu_f(cvec[i]);
            __syncthreads();
            for (int cb = bx; cb < 256; cb += G) {
                if (tid < 384) {
                    const int f4 = tid % 6, rg = tid / 6;
                    f32x4 a0 = {0.f, 0.f, 0.f, 0.f}, a1 = {0.f, 0.f, 0.f, 0.f};
#pragma unroll 4
                    for (int i = 0; i < 16; ++i) { const int r = rg + 64 * i; const f32x4 w = *(const f32x4*)(ada_w + (size_t)r * 6144 + 24 * cb + 4 * f4);
                        a0 += w * sc[r]; a1 += w * sc[1024 + r]; }
                    red[(rg * 6 + f4) * 2 + 0] = a0; red[(rg * 6 + f4) * 2 + 1] = a1;
                }
                __syncthreads();
                if (tid < 48) { const int b = tid / 24, col = tid % 24; float s = 0.f;
                    for (int rg = 0; rg < 64; ++rg) s += red[(rg * 6 + (col >> 2)) * 2 + b][col & 3];
                    MOD[b * 6144 + 24 * cb + col] = s + ada_b[24 * cb + col]; }
                __syncthreads();
            }
        }
        for (int it = bx; it < 128; it += G) {
            const int g = it >> 5, nb = (it >> 1) & 15, cb = it & 1;
            LAS float* PW = (LAS float*)lds;
            LAS float* WO = (LAS float*)(lds + 32768);
            for (int i = tid; i < 64 * 128; i += NTHR) { const int c = i >> 7, j = i & 127; PW[i] = pool_w[(size_t)(g * 128 + cb * 64 + c) * 128 + j] * pool_scale[g * 128 + j]; }
            for (int i = tid; i < 128 * 64; i += NTHR) { const int j = i >> 6, n = i & 63; WO[i] = w_out[(size_t)(512 + g * 128 + j) * 1024 + nb * 64 + n]; }
            __syncthreads();
            const int n = tid & 63, cg = tid >> 6;
            float a[8];
#pragma unroll
            for (int q = 0; q < 8; ++q) a[q] = 0.f;
            for (int j = 0; j < 128; ++j) { const float wo = WO[j * 64 + n];
#pragma unroll
                for (int q = 0; q < 8; ++q) a[q] += PW[(cg * 8 + q) * 128 + j] * wo; }
            u32x4 o; o.x = pk2(a[0], a[1]); o.y = pk2(a[2], a[3]); o.z = pk2(a[4], a[5]); o.w = pk2(a[6], a[7]);
            *(u32x4*)(WOUT + (size_t)(nb * 64 + n) * 1024 + 512 + g * 128 + cb * 64 + cg * 8) = o;
            __syncthreads();
        }
        {
            LAS float* scr = (LAS float*)(lds + wave * 16384);
            constexpr int I_IN = 16 * 64, I_Q = 16 * 64, I_O = 8 * 32;
            for (int it = gw; it < I_IN + I_Q + I_O; it += NGW) {
                int r = it;
                if (r < I_IN) { transpose_item(w_in, INLD, (r >> 6) * 64, (r & 63) * 32, WIN, 1024, 0, scr, lane); continue; } r -= I_IN;
                if (r < I_Q) { transpose_item(peer_wq, 2048, (r >> 6) * 64, (r & 63) * 32, WQ, 1024, 0, scr, lane); continue; } r -= I_Q;
                transpose_item(w_out, 1024, (r >> 5) * 64, (r & 31) * 32, WOUT, 1024, 0, scr, lane);
            }
        }
        for (int i = bx * NTHR + tid; i < 2 * 128 * 128; i += G * NTHR) KK[i] = (bf16_t)f2bf(i < 16384 ? peer_k1[i] : peer_k2[i - 16384]);
    }
    SEAM(0);

    if (IN(1)) REP(1) {
        LAS u32x4* WAPL = (LAS u32x4*)lds;
        LAS float* GWL = (LAS float*)(lds + 32768);
        for (int i = tid; i < 16 * 256; i += NTHR) GWL[i] = gate_w[i];
        {
            const int q = wave >> 1, jb = 2 * (wave & 1);
            unsigned wp[2][8];
#pragma unroll
            for (int p8 = 0; p8 < 8; ++p8) { const int k0 = 4 * lane + 256 * (p8 >> 1) + 2 * (p8 & 1);
                const float* w0 = w_in + (size_t)k0 * INLD + 2048 + 4 * q; const float* w1 = w0 + INLD;
                const f32x4 a = *(const f32x4*)w0, b = *(const f32x4*)w1;
                wp[0][p8] = jb ? pk2(a[2], b[2]) : pk2(a[0], b[0]); wp[1][p8] = jb ? pk2(a[3], b[3]) : pk2(a[1], b[1]); }
#pragma unroll
            for (int j = 0; j < 2; ++j) { const int r = 4 * q + jb + j;
                WAPL[(r * 2 + 0) * 64 + lane] = (u32x4){wp[j][0], wp[j][1], wp[j][2], wp[j][3]}; WAPL[(r * 2 + 1) * 64 + lane] = (u32x4){wp[j][4], wp[j][5], wp[j][6], wp[j][7]}; }
        }
        const f32x4 gb4 = *(const f32x4*)(gate_b + 4 * lane);
        __syncthreads();
        for (int m = gw; m < M; m += NGW) {
            f32x4 v[4]; float ssq = 0.f;
            { const float* xrow = x + (size_t)m * D;
#pragma unroll
                for (int j = 0; j < 4; ++j) { v[j] = *(const f32x4*)(xrow + 4 * lane + 256 * j); ssq += (v[j].x * v[j].x + v[j].y * v[j].y) + (v[j].z * v[j].z + v[j].w * v[j].w); } }
#pragma unroll
            for (int o = 1; o < 64; o <<= 1) ssq += __shfl_xor(ssq, o);
            { const float rstd = 1.f / sqrtf(ssq * (1.f / D) + 1e-6f);
                const float* shift = MOD + (m >= SEQ ? 6144 : 0); const float* scale = shift + 1024; bf16_t* orow = H + (size_t)m * D;
                unsigned yp[8];
#pragma unroll
                for (int j = 0; j < 4; ++j) { const int c = 4 * lane + 256 * j;
                    const f32x4 gg = *(const f32x4*)(norm1_g + c), sh = *(const f32x4*)(shift + c), sc = *(const f32x4*)(scale + c);
                    const f32x4 y = v[j] * rstd * gg * (sc + 1.0f) + sh;
                    yp[2 * j] = pk2(y.x, y.y); yp[2 * j + 1] = pk2(y.z, y.w);
                    u32x2 o; o.x = yp[2 * j]; o.y = yp[2 * j + 1];
                    *(u32x2*)(orow + c) = o; }
                float part[16];
                int wlo = lane; asm volatile("" : "+v"(wlo));
#pragma unroll
                for (int r = 0; r < 16; ++r) { const u32x4 wa = WAPL[(r * 2 + 0) * 64 + wlo], wb = WAPL[(r * 2 + 1) * 64 + wlo]; const unsigned wr[8] = {wa.x, wa.y, wa.z, wa.w, wb.x, wb.y, wb.z, wb.w};
                    float acc = 0.f;
#pragma unroll
                    for (int p8 = 0; p8 < 8; ++p8) acc = __builtin_amdgcn_fdot2_f32_bf16(__builtin_bit_cast(bf16x2_t, yp[p8]), __builtin_bit_cast(bf16x2_t, wr[p8]), acc, false);
                    part[r] = acc;
                    if ((r & 3) == 3) asm volatile("" ::: "memory"); }
                float r1[8], r2[4], r3[2], r4;
#pragma unroll
                for (int k = 0; k < 8; ++k) { const bool hi1 = lane & 1; const float keep = hi1 ? part[2 * k + 1] : part[2 * k], send = hi1 ? part[2 * k] : part[2 * k + 1]; r1[k] = keep + dppf<0xB1>(send); }
#pragma unroll
                for (int k = 0; k < 4; ++k) { const bool hi1 = lane & 2; const float keep = hi1 ? r1[2 * k + 1] : r1[2 * k], send = hi1 ? r1[2 * k] : r1[2 * k + 1]; r2[k] = keep + dppf<0x4E>(send); }
#pragma unroll
                for (int k = 0; k < 2; ++k) { const bool hi1 = lane & 4; const float keep = hi1 ? r2[2 * k + 1] : r2[2 * k], send = hi1 ? r2[2 * k] : r2[2 * k + 1]; r3[k] = keep + dppf<0x124>(send); }
                { const bool hi1 = lane & 8; const float keep = hi1 ? r3[1] : r3[0], send = hi1 ? r3[0] : r3[1]; r4 = keep + dppf<0x128>(send); }
                r4 += __shfl_xor(r4, 16); r4 += __shfl_xor(r4, 32);
                f32x4 lg = gb4;
                int gwo = 4 * lane; asm volatile("" : "+v"(gwo));
#pragma unroll
                for (int r = 0; r < 16; ++r) { const float ar = __builtin_bit_cast(float, __builtin_amdgcn_readlane(__builtin_bit_cast(int, r4), r)); lg += *(const LAS f32x4*)(GWL + r * 256 + gwo) * ar; }
                f32x4 lo;
#pragma unroll
                for (int j = 0; j < 4; ++j) lo[j] = logsig_f(lg[j]) * (1.0f / 16.0f);
                *(f32x4*)(LOGA + (size_t)m * 256 + 4 * lane) = lo;
                asm volatile("" ::: "memory");
            }
        }
    }
    SEAM(1);

    if (IN(2)) REP(2) {
        pg8::Gemm g{H, WIN, M, NIN, D}; pg8::StaticOrder S; S.init(M, NIN, G, bx);
        EpiQ E{PROJ};
        pg8::gemm_phase<EpiQ, pg8::StaticOrder, true, true>(lds, g, S, E);
        for (int r0 = gw; r0 < NEXP; r0 += 4 * NGW) {
            f32x4 v[4][4];
#pragma unroll
            for (int a = 0; a < 4; ++a) { const int r = r0 + a * NGW; if (r < NEXP) { const bool isv = r >= NEXP; const int row = isv ? r - NEXP : r;
                const float* src = (isv ? peer_v : peer_u) + (size_t)row * 1024 + 16 * lane;
#pragma unroll
                for (int q = 0; q < 4; ++q) v[a][q] = *(const f32x4*)(src + 4 * q); } }
#pragma unroll
            for (int a = 0; a < 4; ++a) { const int r = r0 + a * NGW; if (r < NEXP) { const bool isv = r >= NEXP; const int row = isv ? r - NEXP : r;
                float am = 0.f, sq = 0.f;
#pragma unroll
                for (int q = 0; q < 4; ++q) { am = fmaxf(am, fmaxf(fmaxf(fabsf(v[a][q].x), fabsf(v[a][q].y)), fmaxf(fabsf(v[a][q].z), fabsf(v[a][q].w))));
                    sq += (v[a][q].x * v[a][q].x + v[a][q].y * v[a][q].y) + (v[a][q].z * v[a][q].z + v[a][q].w * v[a][q].w); }
#pragma unroll
                for (int off = 1; off < 64; off <<= 1) { am = fmaxf(am, __shfl_xor(am, off)); sq += __shfl_xor(sq, off); }
                unsigned w0 = 0u, w1 = 0u; float sc;
                if (!isv) {
                    const float rms = sqrtf(sq * (1.0f / 1024.0f));
                    sc = rms > 0.f ? rms * (1.0f / 3.0f) : 1.0f; const float inv = 1.0f / sc;
#pragma unroll
                    for (int q = 0; q < 4; ++q)
#pragma unroll
                        for (int j = 0; j < 4; ++j) { const int qi = (int)fminf(fmaxf(rintf(v[a][q][j] * inv), -8.f), 7.f); const unsigned nib = (unsigned)qi & 15u; const int e = 4 * q + j;
                            if (e < 8) w0 |= nib << (4 * e); else w1 |= nib << (4 * (e - 8)); }
                } else {
                    sc = am > 0.f ? am * (1.0f / 6.0f) : 1.0f; const float inv = 1.0f / sc;
                    w0 = __builtin_amdgcn_cvt_scalef32_pk_fp4_f32(w0, v[a][0].x * inv, v[a][0].y * inv, 1.0f, 0); w0 = __builtin_amdgcn_cvt_scalef32_pk_fp4_f32(w0, v[a][0].z * inv, v[a][0].w * inv, 1.0f, 1);
                    w0 = __builtin_amdgcn_cvt_scalef32_pk_fp4_f32(w0, v[a][1].x * inv, v[a][1].y * inv, 1.0f, 2); w0 = __builtin_amdgcn_cvt_scalef32_pk_fp4_f32(w0, v[a][1].z * inv, v[a][1].w * inv, 1.0f, 3);
                    w1 = __builtin_amdgcn_cvt_scalef32_pk_fp4_f32(w1, v[a][2].x * inv, v[a][2].y * inv, 1.0f, 0); w1 = __builtin_amdgcn_cvt_scalef32_pk_fp4_f32(w1, v[a][2].z * inv, v[a][2].w * inv, 1.0f, 1);
                    w1 = __builtin_amdgcn_cvt_scalef32_pk_fp4_f32(w1, v[a][3].x * inv, v[a][3].y * inv, 1.0f, 2); w1 = __builtin_amdgcn_cvt_scalef32_pk_fp4_f32(w1, v[a][3].z * inv, v[a][3].w * inv, 1.0f, 3);
                }
                u32x2 o; o.x = w0; o.y = w1;
                *(u32x2*)((isv ? V8 : U8) + (size_t)row * 512 + 8 * lane) = o;
                if (lane == 0) (isv ? SV : SU)[row] = sc; } }
        }
    }
    SEAM(2);

    if (IN(3)) REP(3) {
        const int hb = tid >> 8, ht = tid & 255, hw = wave & 3, fr = lane & 15, fq = lane >> 4;
        LAS unsigned char* hbase = lds + hb * 49152;
        LAS float* LAT = (LAS float*)hbase;
        LAS float* SEG = (LAS float*)(hbase + 16640);
        LAS bf16_t* VT = (LAS bf16_t*)(hbase + 17664);
        LAS bf16_t* KT = (LAS bf16_t*)(hbase + 36096);
        for (int it = 0; it < (NUNIT + 2 * G - 1) / (2 * G); ++it) {
            const int u = (it * G + bx) * 2 + hb;
            const bool act = u < NUNIT;
            const int h = u & 3, t0 = (u >> 2) * 64;
            const int c = ht & 63, dc = ht >> 6;
            u32x4 kq0, kq1, vq[4];
            if (act) {
                const float* la = LOGA + (size_t)(t0 + c) * 256 + h * 64 + dc * 16;
                const bf16_t* kp = PROJ + (size_t)(t0 + c) * NPROJ + 256 + h * 64 + dc * 16;
                const bf16_t* vp = PROJ + (size_t)(t0 + c) * NPROJ + 512 + h * 128 + dc * 32;
                f32x4 lv[4];
#pragma unroll
                for (int q = 0; q < 4; ++q) lv[q] = *(const f32x4*)(la + 4 * q);
                kq0 = *(const u32x4*)kp; kq1 = *(const u32x4*)(kp + 8);
#pragma unroll
                for (int q = 0; q < 4; ++q) vq[q] = *(const u32x4*)(vp + 8 * q);
#pragma unroll
                for (int q = 0; q < 4; ++q)
#pragma unroll
                    for (int j = 0; j < 4; ++j) LAT[(dc * 16 + q * 4 + j) * 65 + c] = lv[q][j];
            }
            __syncthreads();
            float loc[16];
            { const int d = ht & 63, seg = ht >> 6; float run = 0.f;
#pragma unroll
                for (int r = 0; r < 16; ++r) { run += LAT[d * 65 + 16 * seg + r]; loc[r] = run; }
                SEG[seg * 64 + d] = run; }
            __syncthreads();
            { const int d = ht & 63, seg = ht >> 6; float pre = 0.f;
#pragma unroll
                for (int s2 = 0; s2 < 3; ++s2) pre += (s2 < seg) ? SEG[s2 * 64 + d] : 0.f;
#pragma unroll
                for (int r = 0; r < 16; ++r) LAT[d * 65 + 16 * seg + r] = pre + loc[r];
                if (act && seg == 3) DEC[u * 64 + d] = __expf(pre + loc[15]); }
            __syncthreads();
            if (act) {
                const unsigned kw[8] = {kq0.x, kq0.y, kq0.z, kq0.w, kq1.x, kq1.y, kq1.z, kq1.w};
#pragma unroll
                for (int q = 0; q < 8; ++q) { const int d = dc * 16 + 2 * q;
                    KT[d * 72 + c] = (bf16_t)f2bf(bflo(kw[q]) * __expf(LAT[d * 65 + 63] - LAT[d * 65 + c]));
                    KT[(d + 1) * 72 + c] = (bf16_t)f2bf(bfhi(kw[q]) * __expf(LAT[(d + 1) * 65 + 63] - LAT[(d + 1) * 65 + c])); }
#pragma unroll
                for (int q = 0; q < 4; ++q) { const unsigned vw[4] = {vq[q].x, vq[q].y, vq[q].z, vq[q].w};
#pragma unroll
                    for (int j = 0; j < 4; ++j) { const int v = dc * 32 + 8 * q + 2 * j; VT[v * 72 + c] = (bf16_t)(vw[j] & 0xffffu); VT[(v + 1) * 72 + c] = (bf16_t)(vw[j] >> 16); } }
            }
            __syncthreads();
            if (act) {
#pragma unroll
                for (int mt2 = 0; mt2 < 2; ++mt2) { const int mt = 2 * hw + mt2;
                    const bf16x8 a0 = *(const LAS bf16x8*)(VT + (16 * mt + fr) * 72 + 8 * fq), a1 = *(const LAS bf16x8*)(VT + (16 * mt + fr) * 72 + 32 + 8 * fq);
#pragma unroll
                    for (int nt = 0; nt < 4; ++nt) {
                        const bf16x8 b0 = *(const LAS bf16x8*)(KT + (16 * nt + fr) * 72 + 8 * fq), b1 = *(const LAS bf16x8*)(KT + (16 * nt + fr) * 72 + 32 + 8 * fq);
                        f32x4 acc = {0.f, 0.f, 0.f, 0.f};
                        acc = __builtin_amdgcn_mfma_f32_16x16x32_bf16(a0, b0, acc, 0, 0, 0); acc = __builtin_amdgcn_mfma_f32_16x16x32_bf16(a1, b1, acc, 0, 0, 0);
                        float* kvp = KV + (size_t)u * 8192 + (16 * mt + 4 * fq) * 64 + 16 * nt + fr;
#pragma unroll
                        for (int r = 0; r < 4; ++r) kvp[r * 64] = acc[r]; } }
            }
            __syncthreads();
        }
    }
    SEAM(3);

    if (IN(4)) REP(4) {
        const int nsb = (8 * 8192 + NTHR - 1) / NTHR;
        const bool dopool = (G > nsb) ? (bx >= nsb) : true;
        const int pbx = (G > nsb) ? bx - nsb : bx, pG = (G > nsb) ? G - nsb : G;
        if (dopool) {
        for (int it = pbx * NTHR + tid; it < (M / 8) * 64; it += pG * NTHR) {
            const int cv = it & 63, run = it >> 6, ch = cv * 8, gq = ch >> 7, w = 2 << gq;
            const int t0 = run * 8, pos0 = t0 & (SEQ - 1);
            const bf16_t* pp = PROJ + 1536 + ch;
            float s[8];
#pragma unroll
            for (int j = 0; j < 8; ++j) s[j] = 0.f;
            for (int q = 1; q <= w; ++q) if (pos0 - q >= 0) { const u32x4 v = *(const u32x4*)(pp + (size_t)(t0 - q) * NPROJ);
                s[0] += bflo(v.x); s[1] += bfhi(v.x); s[2] += bflo(v.y); s[3] += bfhi(v.y); s[4] += bflo(v.z); s[5] += bfhi(v.z); s[6] += bflo(v.w); s[7] += bfhi(v.w); }
            for (int r = 0; r < 8; ++r) {
                const int t = t0 + r, pos = pos0 + r;
                const u32x4 v = *(const u32x4*)(pp + (size_t)t * NPROJ);
                const float cur[8] = {bflo(v.x), bfhi(v.x), bflo(v.y), bfhi(v.y), bflo(v.z), bfhi(v.z), bflo(v.w), bfhi(v.w)};
#pragma unroll
                for (int j = 0; j < 8; ++j) s[j] += cur[j];
                if (pos >= w) { const u32x4 o = *(const u32x4*)(pp + (size_t)(t - w) * NPROJ);
                    s[0] -= bflo(o.x); s[1] -= bfhi(o.x); s[2] -= bflo(o.y); s[3] -= bfhi(o.y); s[4] -= bflo(o.z); s[5] -= bfhi(o.z); s[6] -= bflo(o.w); s[7] -= bfhi(o.w); }
                const float inv = 1.f / (float)((pos + 1) < w ? (pos + 1) : w);
                u32x4 ov; ov.x = pk2(s[0] * inv - cur[0], s[1] * inv - cur[1]); ov.y = pk2(s[2] * inv - cur[2], s[3] * inv - cur[3]);
                ov.z = pk2(s[4] * inv - cur[4], s[5] * inv - cur[5]); ov.w = pk2(s[6] * inv - cur[6], s[7] * inv - cur[7]);
                *(u32x4*)(H + (size_t)t * D + 512 + ch) = ov;
            }
        }
        for (int r0 = NEXP + pbx * NWAVES + wave; r0 < 2 * NEXP; r0 += 4 * pG * NWAVES) {
            f32x4 v[4][4];
#pragma unroll
            for (int a = 0; a < 4; ++a) { const int r = r0 + a * pG * NWAVES; if (r < 2 * NEXP) { const bool isv = r >= NEXP; const int row = isv ? r - NEXP : r;
                const float* src = (isv ? peer_v : peer_u) + (size_t)row * 1024 + 16 * lane;
#pragma unroll
                for (int q = 0; q < 4; ++q) v[a][q] = *(const f32x4*)(src + 4 * q); } }
#pragma unroll
            for (int a = 0; a < 4; ++a) { const int r = r0 + a * pG * NWAVES; if (r < 2 * NEXP) { const bool isv = r >= NEXP; const int row = isv ? r - NEXP : r;
                float am = 0.f, sq = 0.f;
#pragma unroll
                for (int q = 0; q < 4; ++q) { am = fmaxf(am, fmaxf(fmaxf(fabsf(v[a][q].x), fabsf(v[a][q].y)), fmaxf(fabsf(v[a][q].z), fabsf(v[a][q].w))));
                    sq += (v[a][q].x * v[a][q].x + v[a][q].y * v[a][q].y) + (v[a][q].z * v[a][q].z + v[a][q].w * v[a][q].w); }
#pragma unroll
                for (int off = 1; off < 64; off <<= 1) { am = fmaxf(am, __shfl_xor(am, off)); sq += __shfl_xor(sq, off); }
                unsigned w0 = 0u, w1 = 0u; float sc;
                if (!isv) {
                    const float rms = sqrtf(sq * (1.0f / 1024.0f));
                    sc = rms > 0.f ? rms * (1.0f / 3.0f) : 1.0f; const float inv = 1.0f / sc;
#pragma unroll
                    for (int q = 0; q < 4; ++q)
#pragma unroll
                        for (int j = 0; j < 4; ++j) { const int qi = (int)fminf(fmaxf(rintf(v[a][q][j] * inv), -8.f), 7.f); const unsigned nib = (unsigned)qi & 15u; const int e = 4 * q + j;
                            if (e < 8) w0 |= nib << (4 * e); else w1 |= nib << (4 * (e - 8)); }
                } else {
                    sc = am > 0.f ? am * (1.0f / 6.0f) : 1.0f; const float inv = 1.0f / sc;
                    w0 = __builtin_amdgcn_cvt_scalef32_pk_fp4_f32(w0, v[a][0].x * inv, v[a][0].y * inv, 1.0f, 0); w0 = __builtin_amdgcn_cvt_scalef32_pk_fp4_f32(w0, v[a][0].z * inv, v[a][0].w * inv, 1.0f, 1);
                    w0 = __builtin_amdgcn_cvt_scalef32_pk_fp4_f32(w0, v[a][1].x * inv, v[a][1].y * inv, 1.0f, 2); w0 = __builtin_amdgcn_cvt_scalef32_pk_fp4_f32(w0, v[a][1].z * inv, v[a][1].w * inv, 1.0f, 3);
                    w1 = __builtin_amdgcn_cvt_scalef32_pk_fp4_f32(w1, v[a][2].x * inv, v[a][2].y * inv, 1.0f, 0); w1 = __builtin_amdgcn_cvt_scalef32_pk_fp4_f32(w1, v[a][2].z * inv, v[a][2].w * inv, 1.0f, 1);
                    w1 = __builtin_amdgcn_cvt_scalef32_pk_fp4_f32(w1, v[a][3].x * inv, v[a][3].y * inv, 1.0f, 2); w1 = __builtin_amdgcn_cvt_scalef32_pk_fp4_f32(w1, v[a][3].z * inv, v[a][3].w * inv, 1.0f, 3);
                }
                u32x2 o; o.x = w0; o.y = w1;
                *(u32x2*)((isv ? V8 : U8) + (size_t)row * 512 + 8 * lane) = o;
                if (lane == 0) (isv ? SV : SU)[row] = sc; } }
        }
        }
        for (int sq = bx * NTHR + tid; sq < 8 * 8192; sq += G * NTHR) {
            const int bh = sq >> 13, e = sq & 8191, b = bh >> 2, h = bh & 3, d = e & 63;
            float st = 0.f;
            for (int n0 = 0; n0 < 128; n0 += 32) {
                float kv[32], dc[32];
#pragma unroll
                for (int q = 0; q < 32; ++q) { const int u = ((b * 128 + n0 + q) * 4 + h); kv[q] = KV[(size_t)u * 8192 + e]; dc[q] = DEC[u * 64 + d]; }
#pragma unroll
                for (int q = 0; q < 32; ++q) { const int u = ((b * 128 + n0 + q) * 4 + h); KV[(size_t)u * 8192 + e] = st; st = st * dc[q] + kv[q]; }
            }
        }
    }
    SEAM(4);

    if (IN(5)) REP(5) {
        LAS float* LAT = (LAS float*)lds;
        LAS float* SEG = (LAS float*)(lds + 16640);
        LAS bf16_t* A2 = (LAS bf16_t*)(lds + 18688);
        LAS bf16_t* KI = (LAS bf16_t*)(lds + 36096);
        LAS bf16_t* BT = (LAS bf16_t*)(lds + 45312);
        LAS float* OL = (LAS float*)(lds + 80128);
        const int fr = lane & 15, fq = lane >> 4;
        for (int u = bx; u < NUNIT; u += G) {
            const int h = u & 3, t0 = (u >> 2) * 64;
            const int i = tid & 63, dc = tid >> 6;
            const float* la = LOGA + (size_t)(t0 + i) * 256 + h * 64 + dc * 8;
            const bf16_t* qp = PROJ + (size_t)(t0 + i) * NPROJ + h * 64 + dc * 8;
            const bf16_t* vp = PROJ + (size_t)(t0 + i) * NPROJ + 512 + h * 128 + dc * 16;
            const float* sp = KV + (size_t)u * 8192;
            const f32x4 la0 = *(const f32x4*)la, la1 = *(const f32x4*)(la + 4);
            const u32x4 qv = *(const u32x4*)qp, kv = *(const u32x4*)(qp + 256), vv0 = *(const u32x4*)vp, vv1 = *(const u32x4*)(vp + 8);
            f32x4 sv[4];
#pragma unroll
            for (int q = 0; q < 4; ++q) sv[q] = *(const f32x4*)(sp + (q * NTHR + tid) * 4);
#pragma unroll
            for (int j = 0; j < 4; ++j) { LAT[(dc * 8 + j) * 65 + i] = la0[j]; LAT[(dc * 8 + 4 + j) * 65 + i] = la1[j]; }
            __syncthreads();
            float loc[8];
            { const int d = tid & 63, seg = tid >> 6; float run = 0.f;
#pragma unroll
                for (int r = 0; r < 8; ++r) { run += LAT[d * 65 + 8 * seg + r]; loc[r] = run; }
                SEG[seg * 64 + d] = run; }
            __syncthreads();
            { const int d = tid & 63, seg = tid >> 6; float pre = 0.f;
#pragma unroll
                for (int s2 = 0; s2 < 7; ++s2) pre += (s2 < seg) ? SEG[s2 * 64 + d] : 0.f;
#pragma unroll
                for (int r = 0; r < 8; ++r) LAT[d * 65 + 8 * seg + r] = pre + loc[r]; }
            __syncthreads();
            {
                const unsigned qw[4] = {qv.x, qv.y, qv.z, qv.w}, kw[4] = {kv.x, kv.y, kv.z, kv.w};
                u32x4 qo, ko; unsigned* qop = (unsigned*)&qo; unsigned* kop = (unsigned*)&ko;
#pragma unroll
                for (int q = 0; q < 4; ++q) { const int d = dc * 8 + 2 * q; const float b0 = LAT[d * 65 + i], b1 = LAT[(d + 1) * 65 + i];
                    qop[q] = pk2(bflo(qw[q]) * __expf(b0) * 0.125f, bfhi(qw[q]) * __expf(b1) * 0.125f);
                    kop[q] = pk2(bflo(kw[q]) * __expf(-b0), bfhi(kw[q]) * __expf(-b1)); }
                *(LAS u32x4*)(A2 + i * 136 + 64 + dc * 8) = qo;
                *(LAS u32x4*)(KI + i * 72 + dc * 8) = ko;
                const unsigned vw[8] = {vv0.x, vv0.y, vv0.z, vv0.w, vv1.x, vv1.y, vv1.z, vv1.w};
#pragma unroll
                for (int j = 0; j < 8; ++j) { const int v = dc * 16 + 2 * j; BT[v * 136 + i] = (bf16_t)(vw[j] & 0xffffu); BT[(v + 1) * 136 + i] = (bf16_t)(vw[j] >> 16); }
#pragma unroll
                for (int q = 0; q < 4; ++q) { const int e = (q * NTHR + tid) * 4, v = e >> 6, d = e & 63;
                    u32x2 so; so.x = pk2(sv[q].x, sv[q].y); so.y = pk2(sv[q].z, sv[q].w);
                    *(LAS u32x2*)(BT + v * 136 + 64 + d) = so; }
            }
            __syncthreads();
            {
                const int mt = wave & 3;
                const bf16x8 a0 = *(const LAS bf16x8*)(A2 + (16 * mt + fr) * 136 + 64 + 8 * fq), a1 = *(const LAS bf16x8*)(A2 + (16 * mt + fr) * 136 + 96 + 8 * fq);
#pragma unroll
                for (int n2 = 0; n2 < 2; ++n2) { const int nt = 2 * (wave >> 2) + n2;
                    const bf16x8 b0 = *(const LAS bf16x8*)(KI + (16 * nt + fr) * 72 + 8 * fq), b1 = *(const LAS bf16x8*)(KI + (16 * nt + fr) * 72 + 32 + 8 * fq);
                    f32x4 acc = {0.f, 0.f, 0.f, 0.f};
                    acc = __builtin_amdgcn_mfma_f32_16x16x32_bf16(a0, b0, acc, 0, 0, 0); acc = __builtin_amdgcn_mfma_f32_16x16x32_bf16(a1, b1, acc, 0, 0, 0);
                    const int jj = 16 * nt + fr;
#pragma unroll
                    for (int r = 0; r < 4; ++r) { const int ii = 16 * mt + 4 * fq + r; A2[ii * 136 + jj] = (bf16_t)f2bf(jj <= ii ? acc[r] : 0.f); } }
            }
            __syncthreads();
            {
                const int mt = wave & 3;
                bf16x8 af[4];
#pragma unroll
                for (int ks = 0; ks < 4; ++ks) af[ks] = *(const LAS bf16x8*)(A2 + (16 * mt + fr) * 136 + 32 * ks + 8 * fq);
#pragma unroll
                for (int n4 = 0; n4 < 4; ++n4) { const int nt = 4 * (wave >> 2) + n4;
                    f32x4 acc = {0.f, 0.f, 0.f, 0.f};
#pragma unroll
                    for (int ks = 0; ks < 4; ++ks) { const bf16x8 bb = *(const LAS bf16x8*)(BT + (16 * nt + fr) * 136 + 32 * ks + 8 * fq); acc = __builtin_amdgcn_mfma_f32_16x16x32_bf16(af[ks], bb, acc, 0, 0, 0); }
#pragma unroll
                    for (int r = 0; r < 4; ++r) OL[(16 * mt + 4 * fq + r) * 132 + 16 * nt + fr] = acc[r]; }
            }
            __syncthreads();
            {
                const int ti = tid >> 3, vc = tid & 7;
                f32x4 o[4]; float ss = 0.f;
#pragma unroll
                for (int q = 0; q < 4; ++q) { o[q] = *(const LAS f32x4*)(OL + ti * 132 + 16 * vc + 4 * q); ss += (o[q].x * o[q].x + o[q].y * o[q].y) + (o[q].z * o[q].z + o[q].w * o[q].w); }
                ss += __shfl_xor(ss, 1); ss += __shfl_xor(ss, 2); ss += __shfl_xor(ss, 4);
                const float rstd = 1.f / sqrtf(ss * (1.f / 128.f) + 1e-6f);
                const int t = t0 + ti;
                const bf16_t* gp = PROJ + (size_t)t * NPROJ + 1024 + h * 128 + 16 * vc;
                const u32x4 g0 = *(const u32x4*)gp, g1 = *(const u32x4*)(gp + 8);
                const unsigned gw8[8] = {g0.x, g0.y, g0.z, g0.w, g1.x, g1.y, g1.z, g1.w};
                unsigned ow[8];
#pragma unroll
                for (int q = 0; q < 4; ++q) { const f32x4 gn = *(const f32x4*)(gla_norm_g + 16 * vc + 4 * q);
                    const float y0 = o[q].x * rstd * gn.x * silu_f(bflo(gw8[2 * q])), y1 = o[q].y * rstd * gn.y * silu_f(bfhi(gw8[2 * q]));
                    const float y2 = o[q].z * rstd * gn.z * silu_f(bflo(gw8[2 * q + 1])), y3 = o[q].w * rstd * gn.w * silu_f(bfhi(gw8[2 * q + 1]));
                    ow[2 * q] = pk2(y0, y1); ow[2 * q + 1] = pk2(y2, y3); }
                bf16_t* hp2 = H + (size_t)t * D + h * 128 + 16 * vc;
                *(u32x4*)hp2 = (u32x4){ow[0], ow[1], ow[2], ow[3]}; *(u32x4*)(hp2 + 8) = (u32x4){ow[4], ow[5], ow[6], ow[7]};
            }
        }
    }
    SEAM(5);

    if (IN(6)) REP(6) {
        pg8::Gemm g{H, WOUT, M, D, D}; pg8::StaticOrder S; S.init(M, D, G, bx);
        EpiX1 E{x, X1, MOD + 2048};
        pg8::gemm_phase<EpiX1, pg8::StaticOrder, true, true>(lds, g, S, E);
    }
    SEAM(6);

    if (IN(7)) REP(7) {
        for (int m = gw; m < M; m += 4 * NGW) norm_mod_rows<4>(X1, m, NGW, norm2_g, MOD, 3072, H, lane);
    }
    SEAM(7);

    if (IN(8)) REP(8) {
        pg8::Gemm g{H, WQ, M, 2048, D}; pg8::StaticOrder S; S.init(M, 2048, G, bx);
        EpiQ E{PROJ};
        pg8::gemm_phase<EpiQ, pg8::StaticOrder, true, true>(lds, g, S, E);
    }
    SEAM(8);

    if (IN(9)) REP(9) {
        LAS bf16_t* KL = (LAS bf16_t*)lds;
        LAS unsigned char* CT = lds + 69632;
        for (int i = tid; i < 2 * 128 * 16; i += NTHR) { const int row = i >> 4, ck = i & 15; *(LAS u32x4*)(KL + row * 136 + ck * 8) = *(const u32x4*)(KK + row * 128 + ck * 8); }
        if (tid < 64) CT[tid] = CAND_IJ[tid];
        __syncthreads();
        const int fr = lane & 15, fq = lane >> 4, rb4 = (lane & 48) * 4;
        int cia[4], cja[4];
#pragma unroll
        for (int sl = 0; sl < 4; ++sl) { const unsigned ij = CAND_IJ[fr * 4 + sl]; cia[sl] = rb4 + 4 * (int)(ij >> 4); cja[sl] = rb4 + 4 * (int)(ij & 15); }
        const bf16_t* Q = PROJ;
        for (int wi = gw; wi < (M / 16) * 8; wi += NGW) {
            const int h = wi & 7, t0 = (wi >> 3) * 16;
            unsigned kk[8][8];
#pragma unroll
            for (int half = 0; half < 2; ++half) {
                const bf16_t* qp = Q + (size_t)(t0 + fr) * 2048 + h * 256 + half * 128 + fq * 8;
                bf16x8 af[4];
#pragma unroll
                for (int ks = 0; ks < 4; ++ks) af[ks] = *(const bf16x8*)(qp + ks * 32);
                int kboff = half * 128 * 136 + fr * 136 + fq * 8;
                asm volatile("" : "+v"(kboff));
                const LAS bf16_t* kb = KL + kboff;
#pragma unroll
                for (int nt = 0; nt < 8; ++nt) {
                    f32x4 c = {0.f, 0.f, 0.f, 0.f};
#pragma unroll
                    for (int ks = 0; ks < 4; ++ks) { const bf16x8 bf = *(const LAS bf16x8*)(kb + nt * 16 * 136 + ks * 32); c = __builtin_amdgcn_mfma_f32_16x16x32_bf16(af[ks], bf, c, 0, 0, 0); }
#pragma unroll
                    for (int r = 0; r < 4; ++r) kk[half * 4 + r][nt] = fkey(c[r], 127u - (unsigned)(nt * 16 + fr), 127u);
                }
            }
#define CE(a, b) do { const unsigned hi_ = umax_(kx[a], kx[b]), lo_ = umin_(kx[a], kx[b]); kx[a] = hi_; kx[b] = lo_; } while (0)
#pragma unroll
            for (int x = 0; x < 8; ++x) { unsigned (&kx)[8] = kk[x];
                CE(0, 1); CE(2, 3); CE(4, 5); CE(6, 7); CE(0, 2); CE(1, 3); CE(4, 6); CE(5, 7); CE(1, 2); CE(5, 6);
                CE(0, 4); CE(1, 5); CE(2, 6); CE(3, 7); CE(2, 4); CE(3, 5); CE(1, 2); CE(3, 4); CE(5, 6); }
            unsigned res[8];
#pragma unroll
            for (int x = 0; x < 8; ++x) res[x] = 0u;
#pragma unroll 1
            for (int rd = 0; rd < 16; ++rd)
#pragma unroll
                for (int x = 0; x < 8; ++x) { unsigned (&kx)[8] = kk[x];
                    const unsigned m = row_allmax(kx[0]); const bool own = kx[0] == m;
#pragma unroll
                    for (int j = 0; j < 7; ++j) kx[j] = own ? kx[j + 1] : kx[j];
                    kx[7] = own ? 0u : kx[7];
                    res[x] = (fr == rd) ? m : res[x]; }
            unsigned ck[4][4];
#pragma unroll
            for (int r = 0; r < 4; ++r)
#pragma unroll
                for (int sl = 0; sl < 4; ++sl) { const unsigned va = __builtin_amdgcn_ds_bpermute(cia[sl], res[r]), vb = __builtin_amdgcn_ds_bpermute(cja[sl], res[4 + r]);
                    const float sum = fkey_val(va, 127u) + fkey_val(vb, 127u);
                    ck[r][sl] = (fr * 4 + sl < 50) ? fkey(sum, 63u - (unsigned)(fr * 4 + sl), 63u) : 0u; }
#pragma unroll
            for (int r = 0; r < 4; ++r) { unsigned (&kx)[4] = ck[r]; CE(0, 1); CE(2, 3); CE(0, 2); CE(1, 3); CE(1, 2); }
#undef CE
            unsigned res3[4], mfirst[4];
#pragma unroll
            for (int r = 0; r < 4; ++r) { res3[r] = 0u; mfirst[r] = 0u; }
#pragma unroll 1
            for (int rd = 0; rd < 16; ++rd)
#pragma unroll
                for (int r = 0; r < 4; ++r) { unsigned (&kx)[4] = ck[r];
                    const unsigned m = row_allmax(kx[0]); const bool own = kx[0] == m;
                    kx[0] = own ? kx[1] : kx[0]; kx[1] = own ? kx[2] : kx[1]; kx[2] = own ? kx[3] : kx[2]; kx[3] = own ? 0u : kx[3];
                    res3[r] = (fr == rd) ? m : res3[r]; mfirst[r] = (rd == 0) ? m : mfirst[r]; }
#pragma unroll
            for (int r = 0; r < 4; ++r) {
                const unsigned cidx = 63u - (res3[r] & 63u);
                const unsigned ij = CT[cidx];
                const unsigned wa = __builtin_amdgcn_ds_bpermute(rb4 + 4 * (int)(ij >> 4), res[r]), wb = __builtin_amdgcn_ds_bpermute(rb4 + 4 * (int)(ij & 15), res[4 + r]);
                const int eid = (int)((127u - (wa & 127u)) * 128u + (127u - (wb & 127u)));
                const float ex = __expf(fkey_val(res3[r], 63u) - fkey_val(mfirst[r], 63u));
                const float tot = row_allsum(ex);
                const size_t o = (size_t)(t0 + 4 * fq + r) * 128 + h * 16 + fr;
                IDX[o] = eid; GATE[o] = ex / tot;
            }
        }
    }
    SEAM(9);

    if (IN(10)) REP(10) {
        struct TokMeta { int id0, id1; float zs0, zs1, as0, as1; u32x4 ha, hb; };
#define P10_META(mm, tt) do { const size_t t_ = (size_t)(tt); (mm).id0 = IDX[t_ * 128 + lane]; (mm).id1 = IDX[t_ * 128 + 64 + lane]; \
            (mm).zs0 = SU[(mm).id0]; (mm).zs1 = SU[(mm).id1]; (mm).as0 = GATE[t_ * 128 + lane] * SV[(mm).id0] * 64.f; (mm).as1 = GATE[t_ * 128 + 64 + lane] * SV[(mm).id1] * 64.f; \
            const bf16_t* hp_ = H + t_ * D + 16 * lane; (mm).ha = *(const u32x4*)hp_; (mm).hb = *(const u32x4*)(hp_ + 8); } while (0)
#define P10_LOAD(ub, vb, mm, cc) peer_chunk_load<4, 4>(ub, vb, U8, V8, ((cc) & 8) ? (mm).id1 : (mm).id0, (8 * (cc)) & 63, lane)
#define P10_COMP(ub, vb, cc) peer_chunk_compute4(ub, vb, hh, o2, (((cc) & 8) ? cur.zs1 : cur.zs0) * hscale, ((cc) & 8) ? cur.as1 : cur.as0, (8 * (cc)) & 63, lane)
        int t = gw;
        if (t < M) {
            TokMeta cur, nxt;
            P10_META(cur, t);
            { const int tn = (t + NGW < M) ? t + NGW : t; P10_META(nxt, tn); }
            RowVec<4> u0[8], u1[8], u2[8], u3[8], v0[8], v1[8], v2[8], v3[8];
            P10_LOAD(u0, v0, cur, 0); P10_LOAD(u1, v1, cur, 1); P10_LOAD(u2, v2, cur, 2);
            for (; t < M; t += NGW) {
                h2_t o2[8]; int hh[4]; float hscale;
                {
                    const unsigned hwv[8] = {cur.ha.x, cur.ha.y, cur.ha.z, cur.ha.w, cur.hb.x, cur.hb.y, cur.hb.z, cur.hb.w};
                    float hf[16], am = 0.f;
#pragma unroll
                    for (int k = 0; k < 8; ++k) { hf[2 * k] = bflo(hwv[k]); hf[2 * k + 1] = bfhi(hwv[k]); am = fmaxf(am, fmaxf(fabsf(hf[2 * k]), fabsf(hf[2 * k + 1]))); o2[k] = (h2_t){(_Float16)0.f, (_Float16)0.f}; }
#pragma unroll
                    for (int off = 1; off < 64; off <<= 1) am = fmaxf(am, __shfl_xor(am, off));
                    hscale = am > 0.f ? am * (1.0f / 119.0f) : 1.0f; const float hinv = 1.0f / hscale;
                    unsigned ph0 = 0u, ph1 = 0u, pl0 = 0u, pl1 = 0u;
#pragma unroll
                    for (int e = 0; e < 16; ++e) { const int hi8 = (int)rintf(hf[e] * hinv); const int lo = ((hi8 + 8) & 15) - 8, hi = (hi8 - lo) >> 4;
                        if (e < 8) { ph0 |= ((unsigned)hi & 15u) << (4 * e); pl0 |= ((unsigned)lo & 15u) << (4 * e); } else { ph1 |= ((unsigned)hi & 15u) << (4 * (e - 8)); pl1 |= ((unsigned)lo & 15u) << (4 * (e - 8)); } }
                    hh[0] = (int)ph0; hh[1] = (int)ph1; hh[2] = (int)pl0; hh[3] = (int)pl1;
                }
#pragma unroll 1
                for (int g4 = 0; g4 < 12; g4 += 4) {
                    P10_LOAD(u3, v3, cur, g4 + 3); P10_COMP(u0, v0, g4);
                    P10_LOAD(u0, v0, cur, g4 + 4); P10_COMP(u1, v1, g4 + 1);
                    P10_LOAD(u1, v1, cur, g4 + 5); P10_COMP(u2, v2, g4 + 2);
                    P10_LOAD(u2, v2, cur, g4 + 6); P10_COMP(u3, v3, g4 + 3);
                }
                const float* g2p = MOD + (t >= SEQ ? 6144 : 0) + 5120 + 16 * lane;
                float* xr = X1 + (size_t)t * D + 16 * lane;
                f32x4 xv[4];
#pragma unroll
                for (int q = 0; q < 4; ++q) xv[q] = *(const f32x4*)(xr + 4 * q);
                P10_LOAD(u3, v3, cur, 15); P10_COMP(u0, v0, 12);
                P10_LOAD(u0, v0, nxt, 0); P10_COMP(u1, v1, 13);
                P10_LOAD(u1, v1, nxt, 1); P10_COMP(u2, v2, 14);
                P10_LOAD(u2, v2, nxt, 2); P10_COMP(u3, v3, 15);
                float ss = 0.f;
#pragma unroll
                for (int q = 0; q < 4; ++q) { const f32x4 ov = {(float)o2[2 * q].x, (float)o2[2 * q].y, (float)o2[2 * q + 1].x, (float)o2[2 * q + 1].y};
                    const f32x4 gg = *(const f32x4*)(g2p + 4 * q);
                    xv[q] = xv[q] + gg * (ov * (1.0f / 64.0f)); ss += (xv[q].x * xv[q].x + xv[q].y * xv[q].y) + (xv[q].z * xv[q].z + xv[q].w * xv[q].w); }
                const float rstd = 1.f / sqrtf(wave_sum(ss) * (1.f / D) + 1e-6f);
#pragma unroll
                for (int q = 0; q < 4; ++q) { const f32x4 fg = *(const f32x4*)(final_g + 16 * lane + 4 * q);
                    *(f32x4*)(xr + 4 * q) = xv[q] * rstd * fg; }
                cur = nxt;
                { const int tn = (t + 2 * NGW < M) ? t + 2 * NGW : ((t + NGW < M) ? t + NGW : t); P10_META(nxt, tn); }
            }
        }
#undef P10_META
#undef P10_LOAD
#undef P10_COMP
    }
    if (TMASK) { xcd_barrier(bar); STAMP(11);
        if (bx == 0 && tid == 0) { volatile LAS unsigned long long* T = (volatile LAS unsigned long long*)(lds + MISC_OFF + 64); unsigned long long span = 0;
#pragma unroll
            for (int k = 0; k < 11; ++k) if ((TMASK >> k) & 1) span += T[k + 1] - T[k];
            unsigned long long t0, t1; asm volatile("s_memrealtime %0\n\ts_waitcnt lgkmcnt(0)" : "=s"(t0) :: "memory");
            do { __builtin_amdgcn_s_sleep(8); asm volatile("s_memrealtime %0\n\ts_waitcnt lgkmcnt(0)" : "=s"(t1) :: "memory"); } while (t1 - t0 < span); } }
#undef IN
#undef REP
#undef SEAM
}

extern "C" void kernel_launch(void* const* d_in, const int* in_sizes, int n_in, void* d_out, int out_size, void* d_ws, size_t ws_size, hipStream_t stream) {
    static int grid = 0;
    if (grid == 0) {
        if (n_in != 19 || out_size != M * D || ws_size < WS_END) { fprintf(stderr, "kernel_launch: unexpected shapes (n_in %d out %d ws %zu)\n", n_in, out_size, ws_size); grid = -1; return; }
        int dev = 0, cus = 0, per_cu = 0;
        (void)hipGetDevice(&dev); (void)hipDeviceGetAttribute(&cus, hipDeviceAttributeMultiprocessorCount, dev);
        (void)hipFuncSetAttribute((const void*)fwd_kernel, hipFuncAttributeMaxDynamicSharedMemorySize, LDS_BYTES);
        (void)hipOccupancyMaxActiveBlocksPerMultiprocessor(&per_cu, (const void*)fwd_kernel, NTHR, LDS_BYTES);
        (void)hipGetLastError();
        if (per_cu < 1) { fprintf(stderr, "kernel_launch: occupancy query says %d blocks/CU\n", per_cu); per_cu = 1; }
        grid = cus;
    }
    if (grid < 0) return;
    (void)hipMemsetAsync((char*)d_ws + WS_CTL, 0, CTL_ZERO_BYTES, stream);
    Params p{};
    for (int i = 0; i < 19; ++i) p.in[i] = (const float*)d_in[i];
    p.out = (float*)d_out; p.ws = (unsigned char*)d_ws; p.ph_lo = 0; p.ph_hi = 11;
    void* args[] = {&p};
    hipError_t e = hipLaunchCooperativeKernel((const void*)fwd_kernel, dim3(grid), dim3(NTHR), args, LDS_BYTES, stream);
    if (e != hipSuccess) fprintf(stderr, "kernel_launch: cooperative launch failed: %s (grid %d)\n", hipGetErrorString(e), grid);
}
```

```cpp
#include <hip/hip_runtime.h>
#include <cstdio>
#include <cstdint>

#define LAS __attribute__((address_space(3)))
#define GAS __attribute__((address_space(1)))
typedef unsigned short bf16_t;
typedef short bf16x8 __attribute__((ext_vector_type(8)));
typedef float f32x4 __attribute__((ext_vector_type(4)));
typedef float f32x2 __attribute__((ext_vector_type(2)));
typedef unsigned u32x4 __attribute__((ext_vector_type(4)));
typedef unsigned u32x2 __attribute__((ext_vector_type(2)));
typedef __bf16 bf16x2_t __attribute__((ext_vector_type(2)));

namespace pg8 {
#define PG8_LAS __attribute__((address_space(3)))
constexpr int BM = 256, BK = 64, HALF = 128, HTB = HALF * BK * 2, STAGE_BYTES = 8 * HTB, NXCD = 8, WGM = 8;
__host__ __device__ __forceinline__ int lds_byte(int r, int c) { const int st = (r >> 4) * 2 + (c >> 5), rr = r & 15, cc = c & 31, ob = rr * 64 + cc * 2; return st * 1024 + (ob ^ (((ob >> 9) & 1) << 5)); }
__host__ __device__ __forceinline__ void stage_rc(int b, int& R, int& C) { const int st = b / 1024, sb = b % 1024, swz = sb ^ (((sb >> 9) & 1) << 5); R = (st >> 1) * 16 + swz / 64; C = (st & 1) * 32 + (swz % 64) / 2; }
__host__ __device__ __forceinline__ int perm32(int rho) { const int n = rho >> 4, i = rho & 15; return 8 * (i >> 2) + 4 * n + (i & 3); }
struct Unit { int pm, pn; };
struct Gemm { const bf16_t* A; const bf16_t* Bt; int M, N, K; };
struct StaticOrder {
    int nM, nN, nwg, G, c;
    __host__ __device__ void init(int M, int N, int G_, int c_) { nM = M / BM; nN = N / BM; nwg = nM * nN; G = G_; c = c_; }
    __host__ __device__ bool next(int i, Unit& u) const {
        const long L = (long)i * G + c; if (L >= nwg) return false;
        int wgid = (int)L; { const int q = nwg / NXCD, r = nwg % NXCD, xcd = wgid % NXCD, off = wgid / NXCD; wgid = (xcd < r ? xcd * (q + 1) : r * (q + 1) + (xcd - r) * q) + off; }
        const int nig = WGM * nN, gid = wgid / nig, fm = gid * WGM, gsz = (nM - fm) < WGM ? (nM - fm) : WGM;
        u.pm = fm + ((wgid % nig) % gsz); u.pn = (wgid % nig) / gsz; return true;
    }
    __device__ __forceinline__ void a_ready(const Unit&) const {}
    __device__ __forceinline__ void done(const Unit&) const {}
};
__device__ __forceinline__ unsigned cvt_pk_bf16(float lo, float hi) { unsigned r; asm volatile("v_cvt_pk_bf16_f32 %0, %1, %2" : "=v"(r) : "v"(lo), "v"(hi)); return r; }

template <class Epi, class Sched, bool ALIGN_EPI = false, bool SP2 = false>
__device__ __forceinline__ void gemm_phase(PG8_LAS unsigned char* lds, const Gemm g, const Sched& S, const Epi& E) {
    const int tid = threadIdx.x, wid = __builtin_amdgcn_readfirstlane(tid >> 6), lane = tid & 63, wr = wid >> 2, wc = wid & 3, fr = lane & 15, fq = lane >> 4;
    const int K = g.K, nt = K / BK;
    unsigned voffA[2], voffB[2];
#pragma unroll
    for (int i = 0; i < 2; ++i) { int R, C; stage_rc(tid * 16 + i * 8192, R, C); const int Rb = Epi::PERM ? ((R & ~31) + perm32(R & 31)) : R;
        voffA[i] = (unsigned)(R * K + C) * 2u; voffB[i] = (unsigned)(Rb * K + C) * 2u; }
    const size_t kstep = (size_t)(BK * 2);
    const size_t hstep = (size_t)HALF * K * 2;
    const size_t tstep = 2 * hstep;
    const unsigned ldsw = (unsigned)wid * 1024u;
    const int aoff = lds_byte(wr * 64 + fr, fq * 8), boff = lds_byte(wc * 32 + fr, fq * 8);
#define PG8_SA(b, h) (((b) * 2 + (h)) * HTB)
#define PG8_SB(b, h) ((4 + (b) * 2 + (h)) * HTB)
#define PG8_STAGE(bufoff, gbase, voff) do { _Pragma("unroll") for (int _i = 0; _i < 2; ++_i) \
        __builtin_amdgcn_global_load_lds((const unsigned*)((const char*)(gbase) + (voff)[_i]), (PG8_LAS unsigned*)(lds + (bufoff) + ldsw + _i * 8192), 16, 0, 0); } while (0)
#define PG8_LDA(dst, b, h) do { _Pragma("unroll") for (int m = 0; m < 4; ++m) _Pragma("unroll") for (int k = 0; k < 2; ++k) dst[m][k] = *(const PG8_LAS bf16x8*)(lds + PG8_SA(b, h) + aoff + m * 2048 + k * 1024); } while (0)
#define PG8_LDB(dst, b, h) do { _Pragma("unroll") for (int n = 0; n < 2; ++n) _Pragma("unroll") for (int k = 0; k < 2; ++k) dst[n][k] = *(const PG8_LAS bf16x8*)(lds + PG8_SB(b, h) + boff + n * 2048 + k * 1024); } while (0)
#define PG8_MMA(ai, bj, At, Bt) do { __builtin_amdgcn_s_setprio(1); _Pragma("unroll") for (int m = 0; m < 4; ++m) _Pragma("unroll") for (int n = 0; n < 2; ++n) _Pragma("unroll") for (int k = 0; k < 2; ++k) \
        acc[ai][bj][m][n] = __builtin_amdgcn_mfma_f32_16x16x32_bf16(Bt[n][k], At[m][k], acc[ai][bj][m][n], 0, 0, 0); __builtin_amdgcn_s_setprio(0); } while (0)
#define PG8_WAIT_V(n) asm volatile("s_waitcnt vmcnt(" #n ")" ::: "memory")
#define PG8_WAIT_L(n) asm volatile("s_waitcnt lgkmcnt(" #n ")" ::: "memory")
#define PG8_BAR __builtin_amdgcn_s_barrier()
#define PG8_SCHED __builtin_amdgcn_sched_barrier(0)
    Unit cur, nxt; int ui = 0;
    if (!S.next(0, cur)) return;
    f32x4 acc[2][2][4][2];
#pragma unroll
    for (int a = 0; a < 2; ++a)
#pragma unroll
        for (int b = 0; b < 2; ++b)
#pragma unroll
            for (int m = 0; m < 4; ++m)
#pragma unroll
                for (int n = 0; n < 2; ++n) acc[a][b][m][n] = (f32x4){0.f, 0.f, 0.f, 0.f};
    bf16x8 At[4][2], B0[2][2], B1[2][2];
    const char* cA = (const char*)g.A + (size_t)cur.pm * tstep; const char* cB = (const char*)g.Bt + (size_t)cur.pn * tstep;
    S.a_ready(cur);
    if constexpr (SP2) {
        PG8_STAGE(PG8_SB(0, 0), cB, voffB); PG8_STAGE(PG8_SB(0, 1), cB + hstep, voffB); PG8_STAGE(PG8_SA(0, 0), cA, voffA); PG8_STAGE(PG8_SA(0, 1), cA + hstep, voffA);
        if (wr == 1) PG8_BAR;
        PG8_WAIT_V(2); PG8_BAR;
        PG8_STAGE(PG8_SB(1, 0), cB + kstep, voffB); PG8_STAGE(PG8_SA(1, 0), cA + kstep, voffA); PG8_STAGE(PG8_SB(1, 1), cB + hstep + kstep, voffB);
        PG8_WAIT_V(6); PG8_BAR;
    } else {
        PG8_STAGE(PG8_SB(0, 0), cB, voffB); PG8_STAGE(PG8_SA(0, 0), cA, voffA); PG8_STAGE(PG8_SB(0, 1), cB + hstep, voffB); PG8_STAGE(PG8_SA(0, 1), cA + hstep, voffA);
        if (wr == 1) PG8_BAR;
        PG8_WAIT_V(4); PG8_BAR;
        PG8_STAGE(PG8_SB(1, 0), cB + kstep, voffB); PG8_STAGE(PG8_SA(1, 0), cA + kstep, voffA); PG8_STAGE(PG8_SB(1, 1), cB + hstep + kstep, voffB);
        PG8_WAIT_V(6); PG8_BAR;
    }
    for (;;) {
        const bool has_next = S.next(ui + 1, nxt);
        const char* nA = has_next ? (const char*)g.A + (size_t)nxt.pm * tstep : cA; const char* nB = has_next ? (const char*)g.Bt + (size_t)nxt.pn * tstep : cB;
        for (int t = 0; t < nt; t += 2) {
            const bool last = (t == nt - 2);
            const char* a1 = cA + (size_t)(t + 1) * kstep;
            const char* a2 = last ? nA : cA + (size_t)(t + 2) * kstep; const char* b2 = last ? nB : cB + (size_t)(t + 2) * kstep;
            const char* a3 = a2 + kstep; const char* b3 = b2 + kstep;
            if (last && has_next) S.a_ready(nxt);
            if constexpr (SP2) {
            PG8_LDB(B0, 0, 0); PG8_LDB(B1, 0, 1); PG8_SCHED; PG8_LDA(At, 0, 0); PG8_STAGE(PG8_SA(1, 1), a1 + hstep, voffA);
            PG8_WAIT_V(8); PG8_WAIT_L(0); PG8_BAR; PG8_MMA(0, 0, At, B0); PG8_MMA(0, 1, At, B1); PG8_BAR; PG8_SCHED;
            PG8_LDA(At, 0, 1); PG8_STAGE(PG8_SB(0, 0), b2, voffB); PG8_STAGE(PG8_SB(0, 1), b2 + hstep, voffB); PG8_STAGE(PG8_SA(0, 0), a2, voffA);
            PG8_WAIT_V(8); PG8_WAIT_L(0); PG8_BAR; PG8_MMA(1, 0, At, B0); PG8_MMA(1, 1, At, B1); PG8_BAR; PG8_SCHED;
            PG8_LDB(B0, 1, 0); PG8_LDB(B1, 1, 1); PG8_SCHED; PG8_LDA(At, 1, 0); PG8_STAGE(PG8_SA(0, 1), a2 + hstep, voffA);
            PG8_WAIT_V(8); PG8_WAIT_L(0); PG8_BAR; PG8_MMA(0, 0, At, B0); PG8_MMA(0, 1, At, B1); PG8_BAR; PG8_SCHED;
            PG8_LDA(At, 1, 1); PG8_STAGE(PG8_SB(1, 0), b3, voffB); PG8_STAGE(PG8_SB(1, 1), b3 + hstep, voffB); PG8_STAGE(PG8_SA(1, 0), a3, voffA);
            PG8_WAIT_V(8); PG8_WAIT_L(0); PG8_BAR; PG8_MMA(1, 0, At, B0); PG8_MMA(1, 1, At, B1); PG8_BAR; PG8_SCHED;
            } else {
            PG8_LDB(B0, 0, 0); PG8_SCHED; PG8_LDA(At, 0, 0); PG8_STAGE(PG8_SA(1, 1), a1 + hstep, voffA);
            PG8_WAIT_L(8); PG8_BAR; PG8_WAIT_L(0); PG8_MMA(0, 0, At, B0); PG8_BAR; PG8_SCHED;
            PG8_LDB(B1, 0, 1); PG8_STAGE(PG8_SB(0, 0), b2, voffB);
            PG8_BAR; PG8_WAIT_L(0); PG8_MMA(0, 1, At, B1); PG8_BAR;
            PG8_LDA(At, 0, 1); PG8_STAGE(PG8_SA(0, 0), a2, voffA);
            PG8_BAR; PG8_WAIT_L(0); PG8_MMA(1, 0, At, B0); PG8_BAR; PG8_SCHED;
            PG8_STAGE(PG8_SB(0, 1), b2 + hstep, voffB);
            PG8_WAIT_V(6); PG8_BAR; PG8_MMA(1, 1, At, B1); PG8_BAR;
            PG8_LDB(B0, 1, 0); PG8_SCHED; PG8_LDA(At, 1, 0); PG8_STAGE(PG8_SA(0, 1), a2 + hstep, voffA);
            PG8_WAIT_L(8); PG8_BAR; PG8_WAIT_L(0); PG8_MMA(0, 0, At, B0); PG8_BAR; PG8_SCHED;
            PG8_LDB(B1, 1, 1); PG8_STAGE(PG8_SB(1, 0), b3, voffB);
            PG8_BAR; PG8_WAIT_L(0); PG8_MMA(0, 1, At, B1); PG8_BAR;
            PG8_LDA(At, 1, 1); PG8_STAGE(PG8_SA(1, 0), a3, voffA);
            PG8_BAR; PG8_WAIT_L(0); PG8_MMA(1, 0, At, B0); PG8_BAR; PG8_SCHED;
            PG8_STAGE(PG8_SB(1, 1), b3 + hstep, voffB);
            PG8_WAIT_V(6); PG8_BAR; PG8_MMA(1, 1, At, B1); PG8_BAR;
            }
        }
        if constexpr (ALIGN_EPI) { if (wr == 0) PG8_BAR; }
        E(acc, cur, wr, wc, fr, fq); S.done(cur);
        if (!has_next) break;
#pragma unroll
        for (int a = 0; a < 2; ++a)
#pragma unroll
            for (int b = 0; b < 2; ++b)
#pragma unroll
                for (int m = 0; m < 4; ++m)
#pragma unroll
                    for (int n = 0; n < 2; ++n) acc[a][b][m][n] = (f32x4){0.f, 0.f, 0.f, 0.f};
        cur = nxt; cA = nA; cB = nB; ++ui;
        if constexpr (ALIGN_EPI) { if (wr == 1) PG8_BAR; }
    }
    PG8_WAIT_V(0);
    if constexpr (!ALIGN_EPI) { if (wr == 0) PG8_BAR; }
    PG8_BAR;
#undef PG8_SA
#undef PG8_SB
#undef PG8_STAGE
#undef PG8_LDA
#undef PG8_LDB
#undef PG8_MMA
#undef PG8_WAIT_V
#undef PG8_WAIT_L
#undef PG8_BAR
#undef PG8_SCHED
}
}

#ifndef DUPMASK
#define DUPMASK 0
#endif
#ifndef TMASK
#define TMASK 0
#endif
#ifndef UFMT
#define UFMT 4
#endif
#ifndef VFMT
#define VFMT 4
#endif
constexpr int NB = 2, SEQ = 8192, D = 1024, M = NB * SEQ;
constexpr int NPROJ = 2048, NIN = 2048, INLD = 2064;
constexpr int NUNIT = 1024;
constexpr int NEXP = 16384;
constexpr size_t MiB = 1u << 20;
constexpr size_t WS_CTL = 0, CTL_ZERO_BYTES = 64 * 1024;
constexpr size_t WS_MOD = 1 * MiB;
constexpr size_t WS_DEC = 1 * MiB + 512 * 1024;
constexpr size_t WS_WIN = 2 * MiB;
constexpr size_t WS_WOUT = 7 * MiB;
constexpr size_t WS_WQ = 9 * MiB;
constexpr size_t WS_KK = 13 * MiB;
constexpr size_t WS_IDX = 14 * MiB;
constexpr size_t WS_GATE = 22 * MiB;
constexpr size_t WS_LOGA = 30 * MiB;
constexpr size_t WS_KV = 46 * MiB;
constexpr size_t WS_H = 78 * MiB;
constexpr size_t WS_U8 = 110 * MiB;
constexpr size_t WS_V8 = 126 * MiB;
constexpr size_t WS_SU = 142 * MiB;
constexpr size_t WS_SV = 142 * MiB + 65536;
constexpr size_t WS_PROJ = 174 * MiB;
constexpr size_t WS_END = 238 * MiB;
constexpr int CW_BAR = 1024;
constexpr int NWAVES = 8, NTHR = 512;
constexpr int LDS_BYTES = 147456, MISC_OFF = 147456 - 256;

#define XB_TMO      128
#define XB_XCNT(j)  (256  + 64 * (j))
#define XB_XSUB(j)  (1280 + 64 * (j))
#define XB_XGEN(j)  (2304 + 64 * (j))
#define XB_TOP      3328
#define XB_TOPGEN   3392
#define XCD_BAR_WORDS 3456
#define XB_SPIN_CAP (1u << 20)
__device__ __forceinline__ unsigned xb_ld(unsigned* p)              { return __hip_atomic_load(p, __ATOMIC_RELAXED, __HIP_MEMORY_SCOPE_AGENT); }
__device__ __forceinline__ unsigned xb_add(unsigned* p, unsigned v) { return __hip_atomic_fetch_add(p, v, __ATOMIC_RELAXED, __HIP_MEMORY_SCOPE_AGENT); }
__device__ __forceinline__ unsigned xb_xcc_id() { return (unsigned)__builtin_amdgcn_s_getreg((3 << 11) | 20) & 0xFu; }
#define XB_SPIN(cond, bar) do { unsigned _sp = 0; while (cond) { __builtin_amdgcn_s_sleep(1); \
    if ((++_sp & 255u) == 0u) { if (xb_ld(&(bar)[XB_TMO])) break; if (_sp > XB_SPIN_CAP) { atomicAdd(&(bar)[XB_TMO], 1u); break; } } } } while (0)
struct XcdBarrier { unsigned* bar; unsigned x; volatile LAS unsigned* st; };
__device__ __forceinline__ XcdBarrier xcd_barrier_post(unsigned* bar, volatile LAS unsigned* st) {
    XcdBarrier b; b.bar = bar; b.x = xb_xcc_id(); b.st = st;
    if (threadIdx.x == 0) (void)xb_add(&bar[XB_XCNT(b.x)], 1u);
    return b;
}
__device__ __forceinline__ void xcd_barrier_complete(unsigned* bar, unsigned x, unsigned& nloc, unsigned& nx) {
    const unsigned G = gridDim.x * gridDim.y * gridDim.z;
    unsigned sum, cnt, mine, sp = 0u;
    for (;;) {
        sum = 0u; cnt = 0u; mine = 0u;
#pragma unroll
        for (unsigned j = 0; j < 16; ++j) { const unsigned c = xb_ld(&bar[XB_XCNT(j)]); sum += c; cnt += (c > 0u) ? 1u : 0u; mine = (j == x) ? c : mine; }
        if (sum == G) break;
        __builtin_amdgcn_s_sleep(1);
        if ((++sp & 255u) == 0u) { if (xb_ld(&bar[XB_TMO])) break; if (sp > XB_SPIN_CAP) { atomicAdd(&bar[XB_TMO], 1u); break; } }
    }
    nloc = mine > 0u ? mine : 1u; nx = cnt > 0u ? cnt : 1u;
}
__device__ __forceinline__ void xcd_barrier(const XcdBarrier& b) {
    asm volatile("s_waitcnt vmcnt(0)" ::: "memory");
    __syncthreads();
    if (threadIdx.x == 0) {
        unsigned* bar = b.bar;
        __builtin_amdgcn_s_waitcnt(0);
        unsigned nloc = b.st[0], nx = b.st[1];
        if (nloc == 0u) { xcd_barrier_complete(bar, b.x, nloc, nx); b.st[0] = nloc; b.st[1] = nx; }
        const unsigned old = xb_add(&bar[XB_XSUB(b.x)], 1u);
        const unsigned gen = old / nloc;
        if (old + 1u == (gen + 1u) * nloc) {
            __builtin_amdgcn_fence(__ATOMIC_RELEASE, "agent");
            asm volatile("s_waitcnt vmcnt(0)" ::: "memory");
            const unsigned og = xb_add(&bar[XB_TOP], 1u);
            const unsigned tg = og / nx;
            if (og + 1u == (tg + 1u) * nx) xb_add(&bar[XB_TOPGEN], 1u);
            else XB_SPIN(xb_ld(&bar[XB_TOPGEN]) == tg, bar);
            __builtin_amdgcn_fence(__ATOMIC_ACQUIRE, "agent");
            xb_add(&bar[XB_XGEN(b.x)], 1u);
            asm volatile("s_waitcnt vmcnt(0)" ::: "memory");
        } else {
            XB_SPIN(xb_ld(&bar[XB_XGEN(b.x)]) == gen, bar);
            __builtin_amdgcn_fence(__ATOMIC_ACQUIRE, "agent");
            asm volatile("s_waitcnt vmcnt(0)" ::: "memory");
        }
    }
    __syncthreads();
}

__device__ __forceinline__ unsigned f2bf(float f) { unsigned u = __builtin_bit_cast(unsigned, f); return (u + 0x7fffu + ((u >> 16) & 1u)) >> 16; }
__device__ __forceinline__ unsigned pk2(float lo, float hi) { return f2bf(lo) | (f2bf(hi) << 16); }
__device__ __forceinline__ float bflo(unsigned w) { return __builtin_bit_cast(float, w << 16); }
__device__ __forceinline__ float bfhi(unsigned w) { return __builtin_bit_cast(float, w & 0xffff0000u); }
__device__ __forceinline__ float wave_sum(float v) {
#pragma unroll
    for (int o = 1; o < 64; o <<= 1) v += __shfl_xor(v, o);
    return v;
}
__device__ __forceinline__ float silu_f(float x) { return x / (1.f + __expf(-x)); }
__device__ __forceinline__ float logsig_f(float x) { return fminf(x, 0.f) - log1pf(__expf(-fabsf(x))); }
__device__ __forceinline__ float gelu_f(float x) { return 0.5f * x * (1.f + erff(x * 0.70710678118654752f)); }

template <int FMT> struct RowVec { u32x4 w; };
template <> struct RowVec<4> { u32x2 w; };
template <int FMT> __device__ __forceinline__ RowVec<FMT> row_load(const unsigned char* tab, int eid, int lane) {
    RowVec<FMT> r;
    if constexpr (FMT == 4) r.w = *(const u32x2*)(tab + (size_t)eid * 512 + 8 * lane); else r.w = *(const u32x4*)(tab + (size_t)eid * 1024 + 16 * lane);
    return r;
}
template <int FMT> __device__ __forceinline__ void row_decode(const RowVec<FMT>& r, float (&f)[16]) {
    if constexpr (FMT == 4) {
        const unsigned w[2] = {r.w.x, r.w.y};
#pragma unroll
        for (int k = 0; k < 2; ++k) {
            const f32x2 p0 = __builtin_amdgcn_cvt_scalef32_pk_f32_fp4(w[k], 1.0f, 0), p1 = __builtin_amdgcn_cvt_scalef32_pk_f32_fp4(w[k], 1.0f, 1);
            const f32x2 p2 = __builtin_amdgcn_cvt_scalef32_pk_f32_fp4(w[k], 1.0f, 2), p3 = __builtin_amdgcn_cvt_scalef32_pk_f32_fp4(w[k], 1.0f, 3);
            f[8 * k] = p0.x; f[8 * k + 1] = p0.y; f[8 * k + 2] = p1.x; f[8 * k + 3] = p1.y; f[8 * k + 4] = p2.x; f[8 * k + 5] = p2.y; f[8 * k + 6] = p3.x; f[8 * k + 7] = p3.y; }
    } else {
        const unsigned w[4] = {r.w.x, r.w.y, r.w.z, r.w.w};
#pragma unroll
        for (int k = 0; k < 4; ++k) { const f32x2 lo = __builtin_amdgcn_cvt_pk_f32_fp8((int)w[k], false), hi = __builtin_amdgcn_cvt_pk_f32_fp8((int)w[k], true);
            f[4 * k] = lo.x; f[4 * k + 1] = lo.y; f[4 * k + 2] = hi.x; f[4 * k + 3] = hi.y; }
    }
}

template <int UF, int VF> __device__ __forceinline__ void peer_chunk_load(RowVec<UF> (&uu)[8], RowVec<VF> (&vv)[8], const unsigned char* U8, const unsigned char* V8, int idr, int c8, int lane) {
#pragma unroll
    for (int q = 0; q < 8; ++q) { const int eid = __builtin_amdgcn_readlane(idr, c8 + q); uu[q] = row_load<UF>(U8, eid, lane); vv[q] = row_load<VF>(V8, eid, lane); }
}
template <int UF, int VF> __device__ __forceinline__ void peer_chunk_compute(const RowVec<UF> (&uu)[8], const RowVec<VF> (&vv)[8], const float (&hf)[16], float (&o)[16], float zs, float as, int c8, int lane) {
    float z[8];
#pragma unroll
    for (int q = 0; q < 8; ++q) { float f[16]; row_decode<UF>(uu[q], f); float a0 = 0.f, a1 = 0.f;
#pragma unroll
        for (int k = 0; k < 8; ++k) { a0 += hf[2 * k] * f[2 * k]; a1 += hf[2 * k + 1] * f[2 * k + 1]; }
        z[q] = a0 + a1; }
    float r1[4], r2[2], r3;
#pragma unroll
    for (int k = 0; k < 4; ++k) { const bool hi1 = lane & 1; const float keep = hi1 ? z[2 * k + 1] : z[2 * k], send = hi1 ? z[2 * k] : z[2 * k + 1]; r1[k] = keep + __shfl_xor(send, 1); }
#pragma unroll
    for (int k = 0; k < 2; ++k) { const bool hi1 = lane & 2; const float keep = hi1 ? r1[2 * k + 1] : r1[2 * k], send = hi1 ? r1[2 * k] : r1[2 * k + 1]; r2[k] = keep + __shfl_xor(send, 2); }
    { const bool hi1 = lane & 4; const float keep = hi1 ? r2[1] : r2[0], send = hi1 ? r2[0] : r2[1]; r3 = keep + __shfl_xor(send, 4); }
    r3 += __shfl_xor(r3, 8); r3 += __shfl_xor(r3, 16); r3 += __shfl_xor(r3, 32);
    const float act = gelu_f(r3 * zs) * as;
#pragma unroll
    for (int q = 0; q < 8; ++q) { const float a = __builtin_bit_cast(float, __builtin_amdgcn_readlane(__builtin_bit_cast(int, act), c8 + q));
        float f[16]; row_decode<VF>(vv[q], f);
#pragma unroll
        for (int k = 0; k < 16; ++k) o[k] += a * f[k]; }
}

typedef _Float16 h2_t __attribute__((ext_vector_type(2)));
template <int CTRL> __device__ __forceinline__ float dppf(float v) { return __builtin_bit_cast(float, __builtin_amdgcn_update_dpp(0, __builtin_bit_cast(int, v), CTRL, 0xF, 0xF, true)); }
__device__ __forceinline__ void peer_chunk_compute4(const RowVec<4> (&uu)[8], const RowVec<4> (&vv)[8], const int (&hq)[4], h2_t (&o2)[8], float zs, float as64, int c8, int lane) {
    float z[8];
#pragma unroll
    for (int q = 0; q < 8; ++q) { const int w0 = (int)uu[q].w.x, w1 = (int)uu[q].w.y;
        int ah = __builtin_amdgcn_sdot8(w0, hq[0], 0, false); ah = __builtin_amdgcn_sdot8(w1, hq[1], ah, false);
        int al = __builtin_amdgcn_sdot8(w0, hq[2], 0, false); al = __builtin_amdgcn_sdot8(w1, hq[3], al, false);
        z[q] = (float)(ah * 16 + al); }
    float r1[4], r2[2], r3;
#pragma unroll
    for (int k = 0; k < 4; ++k) { const bool hi1 = lane & 1; const float keep = hi1 ? z[2 * k + 1] : z[2 * k], send = hi1 ? z[2 * k] : z[2 * k + 1]; r1[k] = keep + dppf<0xB1>(send); }
#pragma unroll
    for (int k = 0; k < 2; ++k) { const bool hi1 = lane & 2; const float keep = hi1 ? r1[2 * k + 1] : r1[2 * k], send = hi1 ? r1[2 * k] : r1[2 * k + 1]; r2[k] = keep + dppf<0x4E>(send); }
    { const bool hi1 = lane & 4; const float keep = hi1 ? r2[1] : r2[0], send = hi1 ? r2[0] : r2[1]; r3 = keep + dppf<0x124>(send); }
    r3 += dppf<0x128>(r3); r3 += __shfl_xor(r3, 16); r3 += __shfl_xor(r3, 32);
    const float act = gelu_f(r3 * zs) * as64;
#pragma unroll
    for (int q = 0; q < 8; ++q) { const float a = __builtin_bit_cast(float, __builtin_amdgcn_readlane(__builtin_bit_cast(int, act), c8 + q));
        const _Float16 ah = (_Float16)a; const h2_t a2 = {ah, ah}; const unsigned w0 = vv[q].w.x, w1 = vv[q].w.y;
        o2[0] = __builtin_amdgcn_cvt_scalef32_pk_f16_fp4(w0, 1.0f, 0) * a2 + o2[0]; o2[1] = __builtin_amdgcn_cvt_scalef32_pk_f16_fp4(w0, 1.0f, 1) * a2 + o2[1];
        o2[2] = __builtin_amdgcn_cvt_scalef32_pk_f16_fp4(w0, 1.0f, 2) * a2 + o2[2]; o2[3] = __builtin_amdgcn_cvt_scalef32_pk_f16_fp4(w0, 1.0f, 3) * a2 + o2[3];
        o2[4] = __builtin_amdgcn_cvt_scalef32_pk_f16_fp4(w1, 1.0f, 0) * a2 + o2[4]; o2[5] = __builtin_amdgcn_cvt_scalef32_pk_f16_fp4(w1, 1.0f, 1) * a2 + o2[5];
        o2[6] = __builtin_amdgcn_cvt_scalef32_pk_f16_fp4(w1, 1.0f, 2) * a2 + o2[6]; o2[7] = __builtin_amdgcn_cvt_scalef32_pk_f16_fp4(w1, 1.0f, 3) * a2 + o2[7]; }
}

struct Params { const float* in[19]; float* out; unsigned char* ws; int ph_lo, ph_hi; };

struct EpiProj {
    static constexpr bool PERM = true;
    bf16_t* P; float* LA; const float* gb;
    __device__ __forceinline__ void operator()(const f32x4 (&acc)[2][2][4][2], const pg8::Unit& u, int wr, int wc, int fr, int fq) const {
        const int row0 = u.pm * 256 + wr * 64 + fr;
        if (u.pn < 8) {
            const int col0 = u.pn * 256 + wc * 32 + 8 * fq;
#pragma unroll
            for (int ai = 0; ai < 2; ++ai)
#pragma unroll
                for (int m = 0; m < 4; ++m) { bf16_t* rowp = P + (size_t)(row0 + ai * 128 + m * 16) * NPROJ + col0;
#pragma unroll
                    for (int bj = 0; bj < 2; ++bj) { const f32x4 v0 = acc[ai][bj][m][0], v1 = acc[ai][bj][m][1];
                        u32x4 w; w.x = pg8::cvt_pk_bf16(v0[0], v0[1]); w.y = pg8::cvt_pk_bf16(v0[2], v0[3]); w.z = pg8::cvt_pk_bf16(v1[0], v1[1]); w.w = pg8::cvt_pk_bf16(v1[2], v1[3]);
                        *(u32x4*)(rowp + bj * 128) = w; } }
        } else {
            const int col0 = wc * 32 + 8 * fq;
            f32x4 bv[2][2];
#pragma unroll
            for (int bj = 0; bj < 2; ++bj)
#pragma unroll
                for (int n = 0; n < 2; ++n) bv[bj][n] = *(const f32x4*)(gb + col0 + bj * 128 + 4 * n);
#pragma unroll
            for (int ai = 0; ai < 2; ++ai)
#pragma unroll
                for (int m = 0; m < 4; ++m) { float* rowp = LA + (size_t)(row0 + ai * 128 + m * 16) * 256 + col0;
#pragma unroll
                    for (int bj = 0; bj < 2; ++bj)
#pragma unroll
                        for (int n = 0; n < 2; ++n) { const f32x4 v = acc[ai][bj][m][n] + bv[bj][n]; f32x4 o;
#pragma unroll
                            for (int j = 0; j < 4; ++j) o[j] = logsig_f(v[j]) * (1.0f / 16.0f);
                            *(f32x4*)(rowp + bj * 128 + 4 * n) = o; } }
        }
    }
};
struct EpiX1 {
    static constexpr bool PERM = true;
    const float* x; bf16_t* X1; const float* gate;
    __device__ __forceinline__ void operator()(const f32x4 (&acc)[2][2][4][2], const pg8::Unit& u, int wr, int wc, int fr, int fq) const {
        const int row0 = u.pm * 256 + wr * 64 + fr, col0 = u.pn * 256 + wc * 32 + 8 * fq;
        const float* gp = gate + (u.pm >= 32 ? 6144 : 0);
        f32x4 gv[2][2];
#pragma unroll
        for (int bj = 0; bj < 2; ++bj)
#pragma unroll
            for (int n = 0; n < 2; ++n) gv[bj][n] = *(const f32x4*)(gp + col0 + bj * 128 + 4 * n);
#pragma unroll
        for (int ai = 0; ai < 2; ++ai)
#pragma unroll
            for (int m = 0; m < 4; ++m) { const size_t ro = (size_t)(row0 + ai * 128 + m * 16) * D + col0;
#pragma unroll
                for (int bj = 0; bj < 2; ++bj) { const f32x4 x0 = *(const f32x4*)(x + ro + bj * 128), x1v = *(const f32x4*)(x + ro + bj * 128 + 4);
                    const f32x4 v0 = x0 + gv[bj][0] * acc[ai][bj][m][0], v1 = x1v + gv[bj][1] * acc[ai][bj][m][1];
                    u32x4 w; w.x = pg8::cvt_pk_bf16(v0[0], v0[1]); w.y = pg8::cvt_pk_bf16(v0[2], v0[3]); w.z = pg8::cvt_pk_bf16(v1[0], v1[1]); w.w = pg8::cvt_pk_bf16(v1[2], v1[3]);
                    *(u32x4*)(X1 + ro + bj * 128) = w; } }
    }
};
struct EpiQ {
    static constexpr bool PERM = true;
    bf16_t* Q;
    __device__ __forceinline__ void operator()(const f32x4 (&acc)[2][2][4][2], const pg8::Unit& u, int wr, int wc, int fr, int fq) const {
        const int row0 = u.pm * 256 + wr * 64 + fr, col0 = u.pn * 256 + wc * 32 + 8 * fq;
#pragma unroll
        for (int ai = 0; ai < 2; ++ai)
#pragma unroll
            for (int m = 0; m < 4; ++m) { bf16_t* rowp = Q + (size_t)(row0 + ai * 128 + m * 16) * 2048 + col0;
#pragma unroll
                for (int bj = 0; bj < 2; ++bj) { const f32x4 v0 = acc[ai][bj][m][0], v1 = acc[ai][bj][m][1];
                    u32x4 w; w.x = pg8::cvt_pk_bf16(v0[0], v0[1]); w.y = pg8::cvt_pk_bf16(v0[2], v0[3]); w.z = pg8::cvt_pk_bf16(v1[0], v1[1]); w.w = pg8::cvt_pk_bf16(v1[2], v1[3]);
                    *(u32x4*)(rowp + bj * 128) = w; } }
    }
};

__device__ __forceinline__ void transpose_item(const float* W, int ldw, int k0, int n0, bf16_t* WT, int ldt, int row0, LAS float* scr, int lane) {
#pragma unroll 8
    for (int i = 0; i < 32; ++i) { const int kk = 2 * i + (lane >> 5); scr[kk * 33 + (lane & 31)] = W[(size_t)(k0 + kk) * ldw + n0 + (lane & 31)]; }
    asm volatile("s_waitcnt lgkmcnt(0)" ::: "memory");
    const int c = lane & 7;
#pragma unroll
    for (int j = 0; j < 4; ++j) { const int n = (lane >> 3) + 8 * j; const LAS float* s = scr + (8 * c) * 33 + n;
        u32x4 o; o.x = pk2(s[0 * 33], s[1 * 33]); o.y = pk2(s[2 * 33], s[3 * 33]); o.z = pk2(s[4 * 33], s[5 * 33]); o.w = pk2(s[6 * 33], s[7 * 33]);
        *(u32x4*)(WT + (size_t)(row0 + n0 + n) * ldt + k0 + 8 * c) = o; }
    asm volatile("s_waitcnt lgkmcnt(0)" ::: "memory");
}

template <int NR> __device__ __forceinline__ void norm_mod_rows(const float* xbase, int m0, int mstride, const float* g, const float* MODp, int modoff, bf16_t* obase, int lane) {
    f32x4 v[NR][4]; float s[NR];
#pragma unroll
    for (int a = 0; a < NR; ++a) { const float* xrow = xbase + (size_t)(m0 + a * mstride) * D;
#pragma unroll
        for (int j = 0; j < 4; ++j) v[a][j] = *(const f32x4*)(xrow + 4 * lane + 256 * j); }
#pragma unroll
    for (int a = 0; a < NR; ++a) { s[a] = 0.f;
#pragma unroll
        for (int j = 0; j < 4; ++j) s[a] += (v[a][j].x * v[a][j].x + v[a][j].y * v[a][j].y) + (v[a][j].z * v[a][j].z + v[a][j].w * v[a][j].w); }
#pragma unroll
    for (int o = 1; o < 64; o <<= 1)
#pragma unroll
        for (int a = 0; a < NR; ++a) s[a] += __shfl_xor(s[a], o);
#pragma unroll
    for (int a = 0; a < NR; ++a) { const int m = m0 + a * mstride; const float rstd = 1.f / sqrtf(s[a] * (1.f / D) + 1e-6f);
        const float* shift = MODp + (m >= SEQ ? 6144 : 0) + modoff; const float* scale = shift + 1024; bf16_t* orow = obase + (size_t)m * D;
#pragma unroll
        for (int j = 0; j < 4; ++j) { const int c = 4 * lane + 256 * j;
            const f32x4 gg = *(const f32x4*)(g + c), sh = *(const f32x4*)(shift + c), sc = *(const f32x4*)(scale + c);
            const f32x4 y = v[a][j] * rstd * gg * (sc + 1.0f) + sh;
            u32x2 o; o.x = pk2(y.x, y.y); o.y = pk2(y.z, y.w);
            *(u32x2*)(orow + c) = o; } }
}

template <int NR> __device__ __forceinline__ void norm_mod_rows_bf16(const bf16_t* xbase, int m0, int mstride, const float* g, const float* MODp, int modoff, bf16_t* obase, int lane) {
    u32x4 a[NR], b[NR]; float s[NR];
#pragma unroll
    for (int r = 0; r < NR; ++r) { const bf16_t* xrow = xbase + (size_t)(m0 + r * mstride) * D + 16 * lane; a[r] = *(const u32x4*)xrow; b[r] = *(const u32x4*)(xrow + 8); }
#pragma unroll
    for (int r = 0; r < NR; ++r) { const unsigned w[8] = {a[r].x, a[r].y, a[r].z, a[r].w, b[r].x, b[r].y, b[r].z, b[r].w}; s[r] = 0.f;
#pragma unroll
        for (int k = 0; k < 8; ++k) { const float lo = bflo(w[k]), hi = bfhi(w[k]); s[r] += lo * lo + hi * hi; } }
#pragma unroll
    for (int o = 1; o < 64; o <<= 1)
#pragma unroll
        for (int r = 0; r < NR; ++r) s[r] += __shfl_xor(s[r], o);
#pragma unroll
    for (int r = 0; r < NR; ++r) { const int m = m0 + r * mstride; const float rstd = 1.f / sqrtf(s[r] * (1.f / D) + 1e-6f);
        const float* shift = MODp + (m >= SEQ ? 6144 : 0) + modoff + 16 * lane; const float* scale = shift + 1024; const float* gp = g + 16 * lane;
        const unsigned w[8] = {a[r].x, a[r].y, a[r].z, a[r].w, b[r].x, b[r].y, b[r].z, b[r].w}; unsigned ow[8];
#pragma unroll
        for (int q = 0; q < 4; ++q) { const f32x4 gg = *(const f32x4*)(gp + 4 * q), sh = *(const f32x4*)(shift + 4 * q), sc = *(const f32x4*)(scale + 4 * q);
            const f32x4 xv = {bflo(w[2 * q]), bfhi(w[2 * q]), bflo(w[2 * q + 1]), bfhi(w[2 * q + 1])};
            const f32x4 y = xv * rstd * gg * (sc + 1.0f) + sh;
            ow[2 * q] = pk2(y.x, y.y); ow[2 * q + 1] = pk2(y.z, y.w); }
        bf16_t* orow = obase + (size_t)m * D + 16 * lane;
        *(u32x4*)orow = (u32x4){ow[0], ow[1], ow[2], ow[3]}; *(u32x4*)(orow + 8) = (u32x4){ow[4], ow[5], ow[6], ow[7]}; }
}

__constant__ unsigned char CAND_IJ[64] = {
    0x00,0x01,0x02,0x03,0x04,0x05,0x06,0x07,0x08,0x09,0x0a,0x0b,0x0c,0x0d,0x0e,0x0f,
    0x10,0x11,0x12,0x13,0x14,0x15,0x16,0x17,
    0x20,0x21,0x22,0x23,0x24,
    0x30,0x31,0x32,0x33,
    0x40,0x41,0x42,
    0x50,0x51, 0x60,0x61, 0x70,0x71,
    0x80,0x90,0xa0,0xb0,0xc0,0xd0,0xe0,0xf0,
    0,0,0,0,0,0,0,0,0,0,0,0,0,0};

__device__ __forceinline__ unsigned fkey(float f, unsigned idbits, unsigned idmask) {
    unsigned u = __builtin_bit_cast(unsigned, f); u = (u & 0x80000000u) ? ~u : (u | 0x80000000u);
    return (u & ~idmask) | idbits;
}
__device__ __forceinline__ float fkey_val(unsigned key, unsigned idmask) {
    unsigned u = key & ~idmask; u = (u & 0x80000000u) ? (u ^ 0x80000000u) : ~u;
    return __builtin_bit_cast(float, u);
}
template <int CTRL, int ROWMASK> __device__ __forceinline__ unsigned dpp_u(unsigned v) { return (unsigned)__builtin_amdgcn_update_dpp(0, (int)v, CTRL, ROWMASK, 0xF, true); }
template <int CTRL, int ROWMASK> __device__ __forceinline__ float dpp_f(float v) { return __builtin_bit_cast(float, __builtin_amdgcn_update_dpp(0, __builtin_bit_cast(int, v), CTRL, ROWMASK, 0xF, true)); }
__device__ __forceinline__ unsigned umax_(unsigned a, unsigned b) { return a > b ? a : b; }
__device__ __forceinline__ unsigned umin_(unsigned a, unsigned b) { return a < b ? a : b; }
template <int N> __device__ __forceinline__ unsigned ror_u(unsigned v) { return (unsigned)__builtin_amdgcn_update_dpp(0, (int)v, 0x120 + N, 0xF, 0xF, true); }
template <int N> __device__ __forceinline__ float ror_f(float v) { return __builtin_bit_cast(float, __builtin_amdgcn_update_dpp(0, __builtin_bit_cast(int, v), 0x120 + N, 0xF, 0xF, true)); }
__device__ __forceinline__ unsigned row_allmax(unsigned m) { m = umax_(m, ror_u<1>(m)); m = umax_(m, ror_u<2>(m)); m = umax_(m, ror_u<4>(m)); m = umax_(m, ror_u<8>(m)); return m; }
__device__ __forceinline__ float row_allsum(float m) { m += ror_f<1>(m); m += ror_f<2>(m); m += ror_f<4>(m); m += ror_f<8>(m); return m; }

__global__ void __launch_bounds__(NTHR, 2) fwd_kernel(Params p) {
    extern __shared__ __attribute__((aligned(16))) unsigned char lds_raw[];
    LAS unsigned char* lds = (LAS unsigned char*)lds_raw;
    const int tid = threadIdx.x, lane = tid & 63, wave = __builtin_amdgcn_readfirstlane(tid >> 6);
    const int G = gridDim.x, bx = blockIdx.x;
    const int gw = bx * NWAVES + wave, NGW = G * NWAVES;
    unsigned char* ws = p.ws;
    unsigned* ctl = (unsigned*)(ws + WS_CTL);
    float* MOD = (float*)(ws + WS_MOD);
    float* DEC = (float*)(ws + WS_DEC);
    bf16_t* WIN = (bf16_t*)(ws + WS_WIN);
    bf16_t* WOUT = (bf16_t*)(ws + WS_WOUT);
    bf16_t* WQ = (bf16_t*)(ws + WS_WQ);
    bf16_t* KK = (bf16_t*)(ws + WS_KK);
    int* IDX = (int*)(ws + WS_IDX);
    float* GATE = (float*)(ws + WS_GATE);
    float* LOGA = (float*)(ws + WS_LOGA);
    float* KV = (float*)(ws + WS_KV);
    bf16_t* H = (bf16_t*)(ws + WS_H);
    unsigned char* U8 = ws + WS_U8;
    unsigned char* V8 = ws + WS_V8;
    float* SU = (float*)(ws + WS_SU);
    float* SV = (float*)(ws + WS_SV);
    bf16_t* PROJ = (bf16_t*)(ws + WS_PROJ);
    const float* x = p.in[0]; const float* cvec = p.in[1]; const float* ada_w = p.in[2]; const float* ada_b = p.in[3]; const float* norm1_g = p.in[4];
    const float* w_in = p.in[5]; const float* gate_w = p.in[6]; const float* gate_b = p.in[7]; const float* gla_norm_g = p.in[8];
    const float* pool_w = p.in[9]; const float* pool_scale = p.in[10]; const float* w_out = p.in[11]; const float* norm2_g = p.in[12];
    const float* peer_wq = p.in[13]; const float* peer_k1 = p.in[14]; const float* peer_k2 = p.in[15]; const float* peer_u = p.in[16]; const float* peer_v = p.in[17];
    const float* final_g = p.in[18];
    bf16_t* X1 = (bf16_t*)(ws + WS_KV);
    float* OUT = p.out;

    volatile LAS unsigned* MISC = (volatile LAS unsigned*)(lds + MISC_OFF);
    if (tid < 64) MISC[tid] = 0u;
    __syncthreads();
    XcdBarrier bar = xcd_barrier_post(ctl + CW_BAR, MISC + 8);
    const int lo = p.ph_lo, hi = p.ph_hi;
#define IN(k) (lo <= (k) && (k) < hi)
#define REP(k) for (int rep_ = 0; rep_ < 1 + ((DUPMASK >> (k)) & 1); ++rep_)
#define STAMP(i) do { if (TMASK && wave == 0) { unsigned long long t_; asm volatile("s_memrealtime %0\n\ts_waitcnt lgkmcnt(0)" : "=s"(t_) :: "memory"); if (tid == 0) ((volatile LAS unsigned long long*)(lds + MISC_OFF + 64))[i] = t_; } } while (0)
#define SEAM(k) do { if (IN(k) && IN((k) + 1)) xcd_barrier(bar); STAMP((k) + 1); } while (0)
    STAMP(0);

    if (IN(0)) REP(0) {
        {
            LAS float* sc = (LAS float*)lds;
            LAS f32x4* red = (LAS f32x4*)(lds + 8192);
            for (int i = tid; i < 2048; i += NTHR) sc[i] = silu_f(cvec[i]);
            __syncthreads();
            for (int cb = bx; cb < 256; cb += G) {
                if (tid < 384) {
                    const int f4 = tid % 6, rg = tid / 6;
                    f32x4 a0 = {0.f, 0.f, 0.f, 0.f}, a1 = {0.f, 0.f, 0.f, 0.f};
#pragma unroll 4
                    for (int i = 0; i < 16; ++i) { const int r = rg + 64 * i; const f32x4 w = *(const f32x4*)(ada_w + (size_t)r * 6144 + 24 * cb + 4 * f4);
                        a0 += w * sc[r]; a1 += w * sc[1024 + r]; }
                    red[(rg * 6 + f4) * 2 + 0] = a0; red[(rg * 6 + f4) * 2 + 1] = a1;
                }
                __syncthreads();
                if (tid < 48) { const int b = tid / 24, col = tid % 24; float s = 0.f;
                    for (int rg = 0; rg < 64; ++rg) s += red[(rg * 6 + (col >> 2)) * 2 + b][col & 3];
                    MOD[b * 6144 + 24 * cb + col] = s + ada_b[24 * cb + col]; }
                __syncthreads();
            }
        }
        for (int it = bx; it < 128; it += G) {
            const int g = it >> 5, nb = (it >> 1) & 15, cb = it & 1;
            LAS float* PW = (LAS float*)lds;
            LAS float* WO = (LAS float*)(lds + 32768);
            for (int i = tid; i < 64 * 128; i += NTHR) { const int c = i >> 7, j = i & 127; PW[i] = pool_w[(size_t)(g * 128 + cb * 64 + c) * 128 + j] * pool_scale[g * 128 + j]; }
            for (int i = tid; i < 128 * 64; i += NTHR) { const int j = i >> 6, n = i & 63; WO[i] = w_out[(size_t)(512 + g * 128 + j) * 1024 + nb * 64 + n]; }
            __syncthreads();
            const int n = tid & 63, cg = tid >> 6;
            float a[8];
#pragma unroll
            for (int q = 0; q < 8; ++q) a[q] = 0.f;
            for (int j = 0; j < 128; ++j) { const float wo = WO[j * 64 + n];
#pragma unroll
                for (int q = 0; q < 8; ++q) a[q] += PW[(cg * 8 + q) * 128 + j] * wo; }
            u32x4 o; o.x = pk2(a[0], a[1]); o.y = pk2(a[2], a[3]); o.z = pk2(a[4], a[5]); o.w = pk2(a[6], a[7]);
            *(u32x4*)(WOUT + (size_t)(nb * 64 + n) * 1024 + 512 + g * 128 + cb * 64 + cg * 8) = o;
            __syncthreads();
        }
        {
            LAS float* scr = (LAS float*)(lds + wave * 16384);
            constexpr int I_IN = 16 * 64, I_Q = 16 * 64, I_O = 8 * 32;
            for (int it = gw; it < I_IN + I_Q + I_O; it += NGW) {
                int r = it;
                if (r < I_IN) { transpose_item(w_in, INLD, (r >> 6) * 64, (r & 63) * 32, WIN, 1024, 0, scr, lane); continue; } r -= I_IN;
                if (r < I_Q) { transpose_item(peer_wq, 2048, (r >> 6) * 64, (r & 63) * 32, WQ, 1024, 0, scr, lane); continue; } r -= I_Q;
                transpose_item(w_out, 1024, (r >> 5) * 64, (r & 31) * 32, WOUT, 1024, 0, scr, lane);
            }
        }
        for (int i = bx * NTHR + tid; i < 2 * 128 * 128; i += G * NTHR) KK[i] = (bf16_t)f2bf(i < 16384 ? peer_k1[i] : peer_k2[i - 16384]);
    }
    SEAM(0);

    if (IN(1)) REP(1) {
        LAS u32x4* WAPL = (LAS u32x4*)lds;
        LAS float* GWL = (LAS float*)(lds + 32768);
        for (int i = tid; i < 16 * 256; i += NTHR) GWL[i] = gate_w[i];
        {
            const int q = wave >> 1, jb = 2 * (wave & 1);
            unsigned wp[2][8];
#pragma unroll
            for (int p8 = 0; p8 < 8; ++p8) { const int k0 = 4 * lane + 256 * (p8 >> 1) + 2 * (p8 & 1);
                const float* w0 = w_in + (size_t)k0 * INLD + 2048 + 4 * q; const float* w1 = w0 + INLD;
                const f32x4 a = *(const f32x4*)w0, b = *(const f32x4*)w1;
                wp[0][p8] = jb ? pk2(a[2], b[2]) : pk2(a[0], b[0]); wp[1][p8] = jb ? pk2(a[3], b[3]) : pk2(a[1], b[1]); }
#pragma unroll
            for (int j = 0; j < 2; ++j) { const int r = 4 * q + jb + j;
                WAPL[(r * 2 + 0) * 64 + lane] = (u32x4){wp[j][0], wp[j][1], wp[j][2], wp[j][3]}; WAPL[(r * 2 + 1) * 64 + lane] = (u32x4){wp[j][4], wp[j][5], wp[j][6], wp[j][7]}; }
        }
        const f32x4 gb4 = *(const f32x4*)(gate_b + 4 * lane);
        __syncthreads();
        for (int m = gw; m < M; m += NGW) {
            f32x4 v[4]; float ssq = 0.f;
            { const float* xrow = x + (size_t)m * D;
#pragma unroll
                for (int j = 0; j < 4; ++j) { v[j] = *(const f32x4*)(xrow + 4 * lane + 256 * j); ssq += (v[j].x * v[j].x + v[j].y * v[j].y) + (v[j].z * v[j].z + v[j].w * v[j].w); } }
#pragma unroll
            for (int o = 1; o < 64; o <<= 1) ssq += __shfl_xor(ssq, o);
            { const float rstd = 1.f / sqrtf(ssq * (1.f / D) + 1e-6f);
                const float* shift = MOD + (m >= SEQ ? 6144 : 0); const float* scale = shift + 1024; bf16_t* orow = H + (size_t)m * D;
                unsigned yp[8];
#pragma unroll
                for (int j = 0; j < 4; ++j) { const int c = 4 * lane + 256 * j;
                    const f32x4 gg = *(const f32x4*)(norm1_g + c), sh = *(const f32x4*)(shift + c), sc = *(const f32x4*)(scale + c);
                    const f32x4 y = v[j] * rstd * gg * (sc + 1.0f) + sh;
                    yp[2 * j] = pk2(y.x, y.y); yp[2 * j + 1] = pk2(y.z, y.w);
                    u32x2 o; o.x = yp[2 * j]; o.y = yp[2 * j + 1];
                    *(u32x2*)(orow + c) = o; }
                float part[16];
                int wlo = lane; asm volatile("" : "+v"(wlo));
#pragma unroll
                for (int r = 0; r < 16; ++r) { const u32x4 wa = WAPL[(r * 2 + 0) * 64 + wlo], wb = WAPL[(r * 2 + 1) * 64 + wlo]; const unsigned wr[8] = {wa.x, wa.y, wa.z, wa.w, wb.x, wb.y, wb.z, wb.w};
                    float acc = 0.f;
#pragma unroll
                    for (int p8 = 0; p8 < 8; ++p8) acc = __builtin_amdgcn_fdot2_f32_bf16(__builtin_bit_cast(bf16x2_t, yp[p8]), __builtin_bit_cast(bf16x2_t, wr[p8]), acc, false);
                    part[r] = acc;
                    if ((r & 3) == 3) asm volatile("" ::: "memory"); }
                float r1[8], r2[4], r3[2], r4;
#pragma unroll
                for (int k = 0; k < 8; ++k) { const bool hi1 = lane & 1; const float keep = hi1 ? part[2 * k + 1] : part[2 * k], send = hi1 ? part[2 * k] : part[2 * k + 1]; r1[k] = keep + dppf<0xB1>(send); }
#pragma unroll
                for (int k = 0; k < 4; ++k) { const bool hi1 = lane & 2; const float keep = hi1 ? r1[2 * k + 1] : r1[2 * k], send = hi1 ? r1[2 * k] : r1[2 * k + 1]; r2[k] = keep + dppf<0x4E>(send); }
#pragma unroll
                for (int k = 0; k < 2; ++k) { const bool hi1 = lane & 4; const float keep = hi1 ? r2[2 * k + 1] : r2[2 * k], send = hi1 ? r2[2 * k] : r2[2 * k + 1]; r3[k] = keep + dppf<0x124>(send); }
                { const bool hi1 = lane & 8; const float keep = hi1 ? r3[1] : r3[0], send = hi1 ? r3[0] : r3[1]; r4 = keep + dppf<0x128>(send); }
                r4 += __shfl_xor(r4, 16); r4 += __shfl_xor(r4, 32);
                f32x4 lg = gb4;
                int gwo = 4 * lane; asm volatile("" : "+v"(gwo));
#pragma unroll
                for (int r = 0; r < 16; ++r) { const float ar = __builtin_bit_cast(float, __builtin_amdgcn_readlane(__builtin_bit_cast(int, r4), r)); lg += *(const LAS f32x4*)(GWL + r * 256 + gwo) * ar; }
                f32x4 lo;
#pragma unroll
                for (int j = 0; j < 4; ++j) lo[j] = logsig_f(lg[j]) * (1.0f / 16.0f);
                *(f32x4*)(LOGA + (size_t)m * 256 + 4 * lane) = lo;
                asm volatile("" ::: "memory");
            }
        }
    }
    SEAM(1);

    if (IN(2)) REP(2) {
        pg8::Gemm g{H, WIN, M, NIN, D}; pg8::StaticOrder S; S.init(M, NIN, G, bx);
        EpiQ E{PROJ};
        pg8::gemm_phase<EpiQ, pg8::StaticOrder, true, true>(lds, g, S, E);
        for (int r0 = gw; r0 < NEXP; r0 += 4 * NGW) {
            f32x4 v[4][4];
#pragma unroll
            for (int a = 0; a < 4; ++a) { const int r = r0 + a * NGW; if (r < NEXP) { const bool isv = r >= NEXP; const int row = isv ? r - NEXP : r;
                const float* src = (isv ? peer_v : peer_u) + (size_t)row * 1024 + 16 * lane;
#pragma unroll
                for (int q = 0; q < 4; ++q) v[a][q] = *(const f32x4*)(src + 4 * q); } }
#pragma unroll
            for (int a = 0; a < 4; ++a) { const int r = r0 + a * NGW; if (r < NEXP) { const bool isv = r >= NEXP; const int row = isv ? r - NEXP : r;
                float am = 0.f, sq = 0.f;
#pragma unroll
                for (int q = 0; q < 4; ++q) { am = fmaxf(am, fmaxf(fmaxf(fabsf(v[a][q].x), fabsf(v[a][q].y)), fmaxf(fabsf(v[a][q].z), fabsf(v[a][q].w))));
                    sq += (v[a][q].x * v[a][q].x + v[a][q].y * v[a][q].y) + (v[a][q].z * v[a][q].z + v[a][q].w * v[a][q].w); }
#pragma unroll
                for (int off = 1; off < 64; off <<= 1) { am = fmaxf(am, __shfl_xor(am, off)); sq += __shfl_xor(sq, off); }
                unsigned w0 = 0u, w1 = 0u; float sc;
                if (!isv) {
                    const float rms = sqrtf(sq * (1.0f / 1024.0f));
                    sc = rms > 0.f ? rms * (1.0f / 3.0f) : 1.0f; const float inv = 1.0f / sc;
#pragma unroll
                    for (int q = 0; q < 4; ++q)
#pragma unroll
                        for (int j = 0; j < 4; ++j) { const int qi = (int)fminf(fmaxf(rintf(v[a][q][j] * inv), -8.f), 7.f); const unsigned nib = (unsigned)qi & 15u; const int e = 4 * q + j;
                            if (e < 8) w0 |= nib << (4 * e); else w1 |= nib << (4 * (e - 8)); }
                } else {
                    sc = am > 0.f ? am * (1.0f / 6.0f) : 1.0f; const float inv = 1.0f / sc;
                    w0 = __builtin_amdgcn_cvt_scalef32_pk_fp4_f32(w0, v[a][0].x * inv, v[a][0].y * inv, 1.0f, 0); w0 = __builtin_amdgcn_cvt_scalef32_pk_fp4_f32(w0, v[a][0].z * inv, v[a][0].w * inv, 1.0f, 1);
                    w0 = __builtin_amdgcn_cvt_scalef32_pk_fp4_f32(w0, v[a][1].x * inv, v[a][1].y * inv, 1.0f, 2); w0 = __builtin_amdgcn_cvt_scalef32_pk_fp4_f32(w0, v[a][1].z * inv, v[a][1].w * inv, 1.0f, 3);
                    w1 = __builtin_amdgcn_cvt_scalef32_pk_fp4_f32(w1, v[a][2].x * inv, v[a][2].y * inv, 1.0f, 0); w1 = __builtin_amdgcn_cvt_scalef32_pk_fp4_f32(w1, v[a][2].z * inv, v[a][2].w * inv, 1.0f, 1);
                    w1 = __builtin_amdgcn_cvt_scalef32_pk_fp4_f32(w1, v[a][3].x * inv, v[a][3].y * inv, 1.0f, 2); w1 = __builtin_amdgcn_cvt_scalef32_pk_fp4_f32(w1, v[a][3].z * inv, v[a][3].w * inv, 1.0f, 3);
                }
                u32x2 o; o.x = w0; o.y = w1;
                *(u32x2*)((isv ? V8 : U8) + (size_t)row * 512 + 8 * lane) = o;
                if (lane == 0) (isv ? SV : SU)[row] = sc; } }
        }
    }
    SEAM(2);

    if (IN(3)) REP(3) {
        const int hb = tid >> 8, ht = tid & 255, hw = wave & 3, fr = lane & 15, fq = lane >> 4;
        LAS unsigned char* hbase = lds + hb * 49152;
        LAS float* LAT = (LAS float*)hbase;
        LAS float* SEG = (LAS float*)(hbase + 16640);
        LAS bf16_t* VT = (LAS bf16_t*)(hbase + 17664);
        LAS bf16_t* KT = (LAS bf16_t*)(hbase + 36096);
        for (int it = 0; it < (NUNIT + 2 * G - 1) / (2 * G); ++it) {
            const int u = (it * G + bx) * 2 + hb;
            const bool act = u < NUNIT;
            const int h = u & 3, t0 = (u >> 2) * 64;
            const int c = ht & 63, dc = ht >> 6;
            u32x4 kq0, kq1, vq[4];
            if (act) {
                const float* la = LOGA + (size_t)(t0 + c) * 256 + h * 64 + dc * 16;
                const bf16_t* kp = PROJ + (size_t)(t0 + c) * NPROJ + 256 + h * 64 + dc * 16;
                const bf16_t* vp = PROJ + (size_t)(t0 + c) * NPROJ + 512 + h * 128 + dc * 32;
                f32x4 lv[4];
#pragma unroll
                for (int q = 0; q < 4; ++q) lv[q] = *(const f32x4*)(la + 4 * q);
                kq0 = *(const u32x4*)kp; kq1 = *(const u32x4*)(kp + 8);
#pragma unroll
                for (int q = 0; q < 4; ++q) vq[q] = *(const u32x4*)(vp + 8 * q);
#pragma unroll
                for (int q = 0; q < 4; ++q)
#pragma unroll
                    for (int j = 0; j < 4; ++j) LAT[(dc * 16 + q * 4 + j) * 65 + c] = lv[q][j];
            }
            __syncthreads();
            float loc[16];
            { const int d = ht & 63, seg = ht >> 6; float run = 0.f;
#pragma unroll
                for (int r = 0; r < 16; ++r) { run += LAT[d * 65 + 16 * seg + r]; loc[r] = run; }
                SEG[seg * 64 + d] = run; }
            __syncthreads();
            { const int d = ht & 63, seg = ht >> 6; float pre = 0.f;
#pragma unroll
                for (int s2 = 0; s2 < 3; ++s2) pre += (s2 < seg) ? SEG[s2 * 64 + d] : 0.f;
#pragma unroll
                for (int r = 0; r < 16; ++r) LAT[d * 65 + 16 * seg + r] = pre + loc[r];
                if (act && seg == 3) DEC[u * 64 + d] = __expf(pre + loc[15]); }
            __syncthreads();
            if (act) {
                const unsigned kw[8] = {kq0.x, kq0.y, kq0.z, kq0.w, kq1.x, kq1.y, kq1.z, kq1.w};
#pragma unroll
                for (int q = 0; q < 8; ++q) { const int d = dc * 16 + 2 * q;
                    KT[d * 72 + c] = (bf16_t)f2bf(bflo(kw[q]) * __expf(LAT[d * 65 + 63] - LAT[d * 65 + c]));
                    KT[(d + 1) * 72 + c] = (bf16_t)f2bf(bfhi(kw[q]) * __expf(LAT[(d + 1) * 65 + 63] - LAT[(d + 1) * 65 + c])); }
#pragma unroll
                for (int q = 0; q < 4; ++q) { const unsigned vw[4] = {vq[q].x, vq[q].y, vq[q].z, vq[q].w};
#pragma unroll
                    for (int j = 0; j < 4; ++j) { const int v = dc * 32 + 8 * q + 2 * j; VT[v * 72 + c] = (bf16_t)(vw[j] & 0xffffu); VT[(v + 1) * 72 + c] = (bf16_t)(vw[j] >> 16); } }
            }
            __syncthreads();
            if (act) {
#pragma unroll
                for (int mt2 = 0; mt2 < 2; ++mt2) { const int mt = 2 * hw + mt2;
                    const bf16x8 a0 = *(const LAS bf16x8*)(VT + (16 * mt + fr) * 72 + 8 * fq), a1 = *(const LAS bf16x8*)(VT + (16 * mt + fr) * 72 + 32 + 8 * fq);
#pragma unroll
                    for (int nt = 0; nt < 4; ++nt) {
                        const bf16x8 b0 = *(const LAS bf16x8*)(KT + (16 * nt + fr) * 72 + 8 * fq), b1 = *(const LAS bf16x8*)(KT + (16 * nt + fr) * 72 + 32 + 8 * fq);
                        f32x4 acc = {0.f, 0.f, 0.f, 0.f};
                        acc = __builtin_amdgcn_mfma_f32_16x16x32_bf16(a0, b0, acc, 0, 0, 0); acc = __builtin_amdgcn_mfma_f32_16x16x32_bf16(a1, b1, acc, 0, 0, 0);
                        float* kvp = KV + (size_t)u * 8192 + (16 * mt + 4 * fq) * 64 + 16 * nt + fr;
#pragma unroll
                        for (int r = 0; r < 4; ++r) kvp[r * 64] = acc[r]; } }
            }
            __syncthreads();
        }
    }
    SEAM(3);

    if (IN(4)) REP(4) {
        const int nsb = (8 * 8192 + NTHR - 1) / NTHR;
        const bool dopool = (G > nsb) ? (bx >= nsb) : true;
        const int pbx = (G > nsb) ? bx - nsb : bx, pG = (G > nsb) ? G - nsb : G;
        if (dopool) {
        for (int it = pbx * NTHR + tid; it < (M / 8) * 64; it += pG * NTHR) {
            const int cv = it & 63, run = it >> 6, ch = cv * 8, gq = ch >> 7, w = 2 << gq;
            const int t0 = run * 8, pos0 = t0 & (SEQ - 1);
            const bf16_t* pp = PROJ + 1536 + ch;
            float s[8];
#pragma unroll
            for (int j = 0; j < 8; ++j) s[j] = 0.f;
            for (int q = 1; q <= w; ++q) if (pos0 - q >= 0) { const u32x4 v = *(const u32x4*)(pp + (size_t)(t0 - q) * NPROJ);
                s[0] += bflo(v.x); s[1] += bfhi(v.x); s[2] += bflo(v.y); s[3] += bfhi(v.y); s[4] += bflo(v.z); s[5] += bfhi(v.z); s[6] += bflo(v.w); s[7] += bfhi(v.w); }
            for (int r = 0; r < 8; ++r) {
                const int t = t0 + r, pos = pos0 + r;
                const u32x4 v = *(const u32x4*)(pp + (size_t)t * NPROJ);
                const float cur[8] = {bflo(v.x), bfhi(v.x), bflo(v.y), bfhi(v.y), bflo(v.z), bfhi(v.z), bflo(v.w), bfhi(v.w)};
#pragma unroll
                for (int j = 0; j < 8; ++j) s[j] += cur[j];
                if (pos >= w) { const u32x4 o = *(const u32x4*)(pp + (size_t)(t - w) * NPROJ);
                    s[0] -= bflo(o.x); s[1] -= bfhi(o.x); s[2] -= bflo(o.y); s[3] -= bfhi(o.y); s[4] -= bflo(o.z); s[5] -= bfhi(o.z); s[6] -= bflo(o.w); s[7] -= bfhi(o.w); }
                const float inv = 1.f / (float)((pos + 1) < w ? (pos + 1) : w);
                u32x4 ov; ov.x = pk2(s[0] * inv - cur[0], s[1] * inv - cur[1]); ov.y = pk2(s[2] * inv - cur[2], s[3] * inv - cur[3]);
                ov.z = pk2(s[4] * inv - cur[4], s[5] * inv - cur[5]); ov.w = pk2(s[6] * inv - cur[6], s[7] * inv - cur[7]);
                *(u32x4*)(H + (size_t)t * D + 512 + ch) = ov;
            }
        }
        for (int r0 = NEXP + pbx * NWAVES + wave; r0 < 2 * NEXP; r0 += 4 * pG * NWAVES) {
            f32x4 v[4][4];
#pragma unroll
            for (int a = 0; a < 4; ++a) { const int r = r0 + a * pG * NWAVES; if (r < 2 * NEXP) { const bool isv = r >= NEXP; const int row = isv ? r - NEXP : r;
                const float* src = (isv ? peer_v : peer_u) + (size_t)row * 1024 + 16 * lane;
#pragma unroll
                for (int q = 0; q < 4; ++q) v[a][q] = *(const f32x4*)(src + 4 * q); } }
#pragma unroll
            for (int a = 0; a < 4; ++a) { const int r = r0 + a * pG * NWAVES; if (r < 2 * NEXP) { const bool isv = r >= NEXP; const int row = isv ? r - NEXP : r;
                float am = 0.f, sq = 0.f;
#pragma unroll
                for (int q = 0; q < 4; ++q) { am = fmaxf(am, fmaxf(fmaxf(fabsf(v[a][q].x), fabsf(v[a][q].y)), fmaxf(fabsf(v[a][q].z), fabsf(v[a][q].w))));
                    sq += (v[a][q].x * v[a][q].x + v[a][q].y * v[a][q].y) + (v[a][q].z * v[a][q].z + v[a][q].w * v[a][q].w); }
#pragma unroll
                for (int off = 1; off < 64; off <<= 1) { am = fmaxf(am, __shfl_xor(am, off)); sq += __shfl_xor(sq, off); }
                unsigned w0 = 0u, w1 = 0u; float sc;
                if (!isv) {
                    const float rms = sqrtf(sq * (1.0f / 1024.0f));
                    sc = rms > 0.f ? rms * (1.0f / 3.0f) : 1.0f; const float inv = 1.0f / sc;
#pragma unroll
                    for (int q = 0; q < 4; ++q)
#pragma unroll
                        for (int j = 0; j < 4; ++j) { const int qi = (int)fminf(fmaxf(rintf(v[a][q][j] * inv), -8.f), 7.f); const unsigned nib = (unsigned)qi & 15u; const int e = 4 * q + j;
                            if (e < 8) w0 |= nib << (4 * e); else w1 |= nib << (4 * (e - 8)); }
                } else {
                    sc = am > 0.f ? am * (1.0f / 6.0f) : 1.0f; const float inv = 1.0f / sc;
                    w0 = __builtin_amdgcn_cvt_scalef32_pk_fp4_f32(w0, v[a][0].x * inv, v[a][0].y * inv, 1.0f, 0); w0 = __builtin_amdgcn_cvt_scalef32_pk_fp4_f32(w0, v[a][0].z * inv, v[a][0].w * inv, 1.0f, 1);
                    w0 = __builtin_amdgcn_cvt_scalef32_pk_fp4_f32(w0, v[a][1].x * inv, v[a][1].y * inv, 1.0f, 2); w0 = __builtin_amdgcn_cvt_scalef32_pk_fp4_f32(w0, v[a][1].z * inv, v[a][1].w * inv, 1.0f, 3);
                    w1 = __builtin_amdgcn_cvt_scalef32_pk_fp4_f32(w1, v[a][2].x * inv, v[a][2].y * inv, 1.0f, 0); w1 = __builtin_amdgcn_cvt_scalef32_pk_fp4_f32(w1, v[a][2].z * inv, v[a][2].w * inv, 1.0f, 1);
                    w1 = __builtin_amdgcn_cvt_scalef32_pk_fp4_f32(w1, v[a][3].x * inv, v[a][3].y * inv, 1.0f, 2); w1 = __builtin_amdgcn_cvt_scalef32_pk_fp4_f32(w1, v[a][3].z * inv, v[a][3].w * inv, 1.0f, 3);
                }
                u32x2 o; o.x = w0; o.y = w1;
                *(u32x2*)((isv ? V8 : U8) + (size_t)row * 512 + 8 * lane) = o;
                if (lane == 0) (isv ? SV : SU)[row] = sc; } }
        }
        }
        for (int sq = bx * NTHR + tid; sq < 8 * 8192; sq += G * NTHR) {
            const int bh = sq >> 13, e = sq & 8191, b = bh >> 2, h = bh & 3, d = e & 63;
            float st = 0.f;
            for (int n0 = 0; n0 < 128; n0 += 32) {
                float kv[32], dc[32];
#pragma unroll
                for (int q = 0; q < 32; ++q) { const int u = ((b * 128 + n0 + q) * 4 + h); kv[q] = KV[(size_t)u * 8192 + e]; dc[q] = DEC[u * 64 + d]; }
#pragma unroll
                for (int q = 0; q < 32; ++q) { const int u = ((b * 128 + n0 + q) * 4 + h); KV[(size_t)u * 8192 + e] = st; st = st * dc[q] + kv[q]; }
            }
        }
    }
    SEAM(4);

    if (IN(5)) REP(5) {
        LAS float* LAT = (LAS float*)lds;
        LAS float* SEG = (LAS float*)(lds + 16640);
        LAS bf16_t* A2 = (LAS bf16_t*)(lds + 18688);
        LAS bf16_t* KI = (LAS bf16_t*)(lds + 36096);
        LAS bf16_t* BT = (LAS bf16_t*)(lds + 45312);
        LAS float* OL = (LAS float*)(lds + 80128);
        const int fr = lane & 15, fq = lane >> 4;
        for (int u = bx; u < NUNIT; u += G) {
            const int h = u & 3, t0 = (u >> 2) * 64;
            const int i = tid & 63, dc = tid >> 6;
            const float* la = LOGA + (size_t)(t0 + i) * 256 + h * 64 + dc * 8;
            const bf16_t* qp = PROJ + (size_t)(t0 + i) * NPROJ + h * 64 + dc * 8;
            const bf16_t* vp = PROJ + (size_t)(t0 + i) * NPROJ + 512 + h * 128 + dc * 16;
            const float* sp = KV + (size_t)u * 8192;
            const f32x4 la0 = *(const f32x4*)la, la1 = *(const f32x4*)(la + 4);
            const u32x4 qv = *(const u32x4*)qp, kv = *(const u32x4*)(qp + 256), vv0 = *(const u32x4*)vp, vv1 = *(const u32x4*)(vp + 8);
            f32x4 sv[4];
#pragma unroll
            for (int q = 0; q < 4; ++q) sv[q] = *(const f32x4*)(sp + (q * NTHR + tid) * 4);
#pragma unroll
            for (int j = 0; j < 4; ++j) { LAT[(dc * 8 + j) * 65 + i] = la0[j]; LAT[(dc * 8 + 4 + j) * 65 + i] = la1[j]; }
            __syncthreads();
            float loc[8];
            { const int d = tid & 63, seg = tid >> 6; float run = 0.f;
#pragma unroll
                for (int r = 0; r < 8; ++r) { run += LAT[d * 65 + 8 * seg + r]; loc[r] = run; }
                SEG[seg * 64 + d] = run; }
            __syncthreads();
            { const int d = tid & 63, seg = tid >> 6; float pre = 0.f;
#pragma unroll
                for (int s2 = 0; s2 < 7; ++s2) pre += (s2 < seg) ? SEG[s2 * 64 + d] : 0.f;
#pragma unroll
                for (int r = 0; r < 8; ++r) LAT[d * 65 + 8 * seg + r] = pre + loc[r]; }
            __syncthreads();
            {
                const unsigned qw[4] = {qv.x, qv.y, qv.z, qv.w}, kw[4] = {kv.x, kv.y, kv.z, kv.w};
                u32x4 qo, ko; unsigned* qop = (unsigned*)&qo; unsigned* kop = (unsigned*)&ko;
#pragma unroll
                for (int q = 0; q < 4; ++q) { const int d = dc * 8 + 2 * q; const float b0 = LAT[d * 65 + i], b1 = LAT[(d + 1) * 65 + i];
                    qop[q] = pk2(bflo(qw[q]) * __expf(b0) * 0.125f, bfhi(qw[q]) * __expf(b1) * 0.125f);
                    kop[q] = pk2(bflo(kw[q]) * __expf(-b0), bfhi(kw[q]) * __expf(-b1)); }
                *(LAS u32x4*)(A2 + i * 136 + 64 + dc * 8) = qo;
                *(LAS u32x4*)(KI + i * 72 + dc * 8) = ko;
                const unsigned vw[8] = {vv0.x, vv0.y, vv0.z, vv0.w, vv1.x, vv1.y, vv1.z, vv1.w};
#pragma unroll
                for (int j = 0; j < 8; ++j) { const int v = dc * 16 + 2 * j; BT[v * 136 + i] = (bf16_t)(vw[j] & 0xffffu); BT[(v + 1) * 136 + i] = (bf16_t)(vw[j] >> 16); }
#pragma unroll
                for (int q = 0; q < 4; ++q) { const int e = (q * NTHR + tid) * 4, v = e >> 6, d = e & 63;
                    u32x2 so; so.x = pk2(sv[q].x, sv[q].y); so.y = pk2(sv[q].z, sv[q].w);
                    *(LAS u32x2*)(BT + v * 136 + 64 + d) = so; }
            }
            __syncthreads();
            {
                const int mt = wave & 3;
                const bf16x8 a0 = *(const LAS bf16x8*)(A2 + (16 * mt + fr) * 136 + 64 + 8 * fq), a1 = *(const LAS bf16x8*)(A2 + (16 * mt + fr) * 136 + 96 + 8 * fq);
#pragma unroll
                for (int n2 = 0; n2 < 2; ++n2) { const int nt = 2 * (wave >> 2) + n2;
                    const bf16x8 b0 = *(const LAS bf16x8*)(KI + (16 * nt + fr) * 72 + 8 * fq), b1 = *(const LAS bf16x8*)(KI + (16 * nt + fr) * 72 + 32 + 8 * fq);
                    f32x4 acc = {0.f, 0.f, 0.f, 0.f};
                    acc = __builtin_amdgcn_mfma_f32_16x16x32_bf16(a0, b0, acc, 0, 0, 0); acc = __builtin_amdgcn_mfma_f32_16x16x32_bf16(a1, b1, acc, 0, 0, 0);
                    const int jj = 16 * nt + fr;
#pragma unroll
                    for (int r = 0; r < 4; ++r) { const int ii = 16 * mt + 4 * fq + r; A2[ii * 136 + jj] = (bf16_t)f2bf(jj <= ii ? acc[r] : 0.f); } }
            }
            __syncthreads();
            {
                const int mt = wave & 3;
                bf16x8 af[4];
#pragma unroll
                for (int ks = 0; ks < 4; ++ks) af[ks] = *(const LAS bf16x8*)(A2 + (16 * mt + fr) * 136 + 32 * ks + 8 * fq);
#pragma unroll
                for (int n4 = 0; n4 < 4; ++n4) { const int nt = 4 * (wave >> 2) + n4;
                    f32x4 acc = {0.f, 0.f, 0.f, 0.f};
#pragma unroll
                    for (int ks = 0; ks < 4; ++ks) { const bf16x8 bb = *(const LAS bf16x8*)(BT + (16 * nt + fr) * 136 + 32 * ks + 8 * fq); acc = __builtin_amdgcn_mfma_f32_16x16x32_bf16(af[ks], bb, acc, 0, 0, 0); }
#pragma unroll
                    for (int r = 0; r < 4; ++r) OL[(16 * mt + 4 * fq + r) * 132 + 16 * nt + fr] = acc[r]; }
            }
            __syncthreads();
            {
                const int ti = tid >> 3, vc = tid & 7;
                f32x4 o[4]; float ss = 0.f;
#pragma unroll
                for (int q = 0; q < 4; ++q) { o[q] = *(const LAS f32x4*)(OL + ti * 132 + 16 * vc + 4 * q); ss += (o[q].x * o[q].x + o[q].y * o[q].y) + (o[q].z * o[q].z + o[q].w * o[q].w); }
                ss += __shfl_xor(ss, 1); ss += __shfl_xor(ss, 2); ss += __shfl_xor(ss, 4);
                const float rstd = 1.f / sqrtf(ss * (1.f / 128.f) + 1e-6f);
                const int t = t0 + ti;
                const bf16_t* gp = PROJ + (size_t)t * NPROJ + 1024 + h * 128 + 16 * vc;
                const u32x4 g0 = *(const u32x4*)gp, g1 = *(const u32x4*)(gp + 8);
                const unsigned gw8[8] = {g0.x, g0.y, g0.z, g0.w, g1.x, g1.y, g1.z, g1.w};
                unsigned ow[8];
#pragma unroll
                for (int q = 0; q < 4; ++q) { const f32x4 gn = *(const f32x4*)(gla_norm_g + 16 * vc + 4 * q);
                    const float y0 = o[q].x * rstd * gn.x * silu_f(bflo(gw8[2 * q])), y1 = o[q].y * rstd * gn.y * silu_f(bfhi(gw8[2 * q]));
                    const float y2 = o[q].z * rstd * gn.z * silu_f(bflo(gw8[2 * q + 1])), y3 = o[q].w * rstd * gn.w * silu_f(bfhi(gw8[2 * q + 1]));
                    ow[2 * q] = pk2(y0, y1); ow[2 * q + 1] = pk2(y2, y3); }
                bf16_t* hp2 = H + (size_t)t * D + h * 128 + 16 * vc;
                *(u32x4*)hp2 = (u32x4){ow[0], ow[1], ow[2], ow[3]}; *(u32x4*)(hp2 + 8) = (u32x4){ow[4], ow[5], ow[6], ow[7]};
            }
        }
    }
    SEAM(5);

    if (IN(6)) REP(6) {
        pg8::Gemm g{H, WOUT, M, D, D}; pg8::StaticOrder S; S.init(M, D, G, bx);
        EpiX1 E{x, X1, MOD + 2048};
        pg8::gemm_phase<EpiX1, pg8::StaticOrder, true, true>(lds, g, S, E);
    }
    SEAM(6);

    if (IN(7)) REP(7) {
        for (int m = gw; m < M; m += 4 * NGW) norm_mod_rows_bf16<4>(X1, m, NGW, norm2_g, MOD, 3072, H, lane);
    }
    SEAM(7);

    if (IN(8)) REP(8) {
        pg8::Gemm g{H, WQ, M, 2048, D}; pg8::StaticOrder S; S.init(M, 2048, G, bx);
        EpiQ E{PROJ};
        pg8::gemm_phase<EpiQ, pg8::StaticOrder, true, true>(lds, g, S, E);
    }
    SEAM(8);

    if (IN(9)) REP(9) {
        LAS bf16_t* KL = (LAS bf16_t*)lds;
        LAS unsigned char* CT = lds + 69632;
        for (int i = tid; i < 2 * 128 * 16; i += NTHR) { const int row = i >> 4, ck = i & 15; *(LAS u32x4*)(KL + row * 136 + ck * 8) = *(const u32x4*)(KK + row * 128 + ck * 8); }
        if (tid < 64) CT[tid] = CAND_IJ[tid];
        __syncthreads();
        const int fr = lane & 15, fq = lane >> 4, rb4 = (lane & 48) * 4;
        int cia[4], cja[4];
#pragma unroll
        for (int sl = 0; sl < 4; ++sl) { const unsigned ij = CAND_IJ[fr * 4 + sl]; cia[sl] = rb4 + 4 * (int)(ij >> 4); cja[sl] = rb4 + 4 * (int)(ij & 15); }
        const bf16_t* Q = PROJ;
        for (int wi = gw; wi < (M / 16) * 8; wi += NGW) {
            const int h = wi & 7, t0 = (wi >> 3) * 16;
            unsigned kk[8][8];
#pragma unroll
            for (int half = 0; half < 2; ++half) {
                const bf16_t* qp = Q + (size_t)(t0 + fr) * 2048 + h * 256 + half * 128 + fq * 8;
                bf16x8 af[4];
#pragma unroll
                for (int ks = 0; ks < 4; ++ks) af[ks] = *(const bf16x8*)(qp + ks * 32);
                int kboff = half * 128 * 136 + fr * 136 + fq * 8;
                asm volatile("" : "+v"(kboff));
                const LAS bf16_t* kb = KL + kboff;
#pragma unroll
                for (int nt = 0; nt < 8; ++nt) {
                    f32x4 c = {0.f, 0.f, 0.f, 0.f};
#pragma unroll
                    for (int ks = 0; ks < 4; ++ks) { const bf16x8 bf = *(const LAS bf16x8*)(kb + nt * 16 * 136 + ks * 32); c = __builtin_amdgcn_mfma_f32_16x16x32_bf16(af[ks], bf, c, 0, 0, 0); }
#pragma unroll
                    for (int r = 0; r < 4; ++r) kk[half * 4 + r][nt] = fkey(c[r], 127u - (unsigned)(nt * 16 + fr), 127u);
                }
            }
#define CE(a, b) do { const unsigned hi_ = umax_(kx[a], kx[b]), lo_ = umin_(kx[a], kx[b]); kx[a] = hi_; kx[b] = lo_; } while (0)
#pragma unroll
            for (int x = 0; x < 8; ++x) { unsigned (&kx)[8] = kk[x];
                CE(0, 1); CE(2, 3); CE(4, 5); CE(6, 7); CE(0, 2); CE(1, 3); CE(4, 6); CE(5, 7); CE(1, 2); CE(5, 6);
                CE(0, 4); CE(1, 5); CE(2, 6); CE(3, 7); CE(2, 4); CE(3, 5); CE(1, 2); CE(3, 4); CE(5, 6); }
            unsigned res[8];
#pragma unroll
            for (int x = 0; x < 8; ++x) res[x] = 0u;
#pragma unroll 1
            for (int rd = 0; rd < 16; ++rd)
#pragma unroll
                for (int x = 0; x < 8; ++x) { unsigned (&kx)[8] = kk[x];
                    const unsigned m = row_allmax(kx[0]); const bool own = kx[0] == m;
#pragma unroll
                    for (int j = 0; j < 7; ++j) kx[j] = own ? kx[j + 1] : kx[j];
                    kx[7] = own ? 0u : kx[7];
                    res[x] = (fr == rd) ? m : res[x]; }
            unsigned ck[4][4];
#pragma unroll
            for (int r = 0; r < 4; ++r)
#pragma unroll
                for (int sl = 0; sl < 4; ++sl) { const unsigned va = __builtin_amdgcn_ds_bpermute(cia[sl], res[r]), vb = __builtin_amdgcn_ds_bpermute(cja[sl], res[4 + r]);
                    const float sum = fkey_val(va, 127u) + fkey_val(vb, 127u);
                    ck[r][sl] = (fr * 4 + sl < 50) ? fkey(sum, 63u - (unsigned)(fr * 4 + sl), 63u) : 0u; }
#pragma unroll
            for (int r = 0; r < 4; ++r) { unsigned (&kx)[4] = ck[r]; CE(0, 1); CE(2, 3); CE(0, 2); CE(1, 3); CE(1, 2); }
#undef CE
            unsigned res3[4], mfirst[4];
#pragma unroll
            for (int r = 0; r < 4; ++r) { res3[r] = 0u; mfirst[r] = 0u; }
#pragma unroll 1
            for (int rd = 0; rd < 16; ++rd)
#pragma unroll
                for (int r = 0; r < 4; ++r) { unsigned (&kx)[4] = ck[r];
                    const unsigned m = row_allmax(kx[0]); const bool own = kx[0] == m;
                    kx[0] = own ? kx[1] : kx[0]; kx[1] = own ? kx[2] : kx[1]; kx[2] = own ? kx[3] : kx[2]; kx[3] = own ? 0u : kx[3];
                    res3[r] = (fr == rd) ? m : res3[r]; mfirst[r] = (rd == 0) ? m : mfirst[r]; }
#pragma unroll
            for (int r = 0; r < 4; ++r) {
                const unsigned cidx = 63u - (res3[r] & 63u);
                const unsigned ij = CT[cidx];
                const unsigned wa = __builtin_amdgcn_ds_bpermute(rb4 + 4 * (int)(ij >> 4), res[r]), wb = __builtin_amdgcn_ds_bpermute(rb4 + 4 * (int)(ij & 15), res[4 + r]);
                const int eid = (int)((127u - (wa & 127u)) * 128u + (127u - (wb & 127u)));
                const float ex = __expf(fkey_val(res3[r], 63u) - fkey_val(mfirst[r], 63u));
                const float tot = row_allsum(ex);
                const size_t o = (size_t)(t0 + 4 * fq + r) * 128 + h * 16 + fr;
                IDX[o] = eid; GATE[o] = ex / tot;
            }
        }
    }
    SEAM(9);

    if (IN(10)) REP(10) {
        struct TokMeta { int id0, id1; float zs0, zs1, as0, as1; u32x4 ha, hb; };
#define P10_META(mm, tt) do { const size_t t_ = (size_t)(tt); (mm).id0 = IDX[t_ * 128 + lane]; (mm).id1 = IDX[t_ * 128 + 64 + lane]; \
            (mm).zs0 = SU[(mm).id0]; (mm).zs1 = SU[(mm).id1]; (mm).as0 = GATE[t_ * 128 + lane] * SV[(mm).id0] * 64.f; (mm).as1 = GATE[t_ * 128 + 64 + lane] * SV[(mm).id1] * 64.f; \
            const bf16_t* hp_ = H + t_ * D + 16 * lane; (mm).ha = *(const u32x4*)hp_; (mm).hb = *(const u32x4*)(hp_ + 8); } while (0)
#define P10_LOAD(ub, vb, mm, cc) peer_chunk_load<4, 4>(ub, vb, U8, V8, ((cc) & 8) ? (mm).id1 : (mm).id0, (8 * (cc)) & 63, lane)
#define P10_COMP(ub, vb, cc) peer_chunk_compute4(ub, vb, hh, o2, (((cc) & 8) ? cur.zs1 : cur.zs0) * hscale, ((cc) & 8) ? cur.as1 : cur.as0, (8 * (cc)) & 63, lane)
        int t = gw;
        if (t < M) {
            TokMeta cur, nxt;
            P10_META(cur, t);
            { const int tn = (t + NGW < M) ? t + NGW : t; P10_META(nxt, tn); }
            RowVec<4> u0[8], u1[8], u2[8], u3[8], v0[8], v1[8], v2[8], v3[8];
            P10_LOAD(u0, v0, cur, 0); P10_LOAD(u1, v1, cur, 1); P10_LOAD(u2, v2, cur, 2);
            for (; t < M; t += NGW) {
                h2_t o2[8]; int hh[4]; float hscale;
                {
                    const unsigned hwv[8] = {cur.ha.x, cur.ha.y, cur.ha.z, cur.ha.w, cur.hb.x, cur.hb.y, cur.hb.z, cur.hb.w};
                    float hf[16], am = 0.f;
#pragma unroll
                    for (int k = 0; k < 8; ++k) { hf[2 * k] = bflo(hwv[k]); hf[2 * k + 1] = bfhi(hwv[k]); am = fmaxf(am, fmaxf(fabsf(hf[2 * k]), fabsf(hf[2 * k + 1]))); o2[k] = (h2_t){(_Float16)0.f, (_Float16)0.f}; }
#pragma unroll
                    for (int off = 1; off < 64; off <<= 1) am = fmaxf(am, __shfl_xor(am, off));
                    hscale = am > 0.f ? am * (1.0f / 119.0f) : 1.0f; const float hinv = 1.0f / hscale;
                    unsigned ph0 = 0u, ph1 = 0u, pl0 = 0u, pl1 = 0u;
#pragma unroll
                    for (int e = 0; e < 16; ++e) { const int hi8 = (int)rintf(hf[e] * hinv); const int lo = ((hi8 + 8) & 15) - 8, hi = (hi8 - lo) >> 4;
                        if (e < 8) { ph0 |= ((unsigned)hi & 15u) << (4 * e); pl0 |= ((unsigned)lo & 15u) << (4 * e); } else { ph1 |= ((unsigned)hi & 15u) << (4 * (e - 8)); pl1 |= ((unsigned)lo & 15u) << (4 * (e - 8)); } }
                    hh[0] = (int)ph0; hh[1] = (int)ph1; hh[2] = (int)pl0; hh[3] = (int)pl1;
                }
#pragma unroll 1
                for (int g4 = 0; g4 < 12; g4 += 4) {
                    P10_LOAD(u3, v3, cur, g4 + 3); P10_COMP(u0, v0, g4);
                    P10_LOAD(u0, v0, cur, g4 + 4); P10_COMP(u1, v1, g4 + 1);
                    P10_LOAD(u1, v1, cur, g4 + 5); P10_COMP(u2, v2, g4 + 2);
                    P10_LOAD(u2, v2, cur, g4 + 6); P10_COMP(u3, v3, g4 + 3);
                }
                const float* g2p = MOD + (t >= SEQ ? 6144 : 0) + 5120 + 16 * lane;
                const bf16_t* xr = X1 + (size_t)t * D + 16 * lane;
                const u32x4 xa = *(const u32x4*)xr, xb = *(const u32x4*)(xr + 8);
                P10_LOAD(u3, v3, cur, 15); P10_COMP(u0, v0, 12);
                P10_LOAD(u0, v0, nxt, 0); P10_COMP(u1, v1, 13);
                P10_LOAD(u1, v1, nxt, 1); P10_COMP(u2, v2, 14);
                P10_LOAD(u2, v2, nxt, 2); P10_COMP(u3, v3, 15);
                const unsigned xw[8] = {xa.x, xa.y, xa.z, xa.w, xb.x, xb.y, xb.z, xb.w};
                float ss = 0.f; f32x4 xv[4];
#pragma unroll
                for (int q = 0; q < 4; ++q) { const f32x4 ov = {(float)o2[2 * q].x, (float)o2[2 * q].y, (float)o2[2 * q + 1].x, (float)o2[2 * q + 1].y};
                    const f32x4 gg = *(const f32x4*)(g2p + 4 * q);
                    const f32x4 x1q = {bflo(xw[2 * q]), bfhi(xw[2 * q]), bflo(xw[2 * q + 1]), bfhi(xw[2 * q + 1])};
                    xv[q] = x1q + gg * (ov * (1.0f / 64.0f)); ss += (xv[q].x * xv[q].x + xv[q].y * xv[q].y) + (xv[q].z * xv[q].z + xv[q].w * xv[q].w); }
                const float rstd = 1.f / sqrtf(wave_sum(ss) * (1.f / D) + 1e-6f);
                float* orow = OUT + (size_t)t * D + 16 * lane;
#pragma unroll
                for (int q = 0; q < 4; ++q) { const f32x4 fg = *(const f32x4*)(final_g + 16 * lane + 4 * q);
                    *(f32x4*)(orow + 4 * q) = xv[q] * rstd * fg; }
                cur = nxt;
                { const int tn = (t + 2 * NGW < M) ? t + 2 * NGW : ((t + NGW < M) ? t + NGW : t); P10_META(nxt, tn); }
            }
        }
#undef P10_META
#undef P10_LOAD
#undef P10_COMP
    }
    if (TMASK) { xcd_barrier(bar); STAMP(11);
        if (bx == 0 && tid == 0) { volatile LAS unsigned long long* T = (volatile LAS unsigned long long*)(lds + MISC_OFF + 64); unsigned long long span = 0;
#pragma unroll
            for (int k = 0; k < 11; ++k) if ((TMASK >> k) & 1) span += T[k + 1] - T[k];
            unsigned long long t0, t1; asm volatile("s_memrealtime %0\n\ts_waitcnt lgkmcnt(0)" : "=s"(t0) :: "memory");
            do { __builtin_amdgcn_s_sleep(8); asm volatile("s_memrealtime %0\n\ts_waitcnt lgkmcnt(0)" : "=s"(t1) :: "memory"); } while (t1 - t0 < span); } }
#undef IN
#undef REP
#undef SEAM
}

extern "C" void kernel_launch(void* const* d_in, const int* in_sizes, int n_in, void* d_out, int out_size, void* d_ws, size_t ws_size, hipStream_t stream) {
    static int grid = 0;
    if (grid == 0) {
        if (n_in != 19 || out_size != M * D || ws_size < WS_END) { fprintf(stderr, "kernel_launch: unexpected shapes (n_in %d out %d ws %zu)\n", n_in, out_size, ws_size); grid = -1; return; }
        int dev = 0, cus = 0, per_cu = 0;
        (void)hipGetDevice(&dev); (void)hipDeviceGetAttribute(&cus, hipDeviceAttributeMultiprocessorCount, dev);
        (void)hipFuncSetAttribute((const void*)fwd_kernel, hipFuncAttributeMaxDynamicSharedMemorySize, LDS_BYTES);
        (void)hipOccupancyMaxActiveBlocksPerMultiprocessor(&per_cu, (const void*)fwd_kernel, NTHR, LDS_BYTES);
        (void)hipGetLastError();
        if (per_cu < 1) { fprintf(stderr, "kernel_launch: occupancy query says %d blocks/CU\n", per_cu); per_cu = 1; }
        grid = cus;
    }
    if (grid < 0) return;
    (void)hipMemsetAsync((char*)d_ws + WS_CTL, 0, CTL_ZERO_BYTES, stream);
    Params p{};
    for (int i = 0; i < 19; ++i) p.in[i] = (const float*)d_in[i];
    p.out = (float*)d_out; p.ws = (unsigned char*)d_ws; p.ph_lo = 0; p.ph_hi = 11;
    void* args[] = {&p};
    hipError_t e = hipLaunchCooperativeKernel((const void*)fwd_kernel, dim3(grid), dim3(NTHR), args, LDS_BYTES, stream);
    if (e != hipSuccess) fprintf(stderr, "kernel_launch: cooperative launch failed: %s (grid %d)\n", hipGetErrorString(e), grid);
}
```
